# Optimizing an MI355X kernel written in HIP

```python
import math
import jax, jax.numpy as jnp
from jax import lax
import numpy as np

D_MODEL = 1024
BATCH = 8
SEQ = 2048
DEPTH = 1

MEM_LEN = 256
MLA_HEADS = 8
QK_NOPE_DIM = 64
QK_ROPE_DIM = 32
V_HEAD_DIM = 64
Q_LORA_RANK = 256
KV_LORA_RANK = 128
ROPE_THETA = 10000.0
Q_BLOCK = 128
CONV_WIDTH = 512
CONV_KSIZE = 3
XATTN_HEADS = 4
XATTN_HEAD_DIM = 128
N_GROUPS = 8
EXPERTS_PER_GROUP = 8
N_EXPERTS = N_GROUPS * EXPERTS_PER_GROUP
TOP_K_IN_GROUP = 2
EXPERT_FF = 256
DISPATCH_BLOCK = 128
N_BRANCHES = 2
EPS = 1e-6

COL_CQ = Q_LORA_RANK
COL_CKV = COL_CQ + KV_LORA_RANK
COL_KROPE = COL_CKV + QK_ROPE_DIM
COL_CONV = COL_KROPE + 3 * CONV_WIDTH
IN_COLS = COL_CONV + N_BRANCHES * D_MODEL

kernel_name = "hybrid_mla_shortconv_gated_hmoe_block"


def rmsnorm(x, g):
    xf = x.astype(jnp.float32)
    y = xf * lax.rsqrt(jnp.mean(xf * xf, axis=-1, keepdims=True) + EPS)
    return (y * g.astype(jnp.float32)).astype(x.dtype)


def rope_tables(positions):
    inv_freq = ROPE_THETA ** (-jnp.arange(0, QK_ROPE_DIM, 2, dtype=jnp.float32) / QK_ROPE_DIM)
    ang = positions.astype(jnp.float32)[..., None] * inv_freq
    return jnp.cos(ang), jnp.sin(ang)


def apply_rope(x, cos, sin):
    half = x.shape[-1] // 2
    x1 = x[..., :half].astype(jnp.float32)
    x2 = x[..., half:].astype(jnp.float32)
    return jnp.concatenate([x1 * cos - x2 * sin, x1 * sin + x2 * cos], axis=-1).astype(x.dtype)


def mla_attention(c_q, c_kv, k_rope_raw, cos, sin, g_cq, w_uq, g_ckv, w_ukv):
    B, S, _ = c_q.shape
    q = (rmsnorm(c_q, g_cq) @ w_uq).reshape(B, S, MLA_HEADS, QK_NOPE_DIM + QK_ROPE_DIM)
    q_nope = q[..., :QK_NOPE_DIM]
    q_rope = apply_rope(q[..., QK_NOPE_DIM:], cos[:, :, None, :], sin[:, :, None, :])
    kv = (rmsnorm(c_kv, g_ckv) @ w_ukv).reshape(B, S, MLA_HEADS, QK_NOPE_DIM + V_HEAD_DIM)
    k_nope, v = kv[..., :QK_NOPE_DIM], kv[..., QK_NOPE_DIM:]
    k_rope = apply_rope(k_rope_raw, cos, sin)
    scale = 1.0 / math.sqrt(QK_NOPE_DIM + QK_ROPE_DIM)
    outs = []
    for i in range(S // Q_BLOCK):
        q0, q1 = i * Q_BLOCK, (i + 1) * Q_BLOCK
        s = (jnp.einsum("bqhd,bkhd->bhqk", q_nope[:, q0:q1], k_nope[:, :q1])
             + jnp.einsum("bqhr,bkr->bhqk", q_rope[:, q0:q1], k_rope[:, :q1]))
        s = s.astype(jnp.float32) * scale
        causal = jnp.arange(q1)[None, :] <= (q0 + jnp.arange(Q_BLOCK))[:, None]
        p = jax.nn.softmax(jnp.where(causal, s, -jnp.inf), axis=-1).astype(v.dtype)
        outs.append(jnp.einsum("bhqk,bkhd->bqhd", p, v[:, :q1]))
    return jnp.concatenate(outs, axis=1).reshape(B, S, MLA_HEADS * V_HEAD_DIM)


def gated_short_conv(bcx, conv_w):
    b_gate, c_gate, xv = jnp.split(bcx, 3, axis=-1)
    u = c_gate * xv
    S = u.shape[1]
    u_pad = jnp.pad(u, ((0, 0), (CONV_KSIZE - 1, 0), (0, 0)))
    y = conv_w[0] * u_pad[:, 0:S]
    for k in range(1, CONV_KSIZE):
        y = y + conv_w[k] * u_pad[:, k:k + S]
    return b_gate * y


def memory_cross_attention(h, mem_n, w_q, w_kv, w_o):
    B, S, _ = h.shape
    M = mem_n.shape[1]
    q = (h @ w_q).reshape(B, S, XATTN_HEADS, XATTN_HEAD_DIM)
    kv = (mem_n @ w_kv).reshape(B, M, 2, XATTN_HEADS, XATTN_HEAD_DIM)
    k, v = kv[:, :, 0], kv[:, :, 1]
    s = jnp.einsum("bqhd,bmhd->bhqm", q, k).astype(jnp.float32) / math.sqrt(XATTN_HEAD_DIM)
    p = jax.nn.softmax(s, axis=-1).astype(v.dtype)
    o = jnp.einsum("bhqm,bmhd->bqhd", p, v).reshape(B, S, XATTN_HEADS * XATTN_HEAD_DIM)
    return o @ w_o


def hierarchical_moe(h, w_rg, b_rg, w_re, b_re, w_gate_up, w_down):
    B, S, D = h.shape
    N = B * S
    hf = h.reshape(N, D)
    group_logits = (hf @ w_rg).astype(jnp.float32) + b_rg.astype(jnp.float32)
    group_prob = jax.nn.softmax(group_logits, axis=-1)
    _, g_idx = lax.top_k(group_logits, 1)
    p_group = jnp.take_along_axis(group_prob, g_idx, axis=-1)
    exp_logits = ((hf @ w_re).astype(jnp.float32) + b_re.astype(jnp.float32)).reshape(N, N_GROUPS, EXPERTS_PER_GROUP)
    idx = jnp.broadcast_to(g_idx[:, :, None], (N, 1, EXPERTS_PER_GROUP))
    in_group = jnp.take_along_axis(exp_logits, idx, axis=1)[:, 0]
    top_vals, top_local = lax.top_k(in_group, TOP_K_IN_GROUP)
    combine = p_group * jax.nn.softmax(top_vals, axis=-1)
    expert_id = (g_idx * EXPERTS_PER_GROUP + top_local).reshape(-1)
    token_id = jnp.repeat(jnp.arange(N, dtype=jnp.int32), TOP_K_IN_GROUP)
    weight = combine.reshape(-1)
    NK = N * TOP_K_IN_GROUP
    order = jnp.argsort(expert_id)
    e_sorted, tok_sorted, w_sorted = expert_id[order], token_id[order], weight[order]
    counts = jnp.zeros((N_EXPERTS,), jnp.int32).at[expert_id].add(1)
    padded = (counts + DISPATCH_BLOCK - 1) // DISPATCH_BLOCK * DISPATCH_BLOCK
    start = jnp.cumsum(counts) - counts
    pad_end = jnp.cumsum(padded)
    pad_start = pad_end - padded
    dest = pad_start[e_sorted] + (jnp.arange(NK, dtype=jnp.int32) - start[e_sorted])
    P = (NK + DISPATCH_BLOCK - 1) // DISPATCH_BLOCK * DISPATCH_BLOCK + N_EXPERTS * DISPATCH_BLOCK
    n_blocks = P // DISPATCH_BLOCK
    x_disp = jnp.zeros((P, D), h.dtype).at[dest].set(hf[tok_sorted])
    block_expert = jnp.minimum(
        jnp.searchsorted(pad_end, jnp.arange(n_blocks, dtype=jnp.int32) * DISPATCH_BLOCK, side="right"),
        N_EXPERTS - 1)

    def expert_block(args):
        xb, e = args
        gate, up = jnp.split(xb @ w_gate_up[e], 2, axis=-1)
        return (jax.nn.silu(gate) * up) @ w_down[e]

    y_disp = lax.map(expert_block, (x_disp.reshape(n_blocks, DISPATCH_BLOCK, D), block_expert)).reshape(P, D)
    y = jnp.zeros((N, D), h.dtype).at[tok_sorted].add(y_disp[dest] * w_sorted[:, None].astype(h.dtype))
    return y.reshape(B, S, D)


def setup_inputs(seed: int = 0) -> dict:
    key = jax.random.key(seed)
    ks = jax.random.split(key, 32)

    def nrm(k, shape, scale):
        return jax.random.normal(k, shape, jnp.float32) * scale

    def gain(k, n):
        return 1.0 + 0.02 * jax.random.normal(k, (DEPTH, n), jnp.float32)

    offsets = jax.random.randint(ks[2], (BATCH, 1), 0, 4096, dtype=jnp.int32)
    positions = offsets + jnp.arange(SEQ, dtype=jnp.int32)[None, :]
    return {
        "x": nrm(ks[0], (BATCH, SEQ, D_MODEL), 1.0),
        "mem": nrm(ks[1], (BATCH, MEM_LEN, D_MODEL), 1.0),
        "positions": positions,
        "g_mix": gain(ks[3], D_MODEL),
        "w_in": nrm(ks[4], (DEPTH, D_MODEL, IN_COLS), D_MODEL ** -0.5),
        "b_gate": nrm(ks[5], (DEPTH, N_BRANCHES * D_MODEL), 0.02),
        "g_cq": gain(ks[6], Q_LORA_RANK),
        "w_uq": nrm(ks[7], (DEPTH, Q_LORA_RANK, MLA_HEADS * (QK_NOPE_DIM + QK_ROPE_DIM)), Q_LORA_RANK ** -0.5),
        "g_ckv": gain(ks[8], KV_LORA_RANK),
        "w_ukv": nrm(ks[9], (DEPTH, KV_LORA_RANK, MLA_HEADS * (QK_NOPE_DIM + V_HEAD_DIM)), KV_LORA_RANK ** -0.5),
        "conv_w": nrm(ks[10], (DEPTH, CONV_KSIZE, CONV_WIDTH), CONV_KSIZE ** -0.5),
        "w_branch_a": nrm(ks[11], (DEPTH, MLA_HEADS * V_HEAD_DIM, D_MODEL), (MLA_HEADS * V_HEAD_DIM) ** -0.5),
        "w_branch_b": nrm(ks[12], (DEPTH, CONV_WIDTH, D_MODEL), CONV_WIDTH ** -0.5),
        "w_out": nrm(ks[13], (DEPTH, D_MODEL, D_MODEL), D_MODEL ** -0.5),
        "g_xattn": gain(ks[14], D_MODEL),
        "g_mem": gain(ks[15], D_MODEL),
        "w_q_mem": nrm(ks[16], (DEPTH, D_MODEL, XATTN_HEADS * XATTN_HEAD_DIM), D_MODEL ** -0.5),
        "w_kv_mem": nrm(ks[17], (DEPTH, D_MODEL, 2 * XATTN_HEADS * XATTN_HEAD_DIM), D_MODEL ** -0.5),
        "w_o_mem": nrm(ks[18], (DEPTH, XATTN_HEADS * XATTN_HEAD_DIM, D_MODEL), (XATTN_HEADS * XATTN_HEAD_DIM) ** -0.5),
        "g_moe": gain(ks[19], D_MODEL),
        "w_router_group": nrm(ks[20], (DEPTH, D_MODEL, N_GROUPS), D_MODEL ** -0.5),
        "b_router_group": nrm(ks[21], (DEPTH, N_GROUPS), 0.01),
        "w_router_expert": nrm(ks[22], (DEPTH, D_MODEL, N_EXPERTS), D_MODEL ** -0.5),
        "b_router_expert": nrm(ks[23], (DEPTH, N_EXPERTS), 0.01),
        "w_gate_up": nrm(ks[24], (DEPTH, N_EXPERTS, D_MODEL, 2 * EXPERT_FF), D_MODEL ** -0.5),
        "w_down": nrm(ks[25], (DEPTH, N_EXPERTS, EXPERT_FF, D_MODEL), EXPERT_FF ** -0.5),
        "g_final": 1.0 + 0.02 * jax.random.normal(ks[26], (D_MODEL,), jnp.float32),
    }


def reference(x, mem, positions, g_mix, w_in, b_gate, g_cq, w_uq, g_ckv, w_ukv, conv_w,
              w_branch_a, w_branch_b, w_out, g_xattn, g_mem, w_q_mem, w_kv_mem, w_o_mem,
              g_moe, w_router_group, b_router_group, w_router_expert, b_router_expert,
              w_gate_up, w_down, g_final):
    cos, sin = rope_tables(positions)
    for l in range(DEPTH):
        h = rmsnorm(x, g_mix[l])
        proj = h @ w_in[l]
        c_q, c_kv, k_rope_raw, bcx, gate_logits = jnp.split(
            proj, [COL_CQ, COL_CKV, COL_KROPE, COL_CONV], axis=-1)
        attn = mla_attention(c_q, c_kv, k_rope_raw, cos, sin, g_cq[l], w_uq[l], g_ckv[l], w_ukv[l])
        conv = gated_short_conv(bcx, conv_w[l])
        gates = jax.nn.sigmoid((gate_logits + b_gate[l]).astype(jnp.float32)).astype(x.dtype)
        g_a, g_b = jnp.split(gates, N_BRANCHES, axis=-1)
        mixed = g_a * (attn @ w_branch_a[l]) + g_b * (conv @ w_branch_b[l])
        x = x + mixed @ w_out[l]
        x = x + memory_cross_attention(rmsnorm(x, g_xattn[l]), rmsnorm(mem, g_mem[l]),
                                       w_q_mem[l], w_kv_mem[l], w_o_mem[l])
        x = x + hierarchical_moe(rmsnorm(x, g_moe[l]), w_router_group[l], b_router_group[l],
                                 w_router_expert[l], b_router_expert[l], w_gate_up[l], w_down[l])
    return rmsnorm(x, g_final)
```

```cpp
#include <hip/hip_runtime.h>
#include <cstdint>
#include <cstdio>

constexpr int D = 1024, BATCH = 8, SEQ = 2048, M = BATCH * SEQ, MEM = 256, MM = BATCH * MEM;
constexpr int NH = 8, DN = 64, DR = 32, DV = 64, QL = 256, KVL = 128, DQK = DN + DR;
constexpr int CW = 512;
constexpr int XH = 4, XD = 128;
constexpr int NG = 8, EPG = 8, NE = 64, FF = 256;
constexpr int COL_CQ = 256, COL_CKV = 384, COL_KR = 416, COL_CONV = 1952, IN_COLS = 4000;
constexpr float EPS = 1e-6f;
constexpr int PMAX = M * 2 + NE * 64;
constexpr int NTILES = PMAX / 64;

__global__ __launch_bounds__(256) void k_gemm(const float* __restrict__ A, int lda, const float* __restrict__ B, int ldb, float* __restrict__ C, int ldc,
                                              int Mr, int N, int K, const int* __restrict__ rowidx, const int* __restrict__ tile_group, long b_group_stride) {
    __shared__ float As[16][65];
    __shared__ float Bs[16][64];
    const int tx = threadIdx.x & 15, ty = threadIdx.x >> 4;
    const int m0 = blockIdx.y * 64, n0 = blockIdx.x * 64;
    const float* Bg = B;
    if (tile_group) { const int g = tile_group[blockIdx.y]; if (g < 0) return; Bg = B + (long)g * b_group_stride; }
    float acc[4][4];
#pragma unroll
    for (int i = 0; i < 4; ++i)
#pragma unroll
        for (int j = 0; j < 4; ++j) acc[i][j] = 0.f;
    const int ar = threadIdx.x >> 2, ak = (threadIdx.x & 3) * 4;
    const int arow = m0 + ar; long asrc = -1;
    if (arow < Mr) asrc = rowidx ? (long)rowidx[arow] : (long)arow;
    const int bk = threadIdx.x >> 4, bn = (threadIdx.x & 15) * 4;
    for (int k0 = 0; k0 < K; k0 += 16) {
        float4 av = make_float4(0.f, 0.f, 0.f, 0.f);
        if (asrc >= 0) av = *(const float4*)(A + asrc * lda + k0 + ak);
        As[ak + 0][ar] = av.x; As[ak + 1][ar] = av.y; As[ak + 2][ar] = av.z; As[ak + 3][ar] = av.w;
#pragma unroll
        for (int j = 0; j < 4; ++j) { const int n = n0 + bn + j; Bs[bk][bn + j] = (n < N) ? Bg[(long)(k0 + bk) * ldb + n] : 0.f; }
        __syncthreads();
#pragma unroll
        for (int kk = 0; kk < 16; ++kk) {
            float a0 = As[kk][ty * 4 + 0], a1 = As[kk][ty * 4 + 1], a2 = As[kk][ty * 4 + 2], a3 = As[kk][ty * 4 + 3];
            float b0 = Bs[kk][tx * 4 + 0], b1 = Bs[kk][tx * 4 + 1], b2 = Bs[kk][tx * 4 + 2], b3 = Bs[kk][tx * 4 + 3];
            acc[0][0] += a0 * b0; acc[0][1] += a0 * b1; acc[0][2] += a0 * b2; acc[0][3] += a0 * b3;
            acc[1][0] += a1 * b0; acc[1][1] += a1 * b1; acc[1][2] += a1 * b2; acc[1][3] += a1 * b3;
            acc[2][0] += a2 * b0; acc[2][1] += a2 * b1; acc[2][2] += a2 * b2; acc[2][3] += a2 * b3;
            acc[3][0] += a3 * b0; acc[3][1] += a3 * b1; acc[3][2] += a3 * b2; acc[3][3] += a3 * b3;
        }
        __syncthreads();
    }
#pragma unroll
    for (int i = 0; i < 4; ++i) { const int r = m0 + ty * 4 + i; if (r >= Mr) continue;
#pragma unroll
        for (int j = 0; j < 4; ++j) { const int c = n0 + tx * 4 + j; if (c < N) C[(long)r * ldc + c] = acc[i][j]; } }
}

__device__ __forceinline__ float wave_sum(float v) {
#pragma unroll
    for (int o = 1; o < 64; o <<= 1) v += __shfl_xor(v, o);
    return v;
}
__global__ __launch_bounds__(64) void k_rmsnorm(const float* __restrict__ in, int ldi, const float* __restrict__ g, float* __restrict__ out, int ldo, int cols) {
    const long r = blockIdx.x; const int lane = threadIdx.x;
    float s = 0.f;
    for (int c = lane; c < cols; c += 64) { const float v = in[r * ldi + c]; s += v * v; }
    s = wave_sum(s);
    const float rs = 1.0f / sqrtf(s / (float)cols + EPS);
    for (int c = lane; c < cols; c += 64) out[r * ldo + c] = in[r * ldi + c] * rs * g[c];
}
__global__ void k_rope_table(const int* __restrict__ pos, float* __restrict__ cs, float* __restrict__ sn) {
    const int i = blockIdx.x * blockDim.x + threadIdx.x; if (i >= M * 16) return;
    const int m = i >> 4, j = i & 15;
    const float inv = powf(10000.0f, -(float)(2 * j) / 32.0f);
    const float ang = (float)pos[m] * inv;
    cs[i] = cosf(ang); sn[i] = sinf(ang);
}
__global__ void k_post_proj(const float* __restrict__ proj, const float* __restrict__ cs, const float* __restrict__ sn, float* __restrict__ KR, float* __restrict__ U) {
    const long m = blockIdx.x; const int t = threadIdx.x;
    const float* p = proj + m * IN_COLS;
    if (t < 16) { const float x1 = p[COL_CKV + t], x2 = p[COL_CKV + 16 + t], c = cs[m * 16 + t], s = sn[m * 16 + t];
        KR[m * 32 + t] = x1 * c - x2 * s; KR[m * 32 + 16 + t] = x1 * s + x2 * c; }
    U[m * CW + t] = p[COL_KR + CW + t] * p[COL_KR + 2 * CW + t];
}
__global__ void k_rope_q(float* __restrict__ Q, const float* __restrict__ cs, const float* __restrict__ sn) {
    const int i = blockIdx.x * blockDim.x + threadIdx.x; if (i >= M * NH * 16) return;
    const int j = i & 15, h = (i >> 4) & 7; const long m = i >> 7;
    float* q = Q + m * (NH * DQK) + h * DQK + DN;
    const float x1 = q[j], x2 = q[16 + j], c = cs[m * 16 + j], s = sn[m * 16 + j];
    q[j] = x1 * c - x2 * s; q[16 + j] = x1 * s + x2 * c;
}
__global__ __launch_bounds__(64) void k_mla_attn(const float* __restrict__ Q, const float* __restrict__ KV, const float* __restrict__ KR, float* __restrict__ O) {
    const int h = blockIdx.y; const long m = (long)blockIdx.x * 64 + threadIdx.x; const int b = (int)(m / SEQ), s = (int)(m % SEQ);
    const int smax = (int)(((long)blockIdx.x * 64) % SEQ) + 63;
    float q[DQK], o[DV];
#pragma unroll
    for (int d = 0; d < DQK; ++d) q[d] = Q[m * (NH * DQK) + h * DQK + d];
#pragma unroll
    for (int d = 0; d < DV; ++d) o[d] = 0.f;
    float mr = -1e30f, l = 0.f; const float scale = 1.0f / sqrtf((float)DQK);
    for (int j = 0; j <= smax; ++j) {
        const long mk = (long)b * SEQ + j;
        const float* kn = KV + mk * (NH * 128) + h * 128; const float* kr = KR + mk * 32;
        float sc = 0.f;
#pragma unroll
        for (int d = 0; d < DN; ++d) sc += q[d] * kn[d];
#pragma unroll
        for (int d = 0; d < DR; ++d) sc += q[DN + d] * kr[d];
        sc *= scale;
        if (j <= s) {
            const float mn = fmaxf(mr, sc), al = expf(mr - mn), p = expf(sc - mn);
            l = l * al + p;
#pragma unroll
            for (int d = 0; d < DV; ++d) o[d] = o[d] * al + p * kn[DN + d];
            mr = mn;
        }
    }
    const float il = 1.0f / l;
#pragma unroll
    for (int d = 0; d < DV; ++d) O[m * (NH * DV) + h * DV + d] = o[d] * il;
}
__global__ void k_conv(const float* __restrict__ proj, const float* __restrict__ U, const float* __restrict__ cw, float* __restrict__ CONV) {
    const long m = blockIdx.x; const int c = threadIdx.x; const int s = (int)(m % SEQ);
    float y = cw[2 * CW + c] * U[m * CW + c];
    if (s >= 1) y += cw[1 * CW + c] * U[(m - 1) * CW + c];
    if (s >= 2) y += cw[0 * CW + c] * U[(m - 2) * CW + c];
    CONV[m * CW + c] = proj[m * IN_COLS + COL_KR + c] * y;
}
__global__ void k_mix(const float* __restrict__ proj, const float* __restrict__ bg, float* __restrict__ BA, const float* __restrict__ BB) {
    const long i = (long)blockIdx.x * blockDim.x + threadIdx.x; const long m = i >> 10; const int c = (int)(i & 1023);
    const float la = proj[m * IN_COLS + COL_CONV + c] + bg[c], lb = proj[m * IN_COLS + COL_CONV + D + c] + bg[D + c];
    const float ga = 1.0f / (1.0f + expf(-la)), gb = 1.0f / (1.0f + expf(-lb));
    BA[i] = ga * BA[i] + gb * BB[i];
}
__global__ void k_add(const float* __restrict__ a, const float* __restrict__ b, float* __restrict__ o) {
    const long i = (long)blockIdx.x * blockDim.x + threadIdx.x; o[i] = a[i] + b[i];
}
__global__ __launch_bounds__(64) void k_xattn(const float* __restrict__ QM, const float* __restrict__ KVM, float* __restrict__ OM) {
    const int h = blockIdx.y, half = blockIdx.z; const long m = (long)blockIdx.x * 64 + threadIdx.x; const int b = (int)(m / SEQ);
    float q[XD], o[64];
#pragma unroll
    for (int d = 0; d < XD; ++d) q[d] = QM[m * (XH * XD) + h * XD + d];
#pragma unroll
    for (int d = 0; d < 64; ++d) o[d] = 0.f;
    float mr = -1e30f, l = 0.f; const float scale = 1.0f / sqrtf((float)XD);
    for (int j = 0; j < MEM; ++j) {
        const float* k = KVM + ((long)b * MEM + j) * (2 * XH * XD) + h * XD; const float* v = k + XH * XD + half * 64;
        float sc = 0.f;
#pragma unroll
        for (int d = 0; d < XD; ++d) sc += q[d] * k[d];
        sc *= scale;
        const float mn = fmaxf(mr, sc), al = expf(mr - mn), p = expf(sc - mn);
        l = l * al + p;
#pragma unroll
        for (int d = 0; d < 64; ++d) o[d] = o[d] * al + p * v[d];
        mr = mn;
    }
    const float il = 1.0f / l;
#pragma unroll
    for (int d = 0; d < 64; ++d) OM[m * (XH * XD) + h * XD + half * 64 + d] = o[d] * il;
}
__global__ void k_route(const float* __restrict__ GL, const float* __restrict__ EL, const float* __restrict__ brg, const float* __restrict__ bre,
                        int* __restrict__ eid, float* __restrict__ ew, int* __restrict__ counts) {
    const int n = blockIdx.x * blockDim.x + threadIdx.x; if (n >= M) return;
    float gl[NG]; float gm = -1e30f; int gi = 0;
#pragma unroll
    for (int g = 0; g < NG; ++g) { gl[g] = GL[(long)n * NG + g] + brg[g]; if (gl[g] > gm) { gm = gl[g]; gi = g; } }
    float se = 0.f;
#pragma unroll
    for (int g = 0; g < NG; ++g) se += expf(gl[g] - gm);
    const float pg = 1.0f / se;
    float v0 = -1e30f, v1 = -1e30f; int i0 = 0, i1 = 0;
    for (int e = 0; e < EPG; ++e) { const float v = EL[(long)n * NE + gi * EPG + e] + bre[gi * EPG + e];
        if (v > v0) { v1 = v0; i1 = i0; v0 = v; i0 = e; } else if (v > v1) { v1 = v; i1 = e; } }
    const float e1 = expf(v1 - v0), w0 = pg / (1.0f + e1), w1 = pg * e1 / (1.0f + e1);
    eid[2 * n] = gi * EPG + i0; eid[2 * n + 1] = gi * EPG + i1; ew[2 * n] = w0; ew[2 * n + 1] = w1;
    atomicAdd(&counts[gi * EPG + i0], 1); atomicAdd(&counts[gi * EPG + i1], 1);
}
__global__ void k_scan(const int* __restrict__ counts, int* __restrict__ offs, int* __restrict__ cursor, int* __restrict__ tile_group, int* __restrict__ rowidx) {
    __shared__ int so[NE + 1];
    if (threadIdx.x == 0) { int a = 0; for (int e = 0; e < NE; ++e) { so[e] = a; a += (counts[e] + 63) / 64 * 64; } so[NE] = a; }
    __syncthreads();
    if (threadIdx.x < NE) { offs[threadIdx.x] = so[threadIdx.x]; cursor[threadIdx.x] = 0; }
    for (int t = threadIdx.x; t < NTILES; t += blockDim.x) { int g = -1; const int r = t * 64; if (r < so[NE]) { for (int e = 0; e < NE; ++e) if (r >= so[e] && r < so[e + 1]) g = e; } tile_group[t] = g; }
    for (int r = threadIdx.x; r < PMAX; r += blockDim.x) rowidx[r] = -1;
}
__global__ void k_scatter(const int* __restrict__ eid, const int* __restrict__ offs, int* __restrict__ cursor, int* __restrict__ rowidx, int* __restrict__ slot) {
    const int i = blockIdx.x * blockDim.x + threadIdx.x; if (i >= 2 * M) return;
    const int e = eid[i]; const int p = offs[e] + atomicAdd(&cursor[e], 1);
    rowidx[p] = i >> 1; slot[i] = p;
}
__global__ void k_silu(const float* __restrict__ GU, float* __restrict__ HH) {
    const long i = (long)blockIdx.x * blockDim.x + threadIdx.x; const long r = i >> 8; const int c = (int)(i & 255);
    const float g = GU[r * 512 + c], u = GU[r * 512 + 256 + c];
    HH[i] = g / (1.0f + expf(-g)) * u;
}
__global__ __launch_bounds__(64) void k_final(const float* __restrict__ X2, const float* __restrict__ YD, const int* __restrict__ slot, const float* __restrict__ ew,
                                              const float* __restrict__ g, float* __restrict__ out) {
    const long m = blockIdx.x; const int lane = threadIdx.x;
    const long s0 = slot[2 * m], s1 = slot[2 * m + 1]; const float w0 = ew[2 * m], w1 = ew[2 * m + 1];
    float v[16]; float ss = 0.f;
#pragma unroll
    for (int j = 0; j < 16; ++j) { const int c = lane + 64 * j; v[j] = X2[m * D + c] + (w0 * YD[s0 * D + c] + w1 * YD[s1 * D + c]); ss += v[j] * v[j]; }
    ss = wave_sum(ss); const float rs = 1.0f / sqrtf(ss / (float)D + EPS);
#pragma unroll
    for (int j = 0; j < 16; ++j) { const int c = lane + 64 * j; out[m * D + c] = v[j] * rs * g[c]; }
}

static void gemm(hipStream_t st, const float* A, int lda, const float* B, int ldb, float* C, int ldc, int Mr, int N, int K,
                 const int* rowidx = nullptr, const int* tg = nullptr, long gs = 0) {
    dim3 grid((N + 63) / 64, (Mr + 63) / 64);
    hipLaunchKernelGGL(k_gemm, grid, dim3(256), 0, st, A, lda, B, ldb, C, ldc, Mr, N, K, rowidx, tg, gs);
}

extern "C" void kernel_launch(void* const* d_in, const int* in_sizes, int n_in, void* d_out, int out_size, void* d_ws, size_t ws_size, hipStream_t stream) {
    const size_t MiB = 1u << 20;
    if (n_in != 27 || ws_size < 512 * MiB) { fprintf(stderr, "kernel_launch: unexpected n_in %d / ws %zu\n", n_in, ws_size); return; }
    const float* x = (const float*)d_in[0]; const float* mem = (const float*)d_in[1]; const int* pos = (const int*)d_in[2];
    const float* g_mix = (const float*)d_in[3]; const float* w_in = (const float*)d_in[4]; const float* b_gate = (const float*)d_in[5];
    const float* g_cq = (const float*)d_in[6]; const float* w_uq = (const float*)d_in[7]; const float* g_ckv = (const float*)d_in[8]; const float* w_ukv = (const float*)d_in[9];
    const float* conv_w = (const float*)d_in[10]; const float* w_a = (const float*)d_in[11]; const float* w_b = (const float*)d_in[12]; const float* w_out = (const float*)d_in[13];
    const float* g_xattn = (const float*)d_in[14]; const float* g_mem = (const float*)d_in[15]; const float* w_q_mem = (const float*)d_in[16]; const float* w_kv_mem = (const float*)d_in[17];
    const float* w_o_mem = (const float*)d_in[18]; const float* g_moe = (const float*)d_in[19]; const float* w_rg = (const float*)d_in[20]; const float* b_rg = (const float*)d_in[21];
    const float* w_re = (const float*)d_in[22]; const float* b_re = (const float*)d_in[23]; const float* w_gu = (const float*)d_in[24]; const float* w_dn = (const float*)d_in[25];
    const float* g_final = (const float*)d_in[26];
    float* out = (float*)d_out; char* ws = (char*)d_ws;
#define WSF(mib) ((float*)(ws + (size_t)(mib) * MiB))
    float* H = WSF(0); float* PROJ = WSF(64); float* Q = WSF(314); float* KV = WSF(362); float* ATT = WSF(426); float* U = WSF(458);
    float* COS = WSF(490); float* SIN = WSF(491); int* CNT = (int*)WSF(492);
    int* OFFS = CNT + 64; int* CUR = CNT + 128; int* TG = CNT + 256; int* EID = (int*)WSF(493); float* EW = WSF(494); int* SLOT = (int*)WSF(495); int* RIDX = (int*)WSF(496);
    float* CQN = WSF(0); float* CKVN = WSF(16); float* KR = WSF(24);
    hipLaunchKernelGGL(k_rope_table, dim3(M * 16 / 256), dim3(256), 0, stream, pos, COS, SIN);
    hipLaunchKernelGGL(k_rmsnorm, dim3(M), dim3(64), 0, stream, x, D, g_mix, H, D, D);
    gemm(stream, H, D, w_in, IN_COLS, PROJ, IN_COLS, M, IN_COLS, D);
    hipLaunchKernelGGL(k_rmsnorm, dim3(M), dim3(64), 0, stream, PROJ, IN_COLS, g_cq, CQN, QL, QL);
    hipLaunchKernelGGL(k_rmsnorm, dim3(M), dim3(64), 0, stream, PROJ + COL_CQ, IN_COLS, g_ckv, CKVN, KVL, KVL);
    hipLaunchKernelGGL(k_post_proj, dim3(M), dim3(512), 0, stream, PROJ, COS, SIN, KR, U);
    gemm(stream, CQN, QL, w_uq, NH * DQK, Q, NH * DQK, M, NH * DQK, QL);
    hipLaunchKernelGGL(k_rope_q, dim3(M * NH * 16 / 256), dim3(256), 0, stream, Q, COS, SIN);
    gemm(stream, CKVN, KVL, w_ukv, NH * 128, KV, NH * 128, M, NH * 128, KVL);
    hipLaunchKernelGGL(k_mla_attn, dim3(M / 64, NH), dim3(64), 0, stream, Q, KV, KR, ATT);
    float* CONV = WSF(314); float* BA = WSF(346); float* BB = WSF(0);
    hipLaunchKernelGGL(k_conv, dim3(M), dim3(512), 0, stream, PROJ, U, conv_w, CONV);
    gemm(stream, ATT, NH * DV, w_a, D, BA, D, M, D, NH * DV);
    gemm(stream, CONV, CW, w_b, D, BB, D, M, D, CW);
    hipLaunchKernelGGL(k_mix, dim3(M * D / 256), dim3(256), 0, stream, PROJ, b_gate, BA, BB);
    float* T = WSF(0);
    gemm(stream, BA, D, w_out, D, T, D, M, D, D);
    float* X1 = WSF(64);
    hipLaunchKernelGGL(k_add, dim3(M * D / 256), dim3(256), 0, stream, x, T, X1);
    float* H2 = WSF(128); float* MEMN = WSF(192); float* KVM = WSF(200); float* QM = WSF(208); float* OM = WSF(240); float* T2 = WSF(0); float* X2 = WSF(272);
    hipLaunchKernelGGL(k_rmsnorm, dim3(M), dim3(64), 0, stream, X1, D, g_xattn, H2, D, D);
    hipLaunchKernelGGL(k_rmsnorm, dim3(MM), dim3(64), 0, stream, mem, D, g_mem, MEMN, D, D);
    gemm(stream, H2, D, w_q_mem, XH * XD, QM, XH * XD, M, XH * XD, D);
    gemm(stream, MEMN, D, w_kv_mem, 2 * XH * XD, KVM, 2 * XH * XD, MM, 2 * XH * XD, D);
    hipLaunchKernelGGL(k_xattn, dim3(M / 64, XH, 2), dim3(64), 0, stream, QM, KVM, OM);
    gemm(stream, OM, XH * XD, w_o_mem, D, T2, D, M, D, XH * XD);
    hipLaunchKernelGGL(k_add, dim3(M * D / 256), dim3(256), 0, stream, X1, T2, X2);
    float* H3 = WSF(192); float* GL = WSF(256); float* EL = WSF(257); float* GU = WSF(336); float* HH = WSF(408); float* YD = WSF(0);
    hipLaunchKernelGGL(k_rmsnorm, dim3(M), dim3(64), 0, stream, X2, D, g_moe, H3, D, D);
    gemm(stream, H3, D, w_rg, NG, GL, NG, M, NG, D);
    gemm(stream, H3, D, w_re, NE, EL, NE, M, NE, D);
    hipMemsetAsync(CNT, 0, 64 * sizeof(int), stream);
    hipLaunchKernelGGL(k_route, dim3(M / 256), dim3(256), 0, stream, GL, EL, b_rg, b_re, EID, EW, CNT);
    hipLaunchKernelGGL(k_scan, dim3(1), dim3(1024), 0, stream, CNT, OFFS, CUR, TG, RIDX);
    hipLaunchKernelGGL(k_scatter, dim3(2 * M / 256), dim3(256), 0, stream, EID, OFFS, CUR, RIDX, SLOT);
    gemm(stream, H3, D, w_gu, 2 * FF, GU, 2 * FF, PMAX, 2 * FF, D, RIDX, TG, (long)D * 2 * FF);
    hipLaunchKernelGGL(k_silu, dim3(PMAX * FF / 256), dim3(256), 0, stream, GU, HH);
    gemm(stream, HH, FF, w_dn, D, YD, D, PMAX, D, FF, nullptr, TG, (long)FF * D);
    hipLaunchKernelGGL(k_final, dim3(M), dim3(64), 0, stream, X2, YD, SLOT, EW, g_final, out);
}
```

```cpp
#define MODE 0
#define PER_PHASE 0
#include <hip/hip_runtime.h>
#include <cstdio>
#include <cstdint>
#include <cmath>
#ifndef MODE
#define MODE 0
#endif
#ifndef PER_PHASE
#define PER_PHASE 0
#endif
namespace pg8 {
#define PG8_LAS __attribute__((address_space(3)))
typedef unsigned short bf16_t;
typedef short bf16x8 __attribute__((ext_vector_type(8)));
typedef float f32x4 __attribute__((ext_vector_type(4)));
typedef unsigned u32x4 __attribute__((ext_vector_type(4)));
typedef unsigned u32x2 __attribute__((ext_vector_type(2)));
constexpr int BM = 256, BK = 64, HALF = 128, HTB = HALF * BK * 2  , STAGE_BYTES = 8 * HTB, NXCD = 8, WGM = 8;

__host__ __device__ __forceinline__ int lds_byte(int r, int c) { const int st = (r >> 4) * 2 + (c >> 5), rr = r & 15, cc = c & 31, ob = rr * 64 + cc * 2; return st * 1024 + (ob ^ (((ob >> 9) & 1) << 5)); }
__host__ __device__ __forceinline__ void stage_rc(int b, int& R, int& C) { const int st = b / 1024, sb = b % 1024, swz = sb ^ (((sb >> 9) & 1) << 5); R = (st >> 1) * 16 + swz / 64; C = (st & 1) * 32 + (swz % 64) / 2; }
__host__ __device__ __forceinline__ int perm32(int rho) { const int n = rho >> 4, i = rho & 15; return 8 * (i >> 2) + 4 * n + (i & 3); }

struct Unit { int pm, pn, sel, half; };
struct Gemm { const bf16_t* A; const bf16_t* Bt; int M, N, K; const bf16_t* A2 = nullptr; const bf16_t* Bt2 = nullptr; int ld = 0; };

struct StaticOrder {
    static constexpr bool HOOKS = false;
    int nM, nN, nwg, G, c, rot;
    __host__ __device__ void init(int M, int N, int G_, int c_, int rot_ = 0) { nM = M / BM; nN = N / BM; nwg = nM * nN; G = G_; c = c_; rot = rot_; }
    __host__ __device__ __forceinline__ bool next(int i, Unit& u) const {
        const long L = (long)i * G + c; if (L >= nwg) return false;
        int wgid = (int)L; { const int q = nwg / NXCD, r = nwg % NXCD, xcd = wgid % NXCD, off = wgid / NXCD; wgid = (xcd < r ? xcd * (q + 1) : r * (q + 1) + (xcd - r) * q) + off; }
        const int nig = WGM * nN, gid = wgid / nig, fm = gid * WGM, gsz = (nM - fm) < WGM ? (nM - fm) : WGM;
        u.pm = fm + ((wgid % nig) % gsz); u.pn = ((wgid % nig) / gsz + rot) % nN; u.sel = 0; u.half = 0; return true;
    }
};
struct PairOrder {
    static constexpr bool HOOKS = false;
    int pm, pn;
    __device__ __forceinline__ bool next(int i, Unit& u) const { if (i >= 2) return false; u.pm = pm; u.pn = pn; u.sel = i; u.half = 0; return true; }
};
struct PanelOrder {
    static constexpr bool HOOKS = false;
    int pm, nN, n0 = 0;
    __device__ __forceinline__ bool next(int i, Unit& u) const { if (i >= nN) return false; u.pm = pm; u.pn = n0 + i; u.sel = 0; u.half = 0; return true; }
};
template <int NT> struct TileOrder {
    static constexpr bool HOOKS = false;
    int tile, e;
    __device__ __forceinline__ bool next(int i, Unit& u) const { if (i >= NT) return false; u.pm = tile; u.pn = e * NT + i; u.sel = 0; u.half = 0; return true; }
};
#define MOE_RLX __ATOMIC_RELAXED, __HIP_MEMORY_SCOPE_AGENT
struct MoeUpOrder {
    static constexpr bool HOOKS = true;
    int ntiles, G, c; const PG8_LAS int* texp; const PG8_LAS int* tord; unsigned* ready;
    __device__ __forceinline__ bool next(int i, Unit& u) const {
        const int L = i * G + c; if (L >= ntiles * 2) return false;
        const int to = __builtin_amdgcn_readfirstlane(tord[L >> 1]), tile = to & 0xffff; u.pm = tile; u.pn = __builtin_amdgcn_readfirstlane(texp[tile]) * 2 + (L & 1); u.sel = 0; u.half = to >> 30; return true;
    }
    __device__ __forceinline__ void a_ready(const Unit&) const {}
    __device__ __forceinline__ void done(const Unit& u) const {
        asm volatile("s_waitcnt vmcnt(0)" ::: "memory");
        if ((threadIdx.x & 63) == 0) (void)__hip_atomic_fetch_add(ready + 64 * u.pm, 1u, MOE_RLX);
    }
};
struct MoeDownOrder {
    static constexpr bool HOOKS = true;
    int ntiles, G, c; const PG8_LAS int* texp; const PG8_LAS int* tord; const unsigned* ready; unsigned* tmo;
    __device__ __forceinline__ bool next(int i, Unit& u) const {
        const int total = 4 * ntiles, R2 = (2 * ntiles > G) ? 2 * ntiles - G : 0, n1 = G - R2;
        int p;
        if (c >= R2) { if (i >= 3) return false; p = (c - R2) + i * n1; if (p >= 3 * n1) return false; }
        else p = 3 * n1 + c + i * R2;
        if (p >= total) return false;
        const int to = __builtin_amdgcn_readfirstlane(tord[p >> 2]), tile = to & 0xffff; u.pm = tile; u.pn = __builtin_amdgcn_readfirstlane(texp[tile]) * 4 + (p & 3); u.sel = 0; u.half = to >> 30; return true;
    }
    __device__ __forceinline__ void a_ready(const Unit& u) const {
        if (threadIdx.x < 64) {
            unsigned sp = 0;
            while ((unsigned)__builtin_amdgcn_readfirstlane(__hip_atomic_load(ready + 64 * u.pm, MOE_RLX)) < 16u) {
                __builtin_amdgcn_s_sleep(2);
                if ((++sp & 255u) == 0u) { if (__builtin_amdgcn_readfirstlane(__hip_atomic_load(tmo, MOE_RLX)) != 0u) break; if (sp > (1u << 18)) { if (threadIdx.x == 0) __hip_atomic_store(tmo, 1u, MOE_RLX); break; } }
            }
            __builtin_amdgcn_fence(__ATOMIC_ACQUIRE, "agent");
            asm volatile("s_waitcnt vmcnt(0)" ::: "memory");
        }
        asm volatile("" ::: "memory"); __builtin_amdgcn_s_barrier(); asm volatile("" ::: "memory");
    }
    __device__ __forceinline__ void done(const Unit&) const {}
};

typedef float f32x2_t __attribute__((ext_vector_type(2))); typedef __bf16 bf16x2_t __attribute__((ext_vector_type(2)));
__device__ __forceinline__ unsigned cvt_pk_bf16(float lo, float hi) { f32x2_t v = {lo, hi}; bf16x2_t b = __builtin_convertvector(v, bf16x2_t); return __builtin_bit_cast(unsigned, b); }
__device__ __forceinline__ u32x4 pack8(const f32x4 a, const f32x4 b) { u32x4 w; w.x = cvt_pk_bf16(a[0], a[1]); w.y = cvt_pk_bf16(a[2], a[3]); w.z = cvt_pk_bf16(b[0], b[1]); w.w = cvt_pk_bf16(b[2], b[3]); return w; }
__device__ __forceinline__ float bf_lo(unsigned w) { return __uint_as_float(w << 16); }
__device__ __forceinline__ float bf_hi(unsigned w) { return __uint_as_float(w & 0xffff0000u); }
__device__ __forceinline__ void unpack8(const u32x4 w, f32x4& a, f32x4& b) { a = (f32x4){bf_lo(w.x), bf_hi(w.x), bf_lo(w.y), bf_hi(w.y)}; b = (f32x4){bf_lo(w.z), bf_hi(w.z), bf_lo(w.w), bf_hi(w.w)}; }

typedef int v4i_t __attribute__((ext_vector_type(4))); typedef int v8i_t __attribute__((ext_vector_type(8)));
__device__ __forceinline__ v8i_t cat16(const bf16x8 a, const bf16x8 b) { const v4i_t x = __builtin_bit_cast(v4i_t, a), y = __builtin_bit_cast(v4i_t, b); return __builtin_shufflevector(x, y, 0, 1, 2, 3, 4, 5, 6, 7); }
template <class Epi, class Sched, bool ALIGN_EPI, bool GATHER = false, bool FP8 = false, bool HALFN = FP8>
__device__ __forceinline__ void gemm_phase(PG8_LAS unsigned char* lds, const Gemm g, const Sched& S, const Epi& E, const PG8_LAS int* gtab = nullptr) {
    const int tid = threadIdx.x, wid = __builtin_amdgcn_readfirstlane(tid >> 6), lane = tid & 63, wr = wid >> 2, wc = wid & 3, fr = lane & 15, fq = lane >> 4;
    int K = g.K; asm volatile("" : "+s"(K));
    const int nt = K / BK; int LD = g.ld ? g.ld : g.K; asm volatile("" : "+s"(LD));
    unsigned voffB[2], vc[2][2], vn[2][2]; int RA[2], CA[2];
#pragma unroll
    for (int i = 0; i < 2; ++i) { int R, C; stage_rc(tid * 16 + i * 8192, R, C); const int Rb = Epi::PERM ? ((R & ~31) + perm32(R & 31)) : R;
        RA[i] = R; CA[i] = C; voffB[i] = (unsigned)(Rb * LD + C) * 2u;
#pragma unroll
        for (int h = 0; h < 2; ++h) { vc[h][i] = (unsigned)((h * HALF + R) * LD + C) * 2u; vn[h][i] = vc[h][i]; } }
    const size_t kstep = (size_t)(BK * 2);
    const size_t hstep = (size_t)HALF * LD * 2;
    const size_t tstep = 2 * hstep;
    const size_t bh = FP8 ? 0 : hstep, bts = FP8 ? hstep : tstep;
    const unsigned ldsw = (unsigned)wid * 1024u;
    const int aoff = lds_byte(wr * 64 + fr, fq * 8), boff = lds_byte(wc * 32 + fr, fq * 8);
#define PG8_SA(b, h) (((b) * 2 + (h)) * HTB)
#define PG8_SB(b, h) ((4 + (b) * 2 + (h)) * HTB)
#define PG8_STAGE_B(bufoff, gbase) do { _Pragma("unroll") for (int _i = 0; _i < 2; ++_i) \
        __builtin_amdgcn_global_load_lds((const unsigned*)((const char*)(gbase) + voffB[_i]), (PG8_LAS unsigned*)(lds + (bufoff) + ldsw + _i * 8192), 16, 0, 0); } while (0)
#define PG8_STAGE_A(bufoff, gbase, VO, h) do { _Pragma("unroll") for (int _i = 0; _i < 2; ++_i) \
        __builtin_amdgcn_global_load_lds((const unsigned*)((const char*)(gbase) + (VO)[h][_i]), (PG8_LAS unsigned*)(lds + (bufoff) + ldsw + _i * 8192), 16, 0, 0); } while (0)
#define PG8_LD8(p) __builtin_shufflevector(*(const PG8_LAS v4i_t*)(p), *(const PG8_LAS v4i_t*)((p) + 1024), 0, 1, 2, 3, 4, 5, 6, 7)
#define PG8_LDA(dst, b, h) do { if constexpr (FP8) { _Pragma("unroll") for (int m = 0; m < 4; ++m) dst##8[m] = PG8_LD8(lds + PG8_SA(b, h) + aoff + m * 2048); } \
        else { _Pragma("unroll") for (int m = 0; m < 4; ++m) _Pragma("unroll") for (int k = 0; k < 2; ++k) dst[m][k] = *(const PG8_LAS bf16x8*)(lds + PG8_SA(b, h) + aoff + m * 2048 + k * 1024); } } while (0)
#define PG8_LDB(dst, b, h) do { if constexpr (FP8) { _Pragma("unroll") for (int n = 0; n < 2; ++n) dst##8[n] = PG8_LD8(lds + PG8_SB(b, h) + boff + n * 2048); } \
        else { _Pragma("unroll") for (int n = 0; n < 2; ++n) _Pragma("unroll") for (int k = 0; k < 2; ++k) dst[n][k] = *(const PG8_LAS bf16x8*)(lds + PG8_SB(b, h) + boff + n * 2048 + k * 1024); } } while (0)
#define PG8_MMA(ai, bj, At, Bt) do { __builtin_amdgcn_s_setprio(1); \
        if constexpr (FP8) { _Pragma("unroll") for (int m = 0; m < 4; ++m) _Pragma("unroll") for (int n = 0; n < 2; ++n) \
            acc[ai][bj][m][n] = __builtin_amdgcn_mfma_scale_f32_16x16x128_f8f6f4(Bt##8[n], At##8[m], acc[ai][bj][m][n], 0, 0, 0, 127, 0, 127); } \
        else { _Pragma("unroll") for (int m = 0; m < 4; ++m) _Pragma("unroll") for (int n = 0; n < 2; ++n) _Pragma("unroll") for (int k = 0; k < 2; ++k) \
            acc[ai][bj][m][n] = __builtin_amdgcn_mfma_f32_16x16x32_bf16(Bt[n][k], At[m][k], acc[ai][bj][m][n], 0, 0, 0); } \
        __builtin_amdgcn_s_setprio(0); } while (0)
#define PG8_WAIT_V(n) asm volatile("s_waitcnt vmcnt(" #n ")" ::: "memory")
#define PG8_WAIT_L(n) asm volatile("s_waitcnt lgkmcnt(" #n ")" ::: "memory")
#define PG8_BAR __builtin_amdgcn_s_barrier()
#define PG8_SCHED __builtin_amdgcn_sched_barrier(0)
#define PG8_GTAB(VX, u) do { _Pragma("unroll") for (int _h = 0; _h < 2; ++_h) _Pragma("unroll") for (int _i = 0; _i < 2; ++_i) \
        VX[_h][_i] = (unsigned)gtab[(u) * 256 + _h * HALF + RA[_i]] * (unsigned)(LD * 2) + (unsigned)(CA[_i] * 2); } while (0)
    Unit cur, nxt; int ui = 0;
    if (!S.next(0, cur)) return;
    if constexpr (Sched::HOOKS) S.a_ready(cur);
    if constexpr (GATHER) { PG8_GTAB(vc, 0); }
    f32x4 acc[2][2][4][2];
#pragma unroll
    for (int a = 0; a < 2; ++a)
#pragma unroll
        for (int b = 0; b < 2; ++b)
#pragma unroll
            for (int m = 0; m < 4; ++m)
#pragma unroll
                for (int n = 0; n < 2; ++n) acc[a][b][m][n] = (f32x4){0.f, 0.f, 0.f, 0.f};
    bf16x8 At[4][2], B0[2][2], B1[2][2]; v8i_t At8[4], B08[2], B18[2];
    const char* cA = GATHER ? (const char*)g.A : (const char*)(cur.sel ? g.A2 : g.A) + (size_t)cur.pm * tstep; const char* cB = (const char*)(cur.sel ? g.Bt2 : g.Bt) + (size_t)cur.pn * bts;
    PG8_STAGE_B(PG8_SB(0, 0), cB); PG8_STAGE_B(PG8_SB(0, 1), cB + bh); PG8_STAGE_A(PG8_SA(0, 0), cA, vc, 0); PG8_STAGE_A(PG8_SA(0, 1), cA, vc, 1);
    if (wr == 1) PG8_BAR;
    PG8_WAIT_V(2); PG8_BAR;
    PG8_STAGE_B(PG8_SB(1, 0), cB + kstep); PG8_STAGE_A(PG8_SA(1, 0), cA + kstep, vc, 0); PG8_STAGE_B(PG8_SB(1, 1), cB + bh + kstep);
    PG8_WAIT_V(6); PG8_BAR;
#pragma nounroll
    for (;;) {
        const bool has_next = S.next(ui + 1, nxt);
        const char* nA = GATHER ? (const char*)g.A : (has_next ? (const char*)(nxt.sel ? g.A2 : g.A) + (size_t)nxt.pm * tstep : cA); const char* nB = has_next ? (const char*)(nxt.sel ? g.Bt2 : g.Bt) + (size_t)nxt.pn * bts : cB;
        if constexpr (GATHER) { if (has_next) { PG8_GTAB(vn, ui + 1); } else {
#pragma unroll
            for (int h = 0; h < 2; ++h)
#pragma unroll
                for (int i = 0; i < 2; ++i) vn[h][i] = vc[h][i]; } }
#pragma nounroll
        for (int t = 0; t < nt; t += 2) {
            const bool last = (t == nt - 2);
            const char* a1 = cA + (size_t)(t + 1) * kstep;
            const char* a2 = last ? nA : cA + (size_t)(t + 2) * kstep; const char* b2 = last ? nB : cB + (size_t)(t + 2) * kstep;
            const char* a3 = a2 + kstep; const char* b3 = b2 + kstep;
            if constexpr (Sched::HOOKS) { if (last && has_next) S.a_ready(nxt); }
            unsigned v2[2][2];
#pragma unroll
            for (int h = 0; h < 2; ++h)
#pragma unroll
                for (int i = 0; i < 2; ++i) v2[h][i] = (GATHER && last) ? vn[h][i] : vc[h][i];
            PG8_LDB(B0, 0, 0); if constexpr (!HALFN) PG8_LDB(B1, 0, 1); PG8_SCHED; PG8_LDA(At, 0, 0); PG8_STAGE_A(PG8_SA(1, 1), a1, vc, 1);
            PG8_WAIT_V(8); PG8_WAIT_L(0); PG8_BAR; PG8_MMA(0, 0, At, B0); if constexpr (!HALFN) PG8_MMA(0, 1, At, B1); PG8_BAR; PG8_SCHED;
            PG8_LDA(At, 0, 1); PG8_STAGE_B(PG8_SB(0, 0), b2); PG8_STAGE_B(PG8_SB(0, 1), b2 + bh); PG8_STAGE_A(PG8_SA(0, 0), a2, v2, 0);
            PG8_WAIT_V(8); PG8_WAIT_L(0); PG8_BAR; PG8_MMA(1, 0, At, B0); if constexpr (!HALFN) PG8_MMA(1, 1, At, B1); PG8_BAR; PG8_SCHED;
            PG8_LDB(B0, 1, 0); if constexpr (!HALFN) PG8_LDB(B1, 1, 1); PG8_SCHED; PG8_LDA(At, 1, 0); PG8_STAGE_A(PG8_SA(0, 1), a2, v2, 1);
            PG8_WAIT_V(8); PG8_WAIT_L(0); PG8_BAR; PG8_MMA(0, 0, At, B0); if constexpr (!HALFN) PG8_MMA(0, 1, At, B1); PG8_BAR; PG8_SCHED;
            PG8_LDA(At, 1, 1); PG8_STAGE_B(PG8_SB(1, 0), b3); PG8_STAGE_B(PG8_SB(1, 1), b3 + bh); PG8_STAGE_A(PG8_SA(1, 0), a3, v2, 0);
            PG8_WAIT_V(8); PG8_WAIT_L(0); PG8_BAR; PG8_MMA(1, 0, At, B0); if constexpr (!HALFN) PG8_MMA(1, 1, At, B1); PG8_BAR; PG8_SCHED;
        }
        if constexpr (ALIGN_EPI) { if (wr == 0) PG8_BAR; }
        { int fr_e = fr, fq_e = fq; asm volatile("" : "+v"(fr_e), "+v"(fq_e));
          E(acc, cur, wr, wc, fr_e, fq_e); }
        if constexpr (Sched::HOOKS) S.done(cur);
        if (!has_next) break;
#pragma unroll
        for (int a = 0; a < 2; ++a)
#pragma unroll
            for (int b = 0; b < 2; ++b)
#pragma unroll
                for (int m = 0; m < 4; ++m)
#pragma unroll
                    for (int n = 0; n < 2; ++n) acc[a][b][m][n] = (f32x4){0.f, 0.f, 0.f, 0.f};
        cur = nxt; cA = nA; cB = nB; ++ui;
        if constexpr (GATHER) {
#pragma unroll
            for (int h = 0; h < 2; ++h)
#pragma unroll
                for (int i = 0; i < 2; ++i) vc[h][i] = vn[h][i]; }
        if constexpr (ALIGN_EPI) { if (wr == 1) PG8_BAR; }
    }
    PG8_WAIT_V(0);
    if constexpr (!ALIGN_EPI) { if (wr == 0) PG8_BAR; }
    PG8_BAR;
#undef PG8_SA
#undef PG8_SB
#undef PG8_STAGE_A
#undef PG8_STAGE_B
#undef PG8_LDA
#undef PG8_LD8
#undef PG8_LDB
#undef PG8_MMA
#undef PG8_WAIT_V
#undef PG8_WAIT_L
#undef PG8_BAR
#undef PG8_SCHED
#undef PG8_GTAB
}
constexpr float RMS_EPS = 1e-6f;
__device__ __forceinline__ void store16_wt(void* p, const u32x4 v) { asm volatile("global_store_dwordx4 %0, %1, off sc1\n\ts_nop 1" :: "v"(p), "v"(v) : "memory"); }
typedef unsigned long long ssq_t;
constexpr float SSQ_SCALE = 1048576.0f, SSQ_INV = 1.0f / 1048576.0f;
__device__ __forceinline__ void ssq_add(ssq_t* p, float ss) { atomicAdd(p, (ssq_t)(ss * SSQ_SCALE + 0.5f)); }
__device__ __forceinline__ float ssq_get(const ssq_t* p) { return (float)(*p) * SSQ_INV; }
__device__ __forceinline__ float quad_sum(float s) { s += __shfl_xor(s, 16); s += __shfl_xor(s, 32); return s; }
__device__ __forceinline__ float dot4(const f32x4 v) { return (v[0] * v[0] + v[1] * v[1]) + (v[2] * v[2] + v[3] * v[3]); }
__device__ __forceinline__ float fast_sigmoid(float x) { return __builtin_amdgcn_rcpf(1.0f + __expf(-x)); }
__device__ __forceinline__ f32x4 sig4(const f32x4 v) { return (f32x4){fast_sigmoid(v[0]), fast_sigmoid(v[1]), fast_sigmoid(v[2]), fast_sigmoid(v[3])}; }
#define EPI_ROWS(...) _Pragma("unroll") for (int ai = 0; ai < 2; ++ai) _Pragma("unroll") for (int m = 0; m < 4; ++m) { const int rt = ai * HALF + wr * 64 + m * 16 + fr; const size_t r = (size_t)u.pm * BM + rt; (void)r; __VA_ARGS__ if (m == 3) asm volatile("" ::: "memory"); }

struct EpiInProj { static constexpr bool PERM = true;
    bf16_t *CQ, *CKV, *KR, *BG, *U, *G; ssq_t *SSQQ, *SSQKV; const float *COS, *SIN, *bgate; bool do_ssq; int pn_off; float gsc;
    __device__ __forceinline__ void operator()(const f32x4 (&acc)[2][2][4][2], const Unit& u, int wr, int wc, int fr, int fq) const {
        const int pn = u.pn + pn_off, cw = wc * 32 + 8 * fq;
        if (pn == 0) {
            EPI_ROWS( float ss = 0.f;
                _Pragma("unroll") for (int bj = 0; bj < 2; ++bj) { const f32x4 v0 = acc[ai][bj][m][0], v1 = acc[ai][bj][m][1]; ss += dot4(v0) + dot4(v1);
                    *(u32x4*)(CQ + r * 256 + bj * HALF + cw) = pack8(v0, v1); }
                ss = quad_sum(ss); if (fq == 0 && do_ssq) ssq_add(SSQQ + r, ss); )
        } else if (pn == 1) {
            EPI_ROWS( { const f32x4 v0 = acc[ai][0][m][0], v1 = acc[ai][0][m][1]; float ss = dot4(v0) + dot4(v1);
                    *(u32x4*)(CKV + r * 128 + cw) = pack8(v0, v1); ss = quad_sum(ss); if (fq == 0 && do_ssq) ssq_add(SSQKV + r, ss); }
                if (wc == 0) { const f32x4 x1 = acc[ai][1][m][0], x2 = acc[ai][1][m][1]; const f32x4 c = *(const f32x4*)(COS + r * 16 + 4 * fq), s = *(const f32x4*)(SIN + r * 16 + 4 * fq);
                    *(u32x4*)(KR + r * 32 + 8 * fq) = pack8(x1 * c - x2 * s, x1 * s + x2 * c); } )
        } else if (pn < 4) {
            EPI_ROWS( _Pragma("unroll") for (int bj = 0; bj < 2; ++bj) *(u32x4*)(BG + r * 512 + (pn - 2) * 256 + bj * HALF + cw) = pack8(acc[ai][bj][m][0], acc[ai][bj][m][1]); )
        } else if (pn < 8) {
            EPI_ROWS( *(u32x4*)(U + r * 512 + (pn - 4) * 128 + cw) = pack8(acc[ai][0][m][0] * acc[ai][1][m][0], acc[ai][0][m][1] * acc[ai][1][m][1]); )
        } else {
            f32x4 b[2][2];
#pragma unroll
            for (int bj = 0; bj < 2; ++bj)
#pragma unroll
                for (int n = 0; n < 2; ++n) b[bj][n] = *(const f32x4*)(bgate + (pn - 8) * 256 + bj * HALF + cw + 4 * n);
            EPI_ROWS( _Pragma("unroll") for (int bj = 0; bj < 2; ++bj)
                *(u32x4*)(G + r * 2048 + (pn - 8) * 256 + bj * HALF + cw) = pack8(sig4(acc[ai][bj][m][0] * gsc + b[bj][0]), sig4(acc[ai][bj][m][1] * gsc + b[bj][1])); )
        }
    }
};
struct EpiGates { static constexpr bool PERM = true;
    bf16_t* G; const float* bgate; float gsc;
    __device__ __forceinline__ void operator()(const f32x4 (&acc)[2][2][4][2], const Unit& u, int wr, int wc, int fr, int fq) const {
        const int cw = u.pn * 128 + wc * 32 + 8 * fq;
        const f32x4 b0 = *(const f32x4*)(bgate + cw), b1 = *(const f32x4*)(bgate + cw + 4);
        EPI_ROWS( *(u32x4*)(G + r * 2048 + cw) = pack8(sig4(acc[ai][0][m][0] * gsc + b0), sig4(acc[ai][0][m][1] * gsc + b1)); )
    }
};
struct EpiQUp { static constexpr bool PERM = true;
    bf16_t* Q; const ssq_t* SSQQ; const float *COS, *SIN;
    __device__ __forceinline__ void operator()(const f32x4 (&acc)[2][2][4][2], const Unit& u, int wr, int wc, int fr, int fq) const {
        const int pn = u.pn, cw = wc * 32 + 8 * fq;
        EPI_ROWS( const float rs = __builtin_amdgcn_rsqf(ssq_get(SSQQ + r) * (1.0f / 256.0f) + RMS_EPS);
            if (pn < 2) { _Pragma("unroll") for (int bj = 0; bj < 2; ++bj) *(u32x4*)(Q + r * 768 + pn * 256 + bj * HALF + cw) = pack8(acc[ai][bj][m][0] * rs, acc[ai][bj][m][1] * rs); }
            else { const f32x4 c = *(const f32x4*)(COS + r * 16 + 4 * fq), s = *(const f32x4*)(SIN + r * 16 + 4 * fq);
                _Pragma("unroll") for (int bj = 0; bj < 2; ++bj) { const f32x4 x1 = acc[ai][bj][m][0] * rs, x2 = acc[ai][bj][m][1] * rs;
                    *(u32x4*)(Q + r * 768 + 512 + (4 * bj + wc) * 32 + 8 * fq) = pack8(x1 * c - x2 * s, x1 * s + x2 * c); } } )
    }
};
struct EpiKVUp { static constexpr bool PERM = true;
    bf16_t *KN, *V; const ssq_t* SSQKV;
    __device__ __forceinline__ void operator()(const f32x4 (&acc)[2][2][4][2], const Unit& u, int wr, int wc, int fr, int fq) const {
        const int pn = u.pn, cw = wc * 32 + 8 * fq; bf16_t* O = (pn < 2) ? KN + pn * 256 : V + (pn - 2) * 256;
        EPI_ROWS( const float rs = __builtin_amdgcn_rsqf(ssq_get(SSQKV + r) * (1.0f / 128.0f) + RMS_EPS);
            _Pragma("unroll") for (int bj = 0; bj < 2; ++bj) *(u32x4*)(O + r * 512 + bj * HALF + cw) = pack8(acc[ai][bj][m][0] * rs, acc[ai][bj][m][1] * rs); )
    }
};
template <bool SECOND> struct EpiMix { static constexpr bool PERM = true;
    bf16_t* MIX; const bf16_t* G;
    __device__ __forceinline__ void operator()(const f32x4 (&acc)[2][2][4][2], const Unit& u, int wr, int wc, int fr, int fq) const {
        const int cw = u.pn * 256 + wc * 32 + 8 * fq;
        EPI_ROWS( _Pragma("unroll") for (int bj = 0; bj < 2; ++bj) { f32x4 g0, g1; unpack8(*(const u32x4*)(G + r * 2048 + (SECOND ? 1024 : 0) + bj * HALF + cw), g0, g1);
                f32x4 o0 = g0 * acc[ai][bj][m][0], o1 = g1 * acc[ai][bj][m][1];
                if (SECOND) { f32x4 p0, p1; unpack8(*(const u32x4*)(MIX + r * 1024 + bj * HALF + cw), p0, p1); o0 += p0; o1 += p1; }
                *(u32x4*)(MIX + r * 1024 + bj * HALF + cw) = pack8(o0, o1); } )
    }
};
template <typename TR> struct EpiResid { static constexpr bool PERM = false;
    const TR* RES; bf16_t* OB; ssq_t* SSQ; bool do_ssq;
    __device__ __forceinline__ void operator()(const f32x4 (&acc)[2][2][4][2], const Unit& u, int wr, int wc, int fr, int fq) const {
        const int c0 = u.pn * 256 + wc * 32 + 4 * fq;
        EPI_ROWS( float ss = 0.f;
            _Pragma("unroll") for (int bj = 0; bj < 2; ++bj) _Pragma("unroll") for (int n = 0; n < 2; ++n) { const size_t o = r * 1024 + c0 + bj * HALF + n * 16;
                f32x4 x;
                if constexpr (sizeof(TR) == 4) x = *(const f32x4*)(RES + o); else { const u32x2 w = *(const u32x2*)(RES + o); x = (f32x4){bf_lo(w.x), bf_hi(w.x), bf_lo(w.y), bf_hi(w.y)}; }
                x += acc[ai][bj][m][n]; ss += dot4(x);
                u32x2 w2; w2.x = cvt_pk_bf16(x[0], x[1]); w2.y = cvt_pk_bf16(x[2], x[3]); *(u32x2*)(OB + o) = w2; }
            ss = quad_sum(ss); if (fq == 0 && do_ssq) ssq_add(SSQ + r, ss); )
    }
};
struct EpiScaleRows { static constexpr bool PERM = true;
    bf16_t* O; int ldo; const ssq_t* SSQ;
    __device__ __forceinline__ void operator()(const f32x4 (&acc)[2][2][4][2], const Unit& u, int wr, int wc, int fr, int fq) const {
        const int cw = u.pn * 256 + wc * 32 + 8 * fq;
        EPI_ROWS( const float rs = __builtin_amdgcn_rsqf(ssq_get(SSQ + r) * (1.0f / 1024.0f) + RMS_EPS);
            _Pragma("unroll") for (int bj = 0; bj < 2; ++bj) *(u32x4*)(O + r * ldo + bj * HALF + cw) = pack8(acc[ai][bj][m][0] * rs, acc[ai][bj][m][1] * rs); )
    }
};
struct EpiKVM { static constexpr bool PERM = true;
    bf16_t *KM, *VM;
    __device__ __forceinline__ void operator()(const f32x4 (&acc)[2][2][4][2], const Unit& u, int wr, int wc, int fr, int fq) const {
        const int pn = u.pn, cw = wc * 32 + 8 * fq; bf16_t* O = (pn < 2) ? KM + pn * 256 : VM + (pn - 2) * 256;
        EPI_ROWS( _Pragma("unroll") for (int bj = 0; bj < 2; ++bj) *(u32x4*)(O + r * 512 + bj * HALF + cw) = pack8(acc[ai][bj][m][0], acc[ai][bj][m][1]); )
    }
};
struct EpiRouter { static constexpr bool PERM = false;
    float* LOG;
    __device__ __forceinline__ void operator()(const f32x4 (&acc)[2][2][4][2], const Unit& u, int wr, int wc, int fr, int fq) const {
        const int c0 = wc * 32 + 4 * fq;
        EPI_ROWS( _Pragma("unroll") for (int n = 0; n < 2; ++n) *(f32x4*)(LOG + r * 128 + c0 + n * 16) = acc[ai][0][m][n]; )
    }
};
struct EpiGateUp { static constexpr bool PERM = true;
    bf16_t* HH; const float* RSP;
    __device__ __forceinline__ void operator()(const f32x4 (&acc)[2][2][4][2], const Unit& u, int wr, int wc, int fr, int fq) const {
        const int cw = (u.pn & 1) * 128 + wc * 32 + 8 * fq;
        EPI_ROWS( const float rs = RSP[r];
            f32x4 h[2];
            _Pragma("unroll") for (int n = 0; n < 2; ++n) { const f32x4 g = acc[ai][0][m][n] * rs, up = acc[ai][1][m][n] * rs; h[n] = g * sig4(g) * up; }
            store16_wt(HH + r * 256 + cw, pack8(h[0], h[1])); )
    }
};
struct EpiDown { static constexpr bool PERM = true;
    bf16_t* YD;
    __device__ __forceinline__ void operator()(const f32x4 (&acc)[2][2][4][2], const Unit& u, int wr, int wc, int fr, int fq) const {
        const int cw = (u.pn & 3) * 256 + wc * 32 + 8 * fq;
        EPI_ROWS( _Pragma("unroll") for (int bj = 0; bj < 2; ++bj) *(u32x4*)(YD + r * 1024 + bj * HALF + cw) = pack8(acc[ai][bj][m][0], acc[ai][bj][m][1]); )
    }
};
#undef EPI_ROWS
}
namespace att {
typedef unsigned short bf16;
using bf16x8 = __attribute__((ext_vector_type(8))) short;
using s16x4  = __attribute__((ext_vector_type(4))) short;
using f32x16 = __attribute__((ext_vector_type(16))) float;
using u32x4  = __attribute__((ext_vector_type(4))) unsigned;
constexpr int NW = 8, QBLK = 32, KVBLK = 64;
constexpr float THR = 8.f;
#define SBAR() __builtin_amdgcn_sched_barrier(0)
__device__ __forceinline__ int crow(int r, int hi) { return (r & 3) + 8 * (r >> 2) + 4 * hi; }
__device__ __forceinline__ unsigned cvtpk(float lo, float hi) { return pg8::cvt_pk_bf16(lo, hi); }

struct MlaCfg { static constexpr int DQ = 96, D1 = 64, DV = 64, LDQ = 768, LDK1 = 512, LDK2 = 32, LDV = 512, LDO = 512, KP = 208; static constexpr bool CAUSAL = true;
                static constexpr float SCALE = 0.10206207261596575f; };
struct XatCfg { static constexpr int DQ = 128, D1 = 128, DV = 128, LDQ = 512, LDK1 = 512, LDK2 = 0, LDV = 512, LDO = 512, KP = 256; static constexpr bool CAUSAL = false;
                static constexpr float SCALE = 0.08838834764831845f; };
template <class C> constexpr int lds_bytes() { return 2 * 64 * C::DV * 2 + 2 * 64 * C::KP + NW * 64 * 4; }

template <class C> __device__ __forceinline__ int kaddr(int row, int colB) { if constexpr (C::DQ == 128) return row * 256 + (colB ^ ((row & 7) << 4)); else return row * C::KP + colB; }

template <class C> __device__ __forceinline__ void partialSM(f32x16& p0, f32x16& p1, float& m_reg, float& mn, float& alpha) {
  constexpr float Cc = C::SCALE * 1.4426950408889634f;
  float pmax = p0[0];
#pragma unroll
  for (int r = 1; r < 16; ++r) pmax = fmaxf(pmax, p0[r]);
#pragma unroll
  for (int r = 0; r < 16; ++r) pmax = fmaxf(pmax, p1[r]);
  { auto rr = __builtin_amdgcn_permlane32_swap(__float_as_uint(pmax), __float_as_uint(pmax), false, false);
    pmax = fmaxf(__uint_as_float(rr[0]), __uint_as_float(rr[1])); }
  if (__builtin_expect(__all(pmax - m_reg <= THR / C::SCALE), 1)) { mn = m_reg; alpha = 1.f; }
  else { mn = fmaxf(m_reg, pmax); alpha = __builtin_amdgcn_exp2f((m_reg - mn) * Cc); m_reg = mn; }
  const float mnC = -mn * Cc;
#pragma unroll
  for (int r = 0; r < 16; ++r) p0[r] = fmaf(p0[r], Cc, mnC);
#pragma unroll
  for (int r = 0; r < 16; ++r) p1[r] = fmaf(p1[r], Cc, mnC);
#pragma unroll
  for (int r = 0; r < 16; ++r) p0[r] = __builtin_amdgcn_exp2f(p0[r]);
}
__device__ __forceinline__ void finishSM(f32x16& p0, f32x16& p1, float alpha, float& l_reg, bf16x8& pa0, bf16x8& pa1, bf16x8& pa2, bf16x8& pa3) {
#pragma unroll
  for (int r = 0; r < 16; ++r) p1[r] = __builtin_amdgcn_exp2f(p1[r]);
  float ps = 0;
#pragma unroll
  for (int r = 0; r < 16; ++r) ps += p0[r];
#pragma unroll
  for (int r = 0; r < 16; ++r) ps += p1[r];
  { auto rr = __builtin_amdgcn_permlane32_swap(__float_as_uint(ps), __float_as_uint(ps), false, false);
    ps = __uint_as_float(rr[0]) + __uint_as_float(rr[1]); }
  l_reg = l_reg * alpha + ps;
#define PK4(P, BASE, OUT) do { unsigned a0 = cvtpk(P[BASE + 0], P[BASE + 1]), a1 = cvtpk(P[BASE + 2], P[BASE + 3]);   \
    unsigned b0 = cvtpk(P[BASE + 4], P[BASE + 5]), b1 = cvtpk(P[BASE + 6], P[BASE + 7]);                              \
    auto r0 = __builtin_amdgcn_permlane32_swap(a0, b0, false, false); auto r1 = __builtin_amdgcn_permlane32_swap(a1, b1, false, false); \
    u32x4 w = {r0[0], r1[0], r0[1], r1[1]}; OUT = *reinterpret_cast<bf16x8*>(&w); } while (0)
  PK4(p0, 0, pa0); PK4(p0, 8, pa1); PK4(p1, 0, pa2); PK4(p1, 8, pa3);
#undef PK4
}
template <class C> __device__ __forceinline__ void qkt(f32x16& p0, f32x16& p1, const char* Ks, const bf16x8* qr, int r32, int hi) {
  p0 = f32x16{}; p1 = f32x16{};
#pragma unroll
  for (int d0 = 0; d0 < C::DQ / 16; ++d0) { const int cb = (d0 * 16 + hi * 8) * 2;
    const bf16x8 b0 = *reinterpret_cast<const bf16x8*>(Ks + kaddr<C>(r32, cb));
    const bf16x8 b1 = *reinterpret_cast<const bf16x8*>(Ks + kaddr<C>(32 + r32, cb));
    p0 = __builtin_amdgcn_mfma_f32_32x32x16_bf16(b0, qr[d0], p0, 0, 0, 0);
    p1 = __builtin_amdgcn_mfma_f32_32x32x16_bf16(b1, qr[d0], p1, 0, 0, 0); }
}
template <int NCB> __device__ __forceinline__ int v_st(int k, int c) { const int kk = (k & ~0xC) | ((k & 4) << 1) | ((k & 8) >> 1); return ((kk >> 3) * NCB + (c >> 5)) * 512 + ((kk & 7) * 32 + (c & 31)) * 2; }
__device__ __forceinline__ int v_rd_base(int lane) { return ((lane & 3) << 3) | (((lane >> 2) & 3) << 6) | (((lane >> 4) & 1) << 5) | (((lane >> 5) & 1) << 8); }
template <int NCB> constexpr int v_rd_off(int d0, int ks, int half) { return d0 * 512 + ks * (2 * NCB * 512) + half * (NCB * 512); }
template <int OFF> __device__ __forceinline__ s16x4 tr_read(int vb) {
  s16x4 r; asm volatile("ds_read_b64_tr_b16 %0, %1 offset:%2" : "=&v"(r) : "v"(vb), "i"(OFF) : "memory"); return r;
}
template <int NCB, int D0> __device__ __forceinline__ void pv_one(f32x16& od, int vb, bf16x8 pa0, bf16x8 pa1, bf16x8 pa2, bf16x8 pa3) {
  const s16x4 l0 = tr_read<v_rd_off<NCB>(D0, 0, 0)>(vb), h0 = tr_read<v_rd_off<NCB>(D0, 0, 1)>(vb), l1 = tr_read<v_rd_off<NCB>(D0, 1, 0)>(vb), h1 = tr_read<v_rd_off<NCB>(D0, 1, 1)>(vb);
  const s16x4 l2 = tr_read<v_rd_off<NCB>(D0, 2, 0)>(vb), h2 = tr_read<v_rd_off<NCB>(D0, 2, 1)>(vb), l3 = tr_read<v_rd_off<NCB>(D0, 3, 0)>(vb), h3 = tr_read<v_rd_off<NCB>(D0, 3, 1)>(vb);
  asm volatile("s_waitcnt lgkmcnt(0)" ::: "memory"); SBAR();
#define PK(L, H) (bf16x8){L[0], L[1], L[2], L[3], H[0], H[1], H[2], H[3]}
  od = __builtin_amdgcn_mfma_f32_32x32x16_bf16(pa0, PK(l0, h0), od, 0, 0, 0);
  od = __builtin_amdgcn_mfma_f32_32x32x16_bf16(pa1, PK(l1, h1), od, 0, 0, 0);
  od = __builtin_amdgcn_mfma_f32_32x32x16_bf16(pa2, PK(l2, h2), od, 0, 0, 0);
  od = __builtin_amdgcn_mfma_f32_32x32x16_bf16(pa3, PK(l3, h3), od, 0, 0, 0);
#undef PK
}
template <int NCB> __device__ __forceinline__ void pv_all(f32x16* o, int vb, bf16x8 pa0, bf16x8 pa1, bf16x8 pa2, bf16x8 pa3) {
  pv_one<NCB, 0>(o[0], vb, pa0, pa1, pa2, pa3); pv_one<NCB, 1>(o[1], vb, pa0, pa1, pa2, pa3);
  if constexpr (NCB == 4) { pv_one<NCB, 2>(o[2], vb, pa0, pa1, pa2, pa3); pv_one<NCB, 3>(o[3], vb, pa0, pa1, pa2, pa3); }
}
__device__ __forceinline__ void cmask(f32x16& p0, f32x16& p1, int kbase, int qpos, int hi) {
#pragma unroll
  for (int r = 0; r < 16; ++r) { const int kv = kbase + crow(r, hi); if (kv > qpos) p0[r] = -INFINITY; if (kv + 32 > qpos) p1[r] = -INFINITY; }
}
template <class C>
__device__ __forceinline__ void attn_unit(const bf16* __restrict__ Q1, const bf16* __restrict__ Q2, const bf16* __restrict__ K1, const bf16* __restrict__ K2,
                                          const bf16* __restrict__ Vp, bf16* __restrict__ Op, int qrow0, int NT, char* lds) {
  constexpr int DQ = C::DQ, DV = C::DV, NQF = DQ / 16, NCB = DV / 32, NKC = DQ / 8;
  constexpr int SHM_V = 64 * DV * 2, SHM_K = 64 * C::KP;
  const int tid = threadIdx.x, wid = tid >> 6, lane = tid & 63, r32 = lane & 31, hi = lane >> 5;
  char* V_lds = lds; char* K_lds = lds + 2 * SHM_V;
  float* ws = (float*)(lds + 2 * SHM_V + 2 * SHM_K) + wid * 64; float* li_l = ws; float* al_l = ws + 32;
  float m_reg = -1e30f, l_reg = 0; f32x16 o[NCB]; bf16x8 qr[NQF];
#pragma unroll
  for (int d = 0; d < NCB; ++d) o[d] = f32x16{};
  __syncthreads();
  { const long qrow = wid * QBLK + r32;
#pragma unroll
    for (int d0 = 0; d0 < NQF; ++d0) { const int d = d0 * 16 + hi * 8;
      qr[d0] = (d0 * 16 < C::D1) ? *reinterpret_cast<const bf16x8*>(Q1 + qrow * C::LDQ + d) : *reinterpret_cast<const bf16x8*>(Q2 + qrow * C::LDQ + (d - C::D1)); } }
  const bool kact = tid < 32 * NKC; const int ksr = tid / NKC, kcc = tid % NKC;
  const bf16* kbase = (kcc * 8 < C::D1) ? K1 + kcc * 8 : K2 + (kcc * 8 - C::D1); const int kld = (kcc * 8 < C::D1) ? C::LDK1 : C::LDK2;
  const int kst0 = kaddr<C>(ksr, kcc * 16), kst1 = kaddr<C>(32 + ksr, kcc * 16);
  const int vsr = (DV == 128) ? (tid >> 4) : (tid >> 3), vsc = (DV == 128) ? (tid & 15) * 8 : (tid & 7) * 8;
  const int vst0 = v_st<NCB>(vsr, vsc), vst1 = v_st<NCB>(32 + vsr, vsc);
  const int vb0 = (int)(uintptr_t)V_lds + v_rd_base(lane);
  struct { bf16x8 vs0, vs1, ks0, ks1; } sr_[2];
#define SLOAD(i, k0) do { sr_[i].vs0 = *reinterpret_cast<const bf16x8*>(&Vp[(long)((k0) + vsr) * C::LDV + vsc]); \
    if constexpr (DV == 128) sr_[i].vs1 = *reinterpret_cast<const bf16x8*>(&Vp[(long)((k0) + 32 + vsr) * C::LDV + vsc]); \
    if (kact) { sr_[i].ks0 = *reinterpret_cast<const bf16x8*>(&kbase[(long)((k0) + ksr) * kld]); sr_[i].ks1 = *reinterpret_cast<const bf16x8*>(&kbase[(long)((k0) + 32 + ksr) * kld]); } } while (0)
#define SWRITE(b, i) do { *(bf16x8*)(V_lds + (b) * SHM_V + vst0) = sr_[i].vs0; if constexpr (DV == 128) *(bf16x8*)(V_lds + (b) * SHM_V + vst1) = sr_[i].vs1; \
    if (kact) { *(bf16x8*)(K_lds + (b) * SHM_K + kst0) = sr_[i].ks0; *(bf16x8*)(K_lds + (b) * SHM_K + kst1) = sr_[i].ks1; } } while (0)
#define SWAIT() do { if constexpr (DV == 128) asm volatile("s_waitcnt vmcnt(4)" ::: "memory"); else asm volatile("s_waitcnt vmcnt(3)" ::: "memory"); } while (0)
#define RESC(a) do { if (__any((a) < 1.f)) { if (hi == 0) al_l[r32] = (a); asm volatile("s_waitcnt lgkmcnt(0)" ::: "memory"); \
    _Pragma("unroll") for (int d = 0; d < NCB; ++d) _Pragma("unroll") for (int r = 0; r < 16; ++r) o[d][r] *= al_l[crow(r, hi)]; } } while (0)
#define CMASK(P0, P1, t) do { if constexpr (C::CAUSAL) { if ((t) >= NT - 4) cmask(P0, P1, (t) * KVBLK, qrow0 + wid * QBLK + r32, hi); } } while (0)
  f32x16 pA0, pA1, pB0, pB1; float mnA, mnB, alA, alB; bf16x8 pa0, pa1, pa2, pa3;
  constexpr int SE = 0, SO = 1;
  SLOAD(SE, 0); asm volatile("s_waitcnt vmcnt(0)" ::: "memory"); SWRITE(0, SE); __syncthreads();
  qkt<C>(pA0, pA1, K_lds, qr, r32, hi); CMASK(pA0, pA1, 0); partialSM<C>(pA0, pA1, m_reg, mnA, alA);
  SLOAD(SO, KVBLK); if (2 < NT) SLOAD(SE, 2 * KVBLK);
  SWAIT(); SWRITE(1, SO); __syncthreads();
  for (int j = 1; j + 1 < NT; j += 2) {
    SBAR(); qkt<C>(pB0, pB1, K_lds + SHM_K, qr, r32, hi);
    finishSM(pA0, pA1, alA, l_reg, pa0, pa1, pa2, pa3); SBAR();
    SLOAD(SO, (j + 2) * KVBLK); SBAR();
    pv_all<NCB>(o, vb0, pa0, pa1, pa2, pa3); CMASK(pB0, pB1, j); partialSM<C>(pB0, pB1, m_reg, mnB, alB);
    __syncthreads(); SWAIT(); SWRITE(0, SE);
    RESC(alB); __syncthreads();
    SBAR(); qkt<C>(pA0, pA1, K_lds, qr, r32, hi);
    finishSM(pB0, pB1, alB, l_reg, pa0, pa1, pa2, pa3); SBAR();
    if (j + 3 < NT) SLOAD(SE, (j + 3) * KVBLK); SBAR();
    pv_all<NCB>(o, vb0 + SHM_V, pa0, pa1, pa2, pa3); CMASK(pA0, pA1, j + 1); partialSM<C>(pA0, pA1, m_reg, mnA, alA);
    __syncthreads(); SWAIT(); SWRITE(1, SO);
    RESC(alA); __syncthreads();
  }
  SBAR(); qkt<C>(pB0, pB1, K_lds + SHM_K, qr, r32, hi);
  finishSM(pA0, pA1, alA, l_reg, pa0, pa1, pa2, pa3); SBAR();
  pv_all<NCB>(o, vb0, pa0, pa1, pa2, pa3); CMASK(pB0, pB1, NT - 1); partialSM<C>(pB0, pB1, m_reg, mnB, alB);
  __syncthreads(); RESC(alB);
  finishSM(pB0, pB1, alB, l_reg, pa0, pa1, pa2, pa3); SBAR();
  pv_all<NCB>(o, vb0 + SHM_V, pa0, pa1, pa2, pa3);
  if (hi == 0) li_l[r32] = l_reg; asm volatile("s_waitcnt lgkmcnt(0)" ::: "memory");
  float rli[16];
#pragma unroll
  for (int r = 0; r < 16; ++r) rli[r] = __builtin_amdgcn_rcpf(li_l[crow(r, hi)]);
  bf16* Ow = Op + (long)(wid * QBLK) * C::LDO;
#pragma unroll
  for (int r = 0; r < 16; ++r) { const int orow = crow(r, hi);
#pragma unroll
    for (int d0 = 0; d0 < NCB; ++d0) Ow[(long)orow * C::LDO + d0 * 32 + r32] = (bf16)(cvtpk(o[d0][r] * rli[r], 0.f) & 0xffffu); }
#undef SLOAD
#undef SWRITE
#undef SWAIT
#undef RESC
#undef CMASK
}
#undef SBAR
}
#define GAS __attribute__((address_space(1)))
#define LAS __attribute__((address_space(3)))
typedef unsigned short bf16;
typedef unsigned v4u __attribute__((ext_vector_type(4)));
typedef float f32x4 __attribute__((ext_vector_type(4)));
typedef short bf16x8 __attribute__((ext_vector_type(8)));
typedef GAS unsigned gu32;
typedef GAS unsigned long long gu64;
#define RLX_AGENT __ATOMIC_RELAXED, __HIP_MEMORY_SCOPE_AGENT
#define LDS_WAIT() asm volatile("s_waitcnt lgkmcnt(0)" ::: "memory")
#define VM_WAIT() asm volatile("s_waitcnt vmcnt(0)" ::: "memory")
__device__ __forceinline__ unsigned long long rt() { return __builtin_amdgcn_s_memrealtime(); }
__device__ __forceinline__ unsigned f2bf(float f) { unsigned u = __builtin_bit_cast(unsigned, f); return (u + 0x7fffu + ((u >> 16) & 1u)) >> 16; }
__device__ __forceinline__ unsigned pk2(float lo, float hi) { return f2bf(lo) | (f2bf(hi) << 16); }

#define XB_TMO      128
#define XB_XCNT(j)  (256  + 64 * (j))
#define XB_XSUB(j)  (1280 + 64 * (j))
#define XB_XGEN(j)  (2304 + 64 * (j))
#define XB_TOP      3328
#define XB_TOPGEN   3392
#define XCD_BAR_WORDS 3456
#define XB_SPIN_CAP (1u << 18)

__device__ __forceinline__ unsigned xb_ld(unsigned* p)              { return __hip_atomic_load(p, __ATOMIC_RELAXED, __HIP_MEMORY_SCOPE_AGENT); }
__device__ __forceinline__ unsigned xb_add(unsigned* p, unsigned v) { return __hip_atomic_fetch_add(p, v, __ATOMIC_RELAXED, __HIP_MEMORY_SCOPE_AGENT); }
__device__ __forceinline__ unsigned xb_xcc_id() { return (unsigned)__builtin_amdgcn_s_getreg((3 << 11) | 20) & 0xFu; }
#define XB_SPIN(cond, bar) do { unsigned _sp = 0; while (cond) { __builtin_amdgcn_s_sleep(1); \
    if ((++_sp & 255u) == 0u) { if (xb_ld(&(bar)[XB_TMO])) break; if (_sp > XB_SPIN_CAP) { atomicAdd(&(bar)[XB_TMO], 1u); break; } } } } while (0)

struct XcdBarrier {
    unsigned* bar; unsigned x;
    volatile LAS unsigned* st;
};

__device__ __forceinline__ XcdBarrier xcd_barrier_post(unsigned* bar, volatile LAS unsigned* st) {
    XcdBarrier b; b.bar = bar; b.x = xb_xcc_id(); b.st = st;
    if (threadIdx.x == 0) (void)xb_add(&bar[XB_XCNT(b.x)], 1u);
    return b;
}
__device__ __forceinline__ void xcd_barrier_complete(unsigned* bar, unsigned x, unsigned& nloc, unsigned& nx) {
    const unsigned G = gridDim.x * gridDim.y * gridDim.z;
    unsigned sum, cnt, mine, sp = 0u;
    for (;;) {
        sum = 0u; cnt = 0u; mine = 0u;
#pragma unroll
        for (unsigned j = 0; j < 16; ++j) { const unsigned c = xb_ld(&bar[XB_XCNT(j)]); sum += c; cnt += (c > 0u) ? 1u : 0u; mine = (j == x) ? c : mine; }
        if (sum == G) break;
        __builtin_amdgcn_s_sleep(1);
        if ((++sp & 255u) == 0u) { if (xb_ld(&bar[XB_TMO])) break; if (sp > XB_SPIN_CAP) { atomicAdd(&bar[XB_TMO], 1u); break; } }
    }
    nloc = mine > 0u ? mine : 1u; nx = cnt > 0u ? cnt : 1u;
}

__device__ __forceinline__ void xcd_barrier(const XcdBarrier& b) {
    asm volatile("s_waitcnt vmcnt(0)" ::: "memory");
    __syncthreads();
    if (threadIdx.x == 0) {
        unsigned* bar = b.bar;
        __builtin_amdgcn_s_waitcnt(0);
        unsigned nloc = b.st[0], nx = b.st[1];
        if (nloc == 0u) { xcd_barrier_complete(bar, b.x, nloc, nx); b.st[0] = nloc; b.st[1] = nx; }
        const unsigned old = xb_add(&bar[XB_XSUB(b.x)], 1u);
        const unsigned gen = old / nloc;
        if (old + 1u == (gen + 1u) * nloc) {
            __builtin_amdgcn_fence(__ATOMIC_RELEASE, "agent");
            asm volatile("s_waitcnt vmcnt(0)" ::: "memory");
            const unsigned og = xb_add(&bar[XB_TOP], 1u);
            const unsigned tg = og / nx;
            if (og + 1u == (tg + 1u) * nx) xb_add(&bar[XB_TOPGEN], 1u);
            else XB_SPIN(xb_ld(&bar[XB_TOPGEN]) == tg, bar);
            __builtin_amdgcn_fence(__ATOMIC_ACQUIRE, "agent");
            xb_add(&bar[XB_XGEN(b.x)], 1u);
            asm volatile("s_waitcnt vmcnt(0)" ::: "memory");
        } else {
            XB_SPIN(xb_ld(&bar[XB_XGEN(b.x)]) == gen, bar);
            __builtin_amdgcn_fence(__ATOMIC_ACQUIRE, "agent");
            asm volatile("s_waitcnt vmcnt(0)" ::: "memory");
        }
    }
    __syncthreads();
}
constexpr int NWAVES = 8;
constexpr int D = 1024, BATCH = 8, SEQ = 2048, M = BATCH * SEQ, MEM = 256, MM = BATCH * MEM;
constexpr int NH = 8, DN = 64, DR = 32, DV = 64, QL = 256, KVL = 128, DQK = DN + DR;
constexpr int CW = 512, XH = 4, XD = 128, NG = 8, EPG = 8, NE = 64, FF = 256;
constexpr int COL_CQ = 256, COL_CKV = 384, COL_KR = 416, COL_CONV = 1952, IN_COLS = 4000, INP = 4096;
constexpr int PMAX = 2 * M + NE * 256, NTILE_MAX = PMAX / 256;
constexpr float EPS = 1e-6f;
constexpr int RCAP = M;

constexpr size_t MiB = 1u << 20;
constexpr size_t WS_CTL = 0, CTL_ZERO_BYTES = 1 * MiB;
constexpr size_t WS_COS = 1 * MiB, WS_SIN = 2 * MiB, WS_RIDX = 3 * MiB, WS_SLOT = WS_RIDX + 256 * 1024, WS_EID = WS_RIDX + 512 * 1024, WS_EW = WS_RIDX + 768 * 1024;
constexpr size_t WS_WIN = 4 * MiB, WS_WUQ = 12 * MiB, WS_WUKV = 12 * MiB + 512 * 1024, WS_WA = 13 * MiB, WS_WB = 14 * MiB, WS_WOUT = 15 * MiB, WS_WQM = 17 * MiB, WS_WKVM = 18 * MiB,
                 WS_WOM = 20 * MiB, WS_WR = 21 * MiB, WS_WGU = 22 * MiB, WS_WDN = 86 * MiB;
constexpr size_t WS_XN = 118 * MiB, WS_MIX = 118 * MiB, WS_G = 150 * MiB, WS_CQ = 214 * MiB, WS_CKV = 222 * MiB, WS_KR = 226 * MiB, WS_BG = 227 * MiB, WS_U = 243 * MiB,
                 WS_Q = 259 * MiB, WS_KN = 283 * MiB, WS_V = 299 * MiB, WS_ATT = 315 * MiB, WS_CONV = 331 * MiB, WS_X1B = 347 * MiB, WS_QM = 379 * MiB, WS_MEMN = 395 * MiB,
                 WS_KM = 399 * MiB, WS_VM = 401 * MiB, WS_OM = 403 * MiB, WS_X2B = 214 * MiB, WS_LOG = 246 * MiB, WS_HH = 259 * MiB, WS_YD = 118 * MiB, WS_RIDX2 = 420 * MiB, WS_XN8 = 424 * MiB, WS_WIN8 = 440 * MiB, WS_X1 = 448 * MiB, WS_END = 512 * MiB;
constexpr int CW_BAR = 4096, CW_SSQQ = 16384, CW_SSQKV = 49152, CW_SSQ1 = 81920, CW_SSQ2 = 114688, CW_INPROJ = 147648, CW_GRP = 147712, CW_TREADY = 151808, CW_COUNTS = 164096;
static_assert((CW_COUNTS + 64 * NE) * 4 <= (int)CTL_ZERO_BYTES && CW_TREADY + 64 * NTILE_MAX <= CW_COUNTS, "CTL words inside the memset region");
constexpr int RING_OFF = 0, RING_BYTES = 131072;
constexpr int LDSCTL_OFF = RING_BYTES, MISC_OFF = LDSCTL_OFF + 320, TEXP_OFF = RING_BYTES + 1024, GTAB_OFF = RING_BYTES + 2048, OFFS_OFF = GTAB_OFF + 4096, TORD_OFF = OFFS_OFF + 1024;
constexpr int LDS_BYTES = 147456;
static_assert(TORD_OFF + 1024 <= LDS_BYTES, "LDS map");

struct Args { const float* in[27]; float* out; unsigned char* ws; int ph_lo, ph_hi, sub, pad; };
constexpr int NPHASE = 15;
#ifndef GROUPBAR
#define GROUPBAR 1
#endif
#ifndef MOEALIGN
#define MOEALIGN true
#endif
#ifndef SUALIGN
#define SUALIGN true
#endif
#ifndef P1ALIGN
#define P1ALIGN false
#endif
#ifndef INROT
#define INROT 0
#endif

__device__ __forceinline__ float wave_sum(float v) {
#pragma unroll
    for (int o = 1; o < 64; o <<= 1) v += __shfl_xor(v, o);
    return v;
}
__device__ __forceinline__ int rope_pos(int j) { const int x = j & 15, second = j >> 4; return 8 * (x >> 2) + 4 * second + (x & 3); }
struct MapId  { __device__ __forceinline__ int operator()(int n) const { return n; } };
struct MapWin { __device__ __forceinline__ int operator()(int n) const {
    if (n < COL_CKV) return n;
    if (n < COL_KR) return 384 + rope_pos(n - COL_CKV);
    if (n < COL_KR + CW) return 512 + (n - COL_KR);
    if (n < COL_KR + 2 * CW) { const int c = n - COL_KR - CW; return 1024 + (c >> 7) * 256 + (c & 127); }
    if (n < COL_CONV) { const int c = n - COL_KR - 2 * CW; return 1024 + (c >> 7) * 256 + 128 + (c & 127); }
    return 2048 + (n - COL_CONV); } };
struct MapUq  { __device__ __forceinline__ int operator()(int n) const { const int h = n / DQK, d = n % DQK; return d < DN ? h * DN + d : 512 + h * DR + rope_pos(d - DN); } };
struct MapUkv { __device__ __forceinline__ int operator()(int n) const { const int h = n >> 7, d = n & 127; return d < 64 ? h * 64 + d : 512 + h * 64 + (d - 64); } };
struct MapGu  { __device__ __forceinline__ int operator()(int n) const { const int c = n & 255; return (c >> 7) * 256 + (n >> 8) * 128 + (c & 127); } };
struct TItem { const float* W; bf16* WT; const float* gain; int K, N, k0, n0, map; };
__device__ __forceinline__ void titem_load(const TItem& t, f32x4 (&v)[8], int lane) {
    const int sub = lane >> 3, c4 = (lane & 7) * 4;
#pragma unroll
    for (int j = 0; j < 8; ++j) v[j] = __builtin_nontemporal_load((const GAS f32x4*)(t.W + (size_t)(t.k0 + 8 * j + sub) * t.N + t.n0 + c4));
}
__device__ __forceinline__ int titem_row(int map, int n) {
    switch (map) { case 1: return MapWin()(n); case 2: return MapUq()(n); case 3: return MapUkv()(n); case 4: return MapGu()(n); default: return n; }
}
__device__ __forceinline__ void titem_finish(const TItem& t, const f32x4 (&v)[8], LAS float* scr, int lane) {
    const int sub = lane >> 3, c4 = (lane & 7) * 4;
#pragma unroll
    for (int j = 0; j < 8; ++j) { const int kk = 8 * j + sub; const float g = t.gain ? t.gain[t.k0 + kk] : 1.0f; LAS float* s = scr + kk * 33 + c4;
        s[0] = v[j].x * g; s[1] = v[j].y * g; s[2] = v[j].z * g; s[3] = v[j].w * g; }
    LDS_WAIT(); asm volatile("" ::: "memory");
    const int c = lane & 7;
#pragma unroll
    for (int j = 0; j < 4; ++j) { const int n = (lane >> 3) + 8 * j; const LAS float* s = scr + (8 * c) * 33 + n;
        if (t.map == 5) { unsigned w0 = 0, w1 = 0;
            w0 = __builtin_amdgcn_cvt_pk_fp8_f32(s[0 * 33] * 32.f, s[1 * 33] * 32.f, w0, false); w0 = __builtin_amdgcn_cvt_pk_fp8_f32(s[2 * 33] * 32.f, s[3 * 33] * 32.f, w0, true);
            w1 = __builtin_amdgcn_cvt_pk_fp8_f32(s[4 * 33] * 32.f, s[5 * 33] * 32.f, w1, false); w1 = __builtin_amdgcn_cvt_pk_fp8_f32(s[6 * 33] * 32.f, s[7 * 33] * 32.f, w1, true);
            *(GAS unsigned long long*)((GAS unsigned char*)t.WT + (size_t)(t.n0 + n - COL_CONV) * t.K + t.k0 + 8 * c) = (unsigned long long)w0 | ((unsigned long long)w1 << 32); continue; }
        v4u o; o.x = pk2(s[0 * 33], s[1 * 33]); o.y = pk2(s[2 * 33], s[3 * 33]); o.z = pk2(s[4 * 33], s[5 * 33]); o.w = pk2(s[6 * 33], s[7 * 33]);
        GAS v4u* dst = (GAS v4u*)(t.WT + (size_t)titem_row(t.map, t.n0 + n) * t.K + t.k0 + 8 * c);
        if (t.map == 4 || t.map == 6) __builtin_nontemporal_store(o, dst); else *dst = o; }
    LDS_WAIT(); asm volatile("" ::: "memory");
}
__device__ __forceinline__ void rms_row_to_bf16(const float* xrow, const float* g, bf16* orow, int lane) {
    const GAS f32x4* xr = (const GAS f32x4*)xrow + lane; const GAS f32x4* gr = (const GAS f32x4*)g + lane;
    f32x4 v[4]; float s = 0.f;
#pragma unroll
    for (int j = 0; j < 4; ++j) { v[j] = xr[64 * j]; s += (v[j].x * v[j].x + v[j].y * v[j].y) + (v[j].z * v[j].z + v[j].w * v[j].w); }
    const float rstd = 1.f / sqrtf(wave_sum(s) * (1.f / D) + EPS);
    GAS unsigned long long* o8 = (GAS unsigned long long*)orow + lane;
#pragma unroll
    for (int j = 0; j < 4; ++j) { const f32x4 gg = gr[64 * j]; o8[64 * j] = (unsigned long long)pk2(v[j].x * rstd * gg.x, v[j].y * rstd * gg.y) | ((unsigned long long)pk2(v[j].z * rstd * gg.z, v[j].w * rstd * gg.w) << 32); }
}

template <class MK>
__device__ __forceinline__ void run_titems(const MK& mk, int it_lo, int it_hi, int wv, int nwv, LAS float* scr, int lane) {
    f32x4 va[8], vb[8], vc[8]; TItem ta, tb, tc; int it = it_lo + wv;
    if (it < it_hi) { ta = mk(it); titem_load(ta, va, lane); }
    if (it + nwv < it_hi) { tb = mk(it + nwv); titem_load(tb, vb, lane); }
    while (it < it_hi) {
        if (it + 2 * nwv < it_hi) { tc = mk(it + 2 * nwv); titem_load(tc, vc, lane); }
        titem_finish(ta, va, scr, lane); it += nwv; if (it >= it_hi) break;
        if (it + 2 * nwv < it_hi) { ta = mk(it + 2 * nwv); titem_load(ta, va, lane); }
        titem_finish(tb, vb, scr, lane); it += nwv; if (it >= it_hi) break;
        if (it + 2 * nwv < it_hi) { tb = mk(it + 2 * nwv); titem_load(tb, vb, lane); }
        titem_finish(tc, vc, scr, lane); it += nwv;
    }
}
constexpr int I_GU = 16 * 16, I_DN = 4 * 32, MOE_ITEMS = NE * (I_GU + I_DN);
__device__ __forceinline__ void moe_prep(unsigned char* ws, const float* w_gu, const float* w_dn, const float* g_moe, int it_lo, int it_hi, int wv, int nwv, LAS float* scr, int lane) {
    auto mk = [&](int it) -> TItem { TItem t; int r = it;
        if (r < NE * I_GU) { const int e = r / I_GU, item = r % I_GU; t.W = w_gu + (size_t)e * D * 512; t.WT = (bf16*)(ws + WS_WGU) + (size_t)e * 512 * D; t.gain = g_moe; t.K = D; t.N = 512; t.k0 = 64 * (item / 16); t.n0 = 32 * (item % 16); t.map = 4; return t; }
        r -= NE * I_GU; { const int e = r / I_DN, item = r % I_DN; t.W = w_dn + (size_t)e * FF * D; t.WT = (bf16*)(ws + WS_WDN) + (size_t)e * D * FF; t.gain = nullptr; t.K = FF; t.N = D; t.k0 = 64 * (item / 32); t.n0 = 32 * (item % 32); t.map = 6; return t; } };
    run_titems(mk, it_lo, it_hi, wv, nwv, scr, lane);
}
#ifdef PREP_IN_P0
#define PREP_A MOE_ITEMS
#define PREP_B MOE_ITEMS
#endif
#ifndef PREP_A
#define PREP_A 1500
#endif
#ifndef PREP_B
#define PREP_B 11000
#endif
__device__ __forceinline__ void group_barrier(unsigned* cnt, unsigned target, unsigned* tmo, volatile LAS unsigned* st) {
    asm volatile("s_waitcnt vmcnt(0)" ::: "memory");
    __syncthreads();
    if (threadIdx.x == 0) {
        const unsigned mode = st[0];
        if (mode != 1u) __builtin_amdgcn_fence(__ATOMIC_RELEASE, "agent");
        asm volatile("s_waitcnt vmcnt(0)" ::: "memory");
        (void)xb_add(cnt, 1u);
        unsigned sp = 0;
        while (xb_ld(cnt) < target) { __builtin_amdgcn_s_sleep(1); if ((++sp & 255u) == 0u) { if (xb_ld(tmo)) break; if (sp > XB_SPIN_CAP) { atomicAdd(tmo, 1u); break; } } }
        __builtin_amdgcn_fence(__ATOMIC_ACQUIRE, "agent");
        asm volatile("s_waitcnt vmcnt(0)" ::: "memory");
        if (mode == 0u) { const unsigned m = xb_ld(cnt + 1); st[0] = (__builtin_popcount(m) == 1) ? 1u : 2u; }
    }
    __syncthreads();
}
__device__ __forceinline__ void conv_item(unsigned char* ws, const float* conv_w, int m, int c) {
    const int s = m % SEQ; const bf16* Ub = (const bf16*)(ws + WS_U) + (size_t)m * CW + c;
    f32x4 u0a, u0b, u1a, u1b, u2a, u2b, ba, bb;
    pg8::unpack8(*(const v4u*)Ub, u2a, u2b); pg8::unpack8(*(const v4u*)((const bf16*)(ws + WS_BG) + (size_t)m * CW + c), ba, bb);
    if (s >= 1) pg8::unpack8(*(const v4u*)(Ub - CW), u1a, u1b); else { u1a = (f32x4){0.f, 0.f, 0.f, 0.f}; u1b = u1a; }
    if (s >= 2) pg8::unpack8(*(const v4u*)(Ub - 2 * CW), u0a, u0b); else { u0a = (f32x4){0.f, 0.f, 0.f, 0.f}; u0b = u0a; }
    const f32x4 w0a = *(const f32x4*)(conv_w + c), w0b = *(const f32x4*)(conv_w + c + 4), w1a = *(const f32x4*)(conv_w + CW + c), w1b = *(const f32x4*)(conv_w + CW + c + 4),
                w2a = *(const f32x4*)(conv_w + 2 * CW + c), w2b = *(const f32x4*)(conv_w + 2 * CW + c + 4);
    *(v4u*)((bf16*)(ws + WS_CONV) + (size_t)m * CW + c) = pg8::pack8(ba * (w0a * u0a + w1a * u1a + w2a * u2a), bb * (w0b * u0b + w1b * u1b + w2b * u2b));
}
__device__ __forceinline__ const void* kernarg_ptr(int i) {
    const void* const* p = (const void* const*)__builtin_amdgcn_kernarg_segment_ptr(); asm volatile("" : "+s"(p)); return p[i];
}
__global__ void __launch_bounds__(NWAVES * 64, 2) mega_fwd(Args args) {
    extern __shared__ __attribute__((aligned(16))) unsigned char lds[];
    LAS unsigned char* const ldsl = (LAS unsigned char*)lds;
    volatile LAS unsigned* const MISC = (volatile LAS unsigned*)(ldsl + MISC_OFF);
    const int tid = threadIdx.x, lane = tid & 63, wave = __builtin_amdgcn_readfirstlane(tid >> 6);
    const int G = gridDim.x, bx = blockIdx.x, vcu = (G % 8 == 0) ? (bx % 8) * (G / 8) + bx / 8 : bx;
    unsigned char* const ws = args.ws;
    gu32* const ctl = (gu32*)(ws + WS_CTL);
#define ARGF(i) ((const float*)kernarg_ptr(i))
#define WSB(off) ((bf16*)(ws + (off)))
    float* const COS = (float*)(ws + WS_COS); float* const SIN = (float*)(ws + WS_SIN);
    int* const RIDX = (int*)(ws + WS_RIDX); int* const SLOT = (int*)(ws + WS_SLOT); int* const EID = (int*)(ws + WS_EID); int* const RIDX2 = (int*)(ws + WS_RIDX2); float* const EW = (float*)(ws + WS_EW);
    pg8::ssq_t* const SSQQ = (pg8::ssq_t*)(ctl + CW_SSQQ); pg8::ssq_t* const SSQKV = (pg8::ssq_t*)(ctl + CW_SSQKV); pg8::ssq_t* const SSQ1 = (pg8::ssq_t*)(ctl + CW_SSQ1); pg8::ssq_t* const SSQ2 = (pg8::ssq_t*)(ctl + CW_SSQ2);
    unsigned* const COUNTS = (unsigned*)(ctl + CW_COUNTS);
    float* const LOG = (float*)(ws + WS_LOG);

    for (int u = tid; u < (LDS_BYTES - LDSCTL_OFF) / 4; u += NWAVES * 64) ((LAS unsigned*)(ldsl + LDSCTL_OFF))[u] = 0u;
    __syncthreads();
    const int lo = args.ph_lo, hi = args.ph_hi;
    XcdBarrier bar; bar.bar = (unsigned*)(ctl + CW_BAR); bar.x = 0; bar.st = nullptr;
    if (hi - lo > 1) { bar = xcd_barrier_post((unsigned*)(ctl + CW_BAR), MISC + 8); if (GROUPBAR && tid == 0) atomicOr((unsigned*)(ctl + CW_GRP) + 64 * (bx % 64) + 1, 1u << bar.x); }
#ifndef PHMASK
#define PHMASK 0x7fff
#endif
#ifndef REPMASK
#define REPMASK 0
#endif
#ifndef REPBAR
#define REPBAR 0
#endif
#define REP(k) for (int rep_ = 0; rep_ < ((((REPMASK) >> (k)) & 1) ? 2 : 1); ++rep_, (REPBAR ? xcd_barrier(bar) : (void)0))
#define IN(k) ((((PHMASK) >> (k)) & 1) && lo <= (k) && (k) < hi)
#ifndef NBAR
#define NBAR 1
#endif
#ifdef TSPROBE
#define TSTAMP(i) do { if (bx == 0 && tid == 0) ((unsigned long long*)(ctl + 512))[i] = __builtin_amdgcn_s_memrealtime(); } while (0)
#else
#define TSTAMP(i) do {} while (0)
#endif
#define SEAM(k) do { if (IN(k) && IN((k) + 1)) { for (int nb_ = 0; nb_ < NBAR; ++nb_) xcd_barrier(bar); } TSTAMP((k) + 1); } while (0)
    unsigned* const grp_cnt = (unsigned*)(ctl + CW_GRP) + 64 * (bx % 64); unsigned* const grp_tmo = (unsigned*)(ctl + CW_BAR) + XB_TMO;
#define GSEAM(k, s) do { if (IN(k) && IN((k) + 1)) { if (GROUPBAR && G == 256) group_barrier(grp_cnt, 4u * ((s) + 1u), grp_tmo, MISC + 12); else xcd_barrier(bar); } TSTAMP((k) + 1); } while (0)
    TSTAMP(0);
#ifndef NPASS
#define NPASS 1
#endif
    const int gw = vcu * NWAVES + wave, NGW = G * NWAVES, gt = vcu * (NWAVES * 64) + tid, NGT = G * NWAVES * 64;

    if (IN(0)) REP(0) {
        const float* x = ARGF(0); const float* mem = ARGF(1); const int* pos = (const int*)ARGF(2); const float* g_mix = ARGF(3); const float* w_in = ARGF(4);
        const float* g_cq = ARGF(6); const float* w_uq = ARGF(7); const float* g_ckv = ARGF(8); const float* w_ukv = ARGF(9); const float* w_a = ARGF(11); const float* w_b = ARGF(12); const float* w_out = ARGF(13);
        const float* g_xattn = ARGF(14); const float* g_mem = ARGF(15); const float* w_q_mem = ARGF(16); const float* w_kv_mem = ARGF(17); const float* w_o_mem = ARGF(18); const float* g_moe = ARGF(19);
        const float* w_rg = ARGF(20); const float* w_re = ARGF(22);
        LAS float* scr = (LAS float*)(ldsl + RING_OFF + wave * 16384);
        constexpr int I_IN = 16 * 125, I_UQ = 4 * 24, I_UKV = 2 * 32, I_A = 8 * 32, I_OUT = 16 * 32, I_QM = 16 * 16, I_KVM = 16 * 32, I_OM = 8 * 32;
        constexpr int NITEMS = I_IN + I_UQ + I_UKV + 2 * I_A + I_OUT + I_QM + I_KVM + I_OM;
        auto mk_item = [&](int it) -> TItem {
            TItem t; int r = it;
            auto set = [&](const float* W, int K, int N, bf16* WT, const float* gain, int map, int item) { const int nblk = N / 32; t.W = W; t.WT = WT; t.gain = gain; t.K = K; t.N = N; t.k0 = 64 * (item / nblk); t.n0 = 32 * (item % nblk); t.map = map; };
            if (r < I_IN) { set(w_in, D, IN_COLS, WSB(WS_WIN), nullptr, 1, r); return t; } r -= I_IN;
            if (r < I_UQ) { set(w_uq, QL, NH * DQK, WSB(WS_WUQ), g_cq, 2, r); return t; } r -= I_UQ;
            if (r < I_UKV) { set(w_ukv, KVL, NH * 128, WSB(WS_WUKV), g_ckv, 3, r); return t; } r -= I_UKV;
            if (r < I_A) { set(w_a, 512, D, WSB(WS_WA), nullptr, 0, r); return t; } r -= I_A;
            if (r < I_A) { set(w_b, 512, D, WSB(WS_WB), nullptr, 0, r); return t; } r -= I_A;
            if (r < I_OUT) { set(w_out, D, D, WSB(WS_WOUT), nullptr, 0, r); return t; } r -= I_OUT;
            if (r < I_QM) { set(w_q_mem, D, 512, WSB(WS_WQM), g_xattn, 0, r); return t; } r -= I_QM;
            if (r < I_KVM) { set(w_kv_mem, D, D, WSB(WS_WKVM), nullptr, 0, r); return t; } r -= I_KVM;
            set(w_o_mem, 512, D, WSB(WS_WOM), nullptr, 0, r); return t;
        };
        run_titems(mk_item, 0, NITEMS, gw, NGW, scr, lane);
#ifdef PREP_IN_P0
        moe_prep(ws, ARGF(24), ARGF(25), ARGF(19), 0, MOE_ITEMS, gw, NGW, scr, lane);
#endif
        {
            auto ldrow = [&](const float* xrow, f32x4 (&v)[4]) { const GAS f32x4* xr = (const GAS f32x4*)xrow + lane; _Pragma("unroll") for (int j = 0; j < 4; ++j) v[j] = xr[64 * j]; };
            auto finrow = [&](const f32x4 (&v)[4], const float* g, bf16* orow, unsigned char* orow8) { float s = 0.f;
                _Pragma("unroll") for (int j = 0; j < 4; ++j) s += (v[j].x * v[j].x + v[j].y * v[j].y) + (v[j].z * v[j].z + v[j].w * v[j].w);
                const float rstd = 1.f / sqrtf(wave_sum(s) * (1.f / D) + EPS); const GAS f32x4* gr = (const GAS f32x4*)g + lane; GAS unsigned long long* o8 = (GAS unsigned long long*)orow + lane;
                _Pragma("unroll") for (int j = 0; j < 4; ++j) { const f32x4 gg = gr[64 * j]; const float a0 = v[j].x * rstd * gg.x, a1 = v[j].y * rstd * gg.y, a2 = v[j].z * rstd * gg.z, a3 = v[j].w * rstd * gg.w;
                    o8[64 * j] = (unsigned long long)pk2(a0, a1) | ((unsigned long long)pk2(a2, a3) << 32);
                    if (orow8) { unsigned w = 0; w = __builtin_amdgcn_cvt_pk_fp8_f32(a0, a1, w, false); w = __builtin_amdgcn_cvt_pk_fp8_f32(a2, a3, w, true); ((GAS unsigned*)orow8)[lane + 64 * j] = w; } } };
            f32x4 r0[4], r1[4];
            for (int m = gw; m < M; m += 2 * NGW) { const int m1 = m + NGW; ldrow(x + (size_t)m * D, r0); if (m1 < M) ldrow(x + (size_t)m1 * D, r1);
                finrow(r0, g_mix, WSB(WS_XN) + (size_t)m * D, nullptr); if (m1 < M) finrow(r1, g_mix, WSB(WS_XN) + (size_t)m1 * D, nullptr); }
            for (int m = gw; m < MM; m += NGW) { ldrow(mem + (size_t)m * D, r0); finrow(r0, g_mem, WSB(WS_MEMN) + (size_t)m * D, nullptr); }
        }
        for (int i = gt; i < M * 16; i += NGT) { const int m = i >> 4, j = i & 15; const float inv = powf(10000.0f, -(float)(2 * j) / 32.0f); const float ang = (float)pos[m] * inv; COS[i] = cosf(ang); SIN[i] = sinf(ang); }
        for (int i = gt; i < PMAX; i += NGT) RIDX[i] = 0;
        for (int i = gt; i < 96 * D; i += NGT) WSB(WS_WIN)[(size_t)416 * D + i] = 0;
        for (int i = gt; i < 256 * D; i += NGT) { const int n = i >> 10, k = i & 1023;
            float v = 0.f; if (n < NG) v = w_rg[k * NG + n] * g_moe[k]; else if (n < NG + NE) v = w_re[k * NE + (n - NG)] * g_moe[k];
            WSB(WS_WR)[i] = (bf16)f2bf(v); }
    }
    SEAM(0);
    if (GROUPBAR && IN(0) && IN(1)) {
        if (tid == 0) { const unsigned m = xb_ld(grp_cnt + 1); MISC[12] = (__builtin_popcount(m) == 1) ? 1u : 2u; }
        __syncthreads();
    }
    if (IN(1)) REP(1) {
        const float* b_gate = ARGF(5);
        pg8::Gemm g{WSB(WS_XN), WSB(WS_WIN), M, INP, D}; pg8::StaticOrder S;
#ifdef P1SPLIT
        S.init(M, INP, 1024, bx + args.sub * 256, INROT);
#else
        S.init(M, INP, G, bx, INROT);
#endif
        pg8::EpiInProj E{WSB(WS_CQ), WSB(WS_CKV), WSB(WS_KR), WSB(WS_BG), WSB(WS_U), WSB(WS_G), SSQQ, SSQKV, COS, SIN, b_gate, rep_ == 0, 0, 1.0f};
        pg8::gemm_phase<pg8::EpiInProj, pg8::StaticOrder, P1ALIGN>(ldsl + RING_OFF, g, S, E);
        if (rep_ == 0 && G == 256) {
            group_barrier(grp_cnt + 4, 4u, grp_tmo, MISC + 12);
            const int pm1 = 8 * (bx % 8) + (bx / 8) % 8, j1 = bx / 64;
            if (j1 == 0 || j1 == 2) { pg8::Gemm g2{WSB(WS_CQ), WSB(WS_WUQ), M, 768, QL}; pg8::PanelOrder S2{pm1, j1 == 0 ? 2 : 1, j1 == 0 ? 0 : 2};
                pg8::EpiQUp E2{WSB(WS_Q), SSQQ, COS, SIN}; pg8::gemm_phase<pg8::EpiQUp, pg8::PanelOrder, true>(ldsl + RING_OFF, g2, S2, E2); }
            if (j1 == 1 || j1 == 2) { pg8::Gemm g2{WSB(WS_CKV), WSB(WS_WUKV), M, 1024, KVL}; pg8::PanelOrder S2{pm1, j1 == 1 ? 3 : 1, j1 == 1 ? 0 : 3};
                pg8::EpiKVUp E2{WSB(WS_KN), WSB(WS_V), SSQKV}; pg8::gemm_phase<pg8::EpiKVUp, pg8::PanelOrder, true>(ldsl + RING_OFF, g2, S2, E2); }
            if (j1 == 3) {
                if (bx < 224) { pg8::Gemm g{WSB(WS_MEMN), WSB(WS_WKVM), MM, 1024, D}; pg8::StaticOrder S; S.init(MM, 1024, G, bx - 192);
                    pg8::EpiKVM E{WSB(WS_KM), WSB(WS_VM)}; pg8::gemm_phase<pg8::EpiKVM, pg8::StaticOrder, true>(ldsl + RING_OFF, g, S, E); }
                else if (PREP_A > 0 && PREP_A < MOE_ITEMS) moe_prep(ws, ARGF(24), ARGF(25), ARGF(19), 0, PREP_A, (bx - 224) * NWAVES + wave, 32 * NWAVES, (LAS float*)(ldsl + RING_OFF + wave * 16384), lane);
            }
        }
    }
    SEAM(1);
    if (IN(3)) REP(3) {
        const float* conv_w = ARGF(10);
        for (int i = gt; i < M * (CW / 8); i += NGT) conv_item(ws, conv_w, i >> 6, (i & 63) * 8);
        for (int v = vcu; v < 256; v += G) {
            const int bh = v >> 2, b = bh >> 3, h = bh & 7, s4 = v & 3;
            for (int k = 0; k < 2; ++k) { const int qb = k ? 7 - s4 : s4; const size_t row0 = (size_t)b * SEQ + qb * 256, key0 = (size_t)b * SEQ;
                att::attn_unit<att::MlaCfg>(WSB(WS_Q) + row0 * 768 + h * 64, WSB(WS_Q) + row0 * 768 + 512 + h * 32, WSB(WS_KN) + key0 * 512 + h * 64, WSB(WS_KR) + key0 * 32,
                                             WSB(WS_V) + key0 * 512 + h * 64, WSB(WS_ATT) + row0 * 512 + h * 64, qb * 256, 4 * (qb + 1), (char*)lds + RING_OFF); }
        }
        __syncthreads();
    }
    SEAM(3);
    if (IN(4)) REP(4) {
        { pg8::Gemm g{WSB(WS_ATT), WSB(WS_WA), M, D, 512}; pg8::StaticOrder S; S.init(M, D, G, bx);
          pg8::EpiMix<false> E{WSB(WS_MIX), WSB(WS_G)}; pg8::gemm_phase<pg8::EpiMix<false>, pg8::StaticOrder, SUALIGN>(ldsl + RING_OFF, g, S, E); }
        { pg8::Gemm g{WSB(WS_CONV), WSB(WS_WB), M, D, 512}; pg8::StaticOrder S; S.init(M, D, G, bx);
          pg8::EpiMix<true> E{WSB(WS_MIX), WSB(WS_G)}; pg8::gemm_phase<pg8::EpiMix<true>, pg8::StaticOrder, SUALIGN>(ldsl + RING_OFF, g, S, E); }
    }
    GSEAM(4, 0);
    if (IN(5)) REP(5) {
        const float* x = ARGF(0);
        pg8::Gemm g{WSB(WS_MIX), WSB(WS_WOUT), M, D, D}; pg8::StaticOrder S; S.init(M, D, G, bx);
        pg8::EpiResid<float> E{x, WSB(WS_X1B), SSQ1, rep_ == 0}; pg8::gemm_phase<pg8::EpiResid<float>, pg8::StaticOrder, SUALIGN>(ldsl + RING_OFF, g, S, E);
    }
    GSEAM(5, 1);
    if (IN(6)) REP(6) {
        pg8::Gemm g{WSB(WS_X1B), WSB(WS_WQM), M, 512, D}; pg8::StaticOrder S; S.init(M, 512, G, bx);
        pg8::EpiScaleRows E{WSB(WS_QM), 512, SSQ1}; pg8::gemm_phase<pg8::EpiScaleRows, pg8::StaticOrder, SUALIGN>(ldsl + RING_OFF, g, S, E);
        if (rep_ == 0 && bx >= 128) moe_prep(ws, ARGF(24), ARGF(25), ARGF(19), PREP_A, PREP_B, (bx - 128) * NWAVES + wave, 128 * NWAVES, (LAS float*)(ldsl + RING_OFF + wave * 16384), lane);
    }
    GSEAM(6, 2);
    if (IN(7)) REP(7) {
        for (int v = bx; v < 256; v += G) {
            const int pmv = 8 * (v % 8) + (v / 8) % 8, b = pmv >> 3, qb = pmv & 7, h = v / 64; const size_t row0 = (size_t)b * SEQ + qb * 256, key0 = (size_t)b * MEM;
            att::attn_unit<att::XatCfg>(WSB(WS_QM) + row0 * 512 + h * 128, nullptr, WSB(WS_KM) + key0 * 512 + h * 128, nullptr, WSB(WS_VM) + key0 * 512 + h * 128,
                                         WSB(WS_OM) + row0 * 512 + h * 128, 0, MEM / 64, (char*)lds + RING_OFF);
        }
        __syncthreads();
    }
    GSEAM(7, 3);
    if (IN(8)) REP(8) {
        pg8::Gemm g{WSB(WS_OM), WSB(WS_WOM), M, D, 512}; pg8::StaticOrder S; S.init(M, D, G, bx);
        pg8::EpiResid<bf16> E{WSB(WS_X1B), WSB(WS_X2B), SSQ2, rep_ == 0}; pg8::gemm_phase<pg8::EpiResid<bf16>, pg8::StaticOrder, SUALIGN>(ldsl + RING_OFF, g, S, E);
    }
    GSEAM(8, 4);
    if (IN(9)) REP(9) {
        const float* b_rg = ARGF(21); const float* b_re = ARGF(23);
        pg8::Gemm g{WSB(WS_X2B), WSB(WS_WR), M, 256, D}; pg8::StaticOrder S; S.init(M, 256, G, bx);
        pg8::EpiRouter E{LOG}; pg8::gemm_phase<pg8::EpiRouter, pg8::StaticOrder, SUALIGN>(ldsl + RING_OFF, g, S, E);
        if (rep_ == 0 && bx >= 64) moe_prep(ws, ARGF(24), ARGF(25), ARGF(19), PREP_B, MOE_ITEMS, (bx - 64) * NWAVES + wave, 192 * NWAVES, (LAS float*)(ldsl + RING_OFF + wave * 16384), lane);
        VM_WAIT(); __syncthreads();
        if (rep_ == 0)
        { pg8::Unit ur; if (S.next(0, ur) && tid < 256) { const int n = ur.pm * 256 + tid;
            const float rs = 1.0f / sqrtf(pg8::ssq_get(SSQ2 + n) * (1.0f / D) + EPS); const float* L = LOG + (size_t)n * 128;
            float gl[NG]; float gm = -3.0e38f; int gi = 0;
#pragma unroll
            for (int g = 0; g < NG; ++g) { gl[g] = L[g] * rs + b_rg[g]; if (gl[g] > gm) { gm = gl[g]; gi = g; } }
            float se = 0.f;
#pragma unroll
            for (int g = 0; g < NG; ++g) se += __expf(gl[g] - gm);
            const float pg = 1.0f / se;
            float v0 = -3.0e38f, v1 = -3.0e38f; int i0 = 0, i1 = 0;
            for (int e = 0; e < EPG; ++e) { const float v = L[NG + gi * EPG + e] * rs + b_re[gi * EPG + e];
                if (v > v0) { v1 = v0; i1 = i0; v0 = v; i0 = e; } else if (v > v1) { v1 = v; i1 = e; } }
            const float e1 = __expf(v1 - v0);
            EID[2 * n] = gi * EPG + i0; EID[2 * n + 1] = gi * EPG + i1; EW[2 * n] = pg / (1.0f + e1); EW[2 * n + 1] = pg * e1 / (1.0f + e1);
            { const int ea = gi * EPG + i0, eb = gi * EPG + i1;
              const int sa = (int)atomicAdd(&COUNTS[64 * ea], 1u), sb = (int)atomicAdd(&COUNTS[64 * eb], 1u);
              RIDX2[ea * RCAP + sa] = n; RIDX2[eb * RCAP + sb] = n; SLOT[2 * n] = sa; SLOT[2 * n + 1] = sb; }
        } }
    }
    SEAM(10);
    if (IN(12) || IN(13)) {
        LAS int* texp = (LAS int*)(ldsl + TEXP_OFF); LAS int* gtab = (LAS int*)(ldsl + GTAB_OFF); LAS int* offs = (LAS int*)(ldsl + OFFS_OFF);
        LAS int* cnts = offs + 128;
        if (tid < NE) cnts[tid] = (int)__hip_atomic_load(&COUNTS[64 * tid], RLX_AGENT);
        __syncthreads();
        LAS int* tord = (LAS int*)(ldsl + TORD_OFF);
        if (tid == 0) { int t = 0; for (int e = 0; e < NE; ++e) { const int nt = (cnts[e] + 255) / 256; offs[e] = t * 256; for (int k = 0; k < nt; ++k) texp[t++] = e; } offs[64] = t;
            int k = 0;
            for (int p = 0; p < 2; ++p) for (int tl = 0; tl < t; ++tl) { const int e = texp[tl], valid = cnts[e] - (tl * 256 - offs[e]); const int hf = 0; (void)valid; if (hf == p) tord[k++] = tl | (hf << 30); } }
        __syncthreads();
        const int ntiles = __builtin_amdgcn_readfirstlane(offs[64]);
        if (IN(12)) {
            unsigned* tready = (unsigned*)(ctl + CW_TREADY);
            for (int i = 0; i < 4; ++i) { const int L = i * G + vcu; if (L < ntiles * 2 && tid < 256) { const int tile = tord[L >> 1] & 0xffff, e = texp[tile], s = tile * 256 - offs[e] + tid;
                const int tok = (s < cnts[e]) ? RIDX2[e * RCAP + s] : 0; gtab[i * 256 + tid] = tok; ((float*)RIDX)[tile * 256 + tid] = __builtin_amdgcn_rsqf(pg8::ssq_get(SSQ2 + tok) * (1.0f / D) + EPS); } }
            VM_WAIT(); __syncthreads();
            { pg8::Gemm g{WSB(WS_X2B), WSB(WS_WGU), PMAX, NE * 512, D}; pg8::MoeUpOrder S{ntiles, G, vcu, texp, tord, tready};
              pg8::EpiGateUp E{WSB(WS_HH), (const float*)RIDX}; pg8::gemm_phase<pg8::EpiGateUp, pg8::MoeUpOrder, MOEALIGN, true>(ldsl + RING_OFF, g, S, E, gtab); }
            { pg8::Gemm g{WSB(WS_HH), WSB(WS_WDN), PMAX, NE * D, FF}; pg8::MoeDownOrder S{ntiles, G, vcu, texp, tord, tready, (unsigned*)(ctl + CW_BAR) + XB_TMO};
              pg8::EpiDown E{WSB(WS_YD)}; pg8::gemm_phase<pg8::EpiDown, pg8::MoeDownOrder, MOEALIGN>(ldsl + RING_OFF, g, S, E); }
        }
    }
    SEAM(13);
    if (IN(14)) REP(14) {
        const float* g_final = ARGF(26);
        LAS int* offs = (LAS int*)(ldsl + OFFS_OFF);
        __syncthreads();
        if (tid < NE) offs[128 + tid] = (int)__hip_atomic_load(&COUNTS[64 * tid], RLX_AGENT);
        __syncthreads();
        if (tid == 0) { int t = 0; for (int e = 0; e < NE; ++e) { offs[e] = t * 256; t += (offs[128 + e] + 255) / 256; } }
        __syncthreads();
        {
            typedef unsigned long long u64;
            const GAS f32x4* gr = (const GAS f32x4*)g_final + lane; f32x4 gg[4];
#pragma unroll
            for (int j = 0; j < 4; ++j) gg[j] = gr[64 * j];
            u64 ra[2][4], rb[2][4], rx[2][4]; float w0[2], w1[2];
            auto ld = [&](int m, int b) { const size_t s0 = (size_t)(offs[EID[2 * m]] + SLOT[2 * m]), s1 = (size_t)(offs[EID[2 * m + 1]] + SLOT[2 * m + 1]); w0[b] = EW[2 * m]; w1[b] = EW[2 * m + 1];
                const GAS u64* xr = (const GAS u64*)(WSB(WS_X2B) + (size_t)m * D) + lane; const GAS u64* y0 = (const GAS u64*)(WSB(WS_YD) + s0 * D) + lane; const GAS u64* y1 = (const GAS u64*)(WSB(WS_YD) + s1 * D) + lane;
                _Pragma("unroll") for (int j = 0; j < 4; ++j) { ra[b][j] = y0[64 * j]; rb[b][j] = y1[64 * j]; rx[b][j] = xr[64 * j]; } };
            auto fin = [&](int m, int b) { f32x4 v[4]; float ss = 0.f;
                _Pragma("unroll") for (int j = 0; j < 4; ++j) { const u64 a = ra[b][j], bq = rb[b][j], xw = rx[b][j];
                    const unsigned al = (unsigned)a, ah = (unsigned)(a >> 32), bl = (unsigned)bq, bh = (unsigned)(bq >> 32), xl = (unsigned)xw, xh = (unsigned)(xw >> 32);
                    const f32x4 ya = (f32x4){pg8::bf_lo(al), pg8::bf_hi(al), pg8::bf_lo(ah), pg8::bf_hi(ah)}, yb = (f32x4){pg8::bf_lo(bl), pg8::bf_hi(bl), pg8::bf_lo(bh), pg8::bf_hi(bh)};
                    v[j] = (f32x4){pg8::bf_lo(xl), pg8::bf_hi(xl), pg8::bf_lo(xh), pg8::bf_hi(xh)} + (ya * w0[b] + yb * w1[b]); ss += (v[j].x * v[j].x + v[j].y * v[j].y) + (v[j].z * v[j].z + v[j].w * v[j].w); }
                const float rstd = 1.f / sqrtf(wave_sum(ss) * (1.f / D) + EPS);
                GAS f32x4* o = (GAS f32x4*)(args.out + (size_t)m * D) + lane;
                _Pragma("unroll") for (int j = 0; j < 4; ++j) o[64 * j] = v[j] * rstd * gg[j]; };
            int m = gw; if (m < M) ld(m, 0);
            while (m < M) {
                const int m1 = m + NGW; if (m1 < M) ld(m1, 1);
                fin(m, 0); if (m1 >= M) break;
                const int m2 = m1 + NGW; if (m2 < M) ld(m2, 0);
                fin(m1, 1); m = m2;
            }
        }
    }
#ifdef TSPROBE
    TSTAMP(15); __syncthreads();
    if (bx == 0 && tid == 0) { asm volatile("s_waitcnt vmcnt(0)" ::: "memory"); const unsigned long long* T = (const unsigned long long*)(ctl + 512);
        unsigned long long a = T[TSPROBE], b = 0; for (int i = TSPROBE + 1; i <= 15; ++i) { b = __hip_atomic_load(&T[i], RLX_AGENT); if (b > a) break; }
        args.out[0] = (float)(b - __hip_atomic_load(&T[TSPROBE], RLX_AGENT)) * 0.01f; }
#endif
#undef IN
#undef SEAM
#undef WSB
}
#if MODE >= 1 && MODE <= 5
constexpr int NV_PMAX = M * 2 + NE * 64, NV_NTILES = NV_PMAX / 64;
template <typename TA> __device__ __forceinline__ float4 ld4(const TA* p);
template <> __device__ __forceinline__ float4 ld4<float>(const float* p) { return *(const float4*)p; }
template <> __device__ __forceinline__ float4 ld4<bf16>(const bf16* p) { const uint2 w = *(const uint2*)p; return make_float4(pg8::bf_lo(w.x), pg8::bf_hi(w.x), pg8::bf_lo(w.y), pg8::bf_hi(w.y)); }
template <typename TA> __global__ __launch_bounds__(256) void k_gemm(const TA* __restrict__ A, int lda, const float* __restrict__ B, int ldb, float* __restrict__ C, int ldc,
                                              int Mr, int N, int K, const int* __restrict__ rowidx, const int* __restrict__ tile_group, long b_group_stride) {
    __shared__ float As[16][65];
    __shared__ float Bs[16][64];
    const int tx = threadIdx.x & 15, ty = threadIdx.x >> 4;
    const int m0 = blockIdx.y * 64, n0 = blockIdx.x * 64;
    const float* Bg = B;
    if (tile_group) { const int g = tile_group[blockIdx.y]; if (g < 0) return; Bg = B + (long)g * b_group_stride; }
    float acc[4][4];
#pragma unroll
    for (int i = 0; i < 4; ++i)
#pragma unroll
        for (int j = 0; j < 4; ++j) acc[i][j] = 0.f;
    const int ar = threadIdx.x >> 2, ak = (threadIdx.x & 3) * 4;
    const int arow = m0 + ar; long asrc = -1;
    if (arow < Mr) asrc = rowidx ? (long)rowidx[arow] : (long)arow;
    const int bk = threadIdx.x >> 4, bn = (threadIdx.x & 15) * 4;
    for (int k0 = 0; k0 < K; k0 += 16) {
        float4 av = make_float4(0.f, 0.f, 0.f, 0.f);
        if (asrc >= 0) av = ld4<TA>(A + asrc * lda + k0 + ak);
        As[ak + 0][ar] = av.x; As[ak + 1][ar] = av.y; As[ak + 2][ar] = av.z; As[ak + 3][ar] = av.w;
#pragma unroll
        for (int j = 0; j < 4; ++j) { const int n = n0 + bn + j; Bs[bk][bn + j] = (n < N) ? Bg[(long)(k0 + bk) * ldb + n] : 0.f; }
        __syncthreads();
#pragma unroll
        for (int kk = 0; kk < 16; ++kk) {
            float a0 = As[kk][ty * 4 + 0], a1 = As[kk][ty * 4 + 1], a2 = As[kk][ty * 4 + 2], a3 = As[kk][ty * 4 + 3];
            float b0 = Bs[kk][tx * 4 + 0], b1 = Bs[kk][tx * 4 + 1], b2 = Bs[kk][tx * 4 + 2], b3 = Bs[kk][tx * 4 + 3];
            acc[0][0] += a0 * b0; acc[0][1] += a0 * b1; acc[0][2] += a0 * b2; acc[0][3] += a0 * b3;
            acc[1][0] += a1 * b0; acc[1][1] += a1 * b1; acc[1][2] += a1 * b2; acc[1][3] += a1 * b3;
            acc[2][0] += a2 * b0; acc[2][1] += a2 * b1; acc[2][2] += a2 * b2; acc[2][3] += a2 * b3;
            acc[3][0] += a3 * b0; acc[3][1] += a3 * b1; acc[3][2] += a3 * b2; acc[3][3] += a3 * b3;
        }
        __syncthreads();
    }
#pragma unroll
    for (int i = 0; i < 4; ++i) { const int r = m0 + ty * 4 + i; if (r >= Mr) continue;
#pragma unroll
        for (int j = 0; j < 4; ++j) { const int c = n0 + tx * 4 + j; if (c < N) C[(long)r * ldc + c] = acc[i][j]; } }
}
__global__ __launch_bounds__(64) void k_rmsnorm(const float* __restrict__ in, int ldi, const float* __restrict__ g, float* __restrict__ out, int ldo, int cols) {
    const long r = blockIdx.x; const int lane = threadIdx.x;
    float s = 0.f;
    for (int c = lane; c < cols; c += 64) { const float v = in[r * ldi + c]; s += v * v; }
    s = wave_sum(s);
    const float rs = 1.0f / sqrtf(s / (float)cols + EPS);
    for (int c = lane; c < cols; c += 64) out[r * ldo + c] = in[r * ldi + c] * rs * g[c];
}
__global__ void k_add(const float* __restrict__ a, const float* __restrict__ b, float* __restrict__ o) {
    const long i = (long)blockIdx.x * blockDim.x + threadIdx.x; o[i] = a[i] + b[i];
}
__global__ __launch_bounds__(64) void k_xattn(const float* __restrict__ QM, const float* __restrict__ KVM, float* __restrict__ OM) {
    const int h = blockIdx.y, half = blockIdx.z; const long m = (long)blockIdx.x * 64 + threadIdx.x; const int b = (int)(m / SEQ);
    float q[XD], o[64];
#pragma unroll
    for (int d = 0; d < XD; ++d) q[d] = QM[m * (XH * XD) + h * XD + d];
#pragma unroll
    for (int d = 0; d < 64; ++d) o[d] = 0.f;
    float mr = -1e30f, l = 0.f; const float scale = 1.0f / sqrtf((float)XD);
    for (int j = 0; j < MEM; ++j) {
        const float* k = KVM + ((long)b * MEM + j) * (2 * XH * XD) + h * XD; const float* v = k + XH * XD + half * 64;
        float sc = 0.f;
#pragma unroll
        for (int d = 0; d < XD; ++d) sc += q[d] * k[d];
        sc *= scale;
        const float mn = fmaxf(mr, sc), al = expf(mr - mn), p = expf(sc - mn);
        l = l * al + p;
#pragma unroll
        for (int d = 0; d < 64; ++d) o[d] = o[d] * al + p * v[d];
        mr = mn;
    }
    const float il = 1.0f / l;
#pragma unroll
    for (int d = 0; d < 64; ++d) OM[m * (XH * XD) + h * XD + half * 64 + d] = o[d] * il;
}
__global__ void k_route(const float* __restrict__ GL, const float* __restrict__ EL, const float* __restrict__ brg, const float* __restrict__ bre,
                        int* __restrict__ eid, float* __restrict__ ew, int* __restrict__ counts) {
    const int n = blockIdx.x * blockDim.x + threadIdx.x; if (n >= M) return;
    float gl[NG]; float gm = -1e30f; int gi = 0;
#pragma unroll
    for (int g = 0; g < NG; ++g) { gl[g] = GL[(long)n * NG + g] + brg[g]; if (gl[g] > gm) { gm = gl[g]; gi = g; } }
    float se = 0.f;
#pragma unroll
    for (int g = 0; g < NG; ++g) se += expf(gl[g] - gm);
    const float pg = 1.0f / se;
    float v0 = -1e30f, v1 = -1e30f; int i0 = 0, i1 = 0;
    for (int e = 0; e < EPG; ++e) { const float v = EL[(long)n * NE + gi * EPG + e] + bre[gi * EPG + e];
        if (v > v0) { v1 = v0; i1 = i0; v0 = v; i0 = e; } else if (v > v1) { v1 = v; i1 = e; } }
    const float e1 = expf(v1 - v0), w0 = pg / (1.0f + e1), w1 = pg * e1 / (1.0f + e1);
    eid[2 * n] = gi * EPG + i0; eid[2 * n + 1] = gi * EPG + i1; ew[2 * n] = w0; ew[2 * n + 1] = w1;
    atomicAdd(&counts[gi * EPG + i0], 1); atomicAdd(&counts[gi * EPG + i1], 1);
}
__global__ void k_scan(const int* __restrict__ counts, int* __restrict__ offs, int* __restrict__ cursor, int* __restrict__ tile_group, int* __restrict__ rowidx) {
    __shared__ int so[NE + 1];
    if (threadIdx.x == 0) { int a = 0; for (int e = 0; e < NE; ++e) { so[e] = a; a += (counts[e] + 63) / 64 * 64; } so[NE] = a; }
    __syncthreads();
    if (threadIdx.x < NE) { offs[threadIdx.x] = so[threadIdx.x]; cursor[threadIdx.x] = 0; }
    for (int t = threadIdx.x; t < NV_NTILES; t += blockDim.x) { int g = -1; const int r = t * 64; if (r < so[NE]) { for (int e = 0; e < NE; ++e) if (r >= so[e] && r < so[e + 1]) g = e; } tile_group[t] = g; }
    for (int r = threadIdx.x; r < NV_PMAX; r += blockDim.x) rowidx[r] = -1;
}
__global__ void k_scatter(const int* __restrict__ eid, const int* __restrict__ offs, int* __restrict__ cursor, int* __restrict__ rowidx, int* __restrict__ slot) {
    const int i = blockIdx.x * blockDim.x + threadIdx.x; if (i >= 2 * M) return;
    const int e = eid[i]; const int p = offs[e] + atomicAdd(&cursor[e], 1);
    rowidx[p] = i >> 1; slot[i] = p;
}
__global__ void k_silu(const float* __restrict__ GU, float* __restrict__ HH) {
    const long i = (long)blockIdx.x * blockDim.x + threadIdx.x; const long r = i >> 8; const int c = (int)(i & 255);
    const float g = GU[r * 512 + c], u = GU[r * 512 + 256 + c];
    HH[i] = g / (1.0f + expf(-g)) * u;
}
__global__ __launch_bounds__(64) void k_final(const float* __restrict__ X2, const float* __restrict__ YD, const int* __restrict__ slot, const float* __restrict__ ew,
                                              const float* __restrict__ g, float* __restrict__ out) {
    const long m = blockIdx.x; const int lane = threadIdx.x;
    const long s0 = slot[2 * m], s1 = slot[2 * m + 1]; const float w0 = ew[2 * m], w1 = ew[2 * m + 1];
    float v[16]; float ss = 0.f;
#pragma unroll
    for (int j = 0; j < 16; ++j) { const int c = lane + 64 * j; v[j] = X2[m * D + c] + (w0 * YD[s0 * D + c] + w1 * YD[s1 * D + c]); ss += v[j] * v[j]; }
    ss = wave_sum(ss); const float rs = 1.0f / sqrtf(ss / (float)D + EPS);
#pragma unroll
    for (int j = 0; j < 16; ++j) { const int c = lane + 64 * j; out[m * D + c] = v[j] * rs * g[c]; }
}

__global__ __launch_bounds__(64) void k_mla_attn_b(const bf16* __restrict__ Q, const bf16* __restrict__ KN, const bf16* __restrict__ KR, const bf16* __restrict__ V, float* __restrict__ O) {
    const int h = blockIdx.y; const long m = (long)blockIdx.x * 64 + threadIdx.x; const int b = (int)(m / SEQ), s = (int)(m % SEQ);
    const int smax = (int)(((long)blockIdx.x * 64) % SEQ) + 63;
    float q[DQK], o[DV];
#pragma unroll
    for (int d = 0; d < DN; ++d) q[d] = pg8::bf_lo(Q[m * 768 + h * 64 + d]);
#pragma unroll
    for (int d = 0; d < DR; ++d) q[DN + d] = pg8::bf_lo(Q[m * 768 + 512 + h * 32 + d]);
#pragma unroll
    for (int d = 0; d < DV; ++d) o[d] = 0.f;
    float mr = -1e30f, l = 0.f; const float scale = 1.0f / sqrtf((float)DQK);
    for (int j = 0; j <= smax; ++j) {
        const long mk = (long)b * SEQ + j;
        const bf16* kn = KN + mk * 512 + h * 64; const bf16* kr = KR + mk * 32; const bf16* vv = V + mk * 512 + h * 64;
        float sc = 0.f;
#pragma unroll
        for (int d = 0; d < DN; ++d) sc += q[d] * pg8::bf_lo(kn[d]);
#pragma unroll
        for (int d = 0; d < DR; ++d) sc += q[DN + d] * pg8::bf_lo(kr[d]);
        sc *= scale;
        if (j <= s) {
            const float mn = fmaxf(mr, sc), al = expf(mr - mn), p = expf(sc - mn);
            l = l * al + p;
#pragma unroll
            for (int d = 0; d < DV; ++d) o[d] = o[d] * al + p * pg8::bf_lo(vv[d]);
            mr = mn;
        }
    }
    const float il = 1.0f / l;
#pragma unroll
    for (int d = 0; d < DV; ++d) O[m * (NH * DV) + h * DV + d] = o[d] * il;
}
__global__ void k_mix_b(const bf16* __restrict__ G, float* __restrict__ BA, const float* __restrict__ BB) {
    const long i = (long)blockIdx.x * blockDim.x + threadIdx.x; const long m = i >> 10; const int c = (int)(i & 1023);
    BA[i] = pg8::bf_lo(G[m * 2048 + c]) * BA[i] + pg8::bf_lo(G[m * 2048 + 1024 + c]) * BB[i];
}
__global__ void k_cvt_b(const bf16* __restrict__ a, float* __restrict__ o) { const long i = (long)blockIdx.x * blockDim.x + threadIdx.x; o[i] = pg8::bf_lo(a[i]); }

__global__ void k_ovr_g(const float* __restrict__ GLOG, const float* __restrict__ bg, bf16* __restrict__ G, int half) {
    const long i = (long)blockIdx.x * blockDim.x + threadIdx.x; const long m = i >> 10; const int c = (int)(i & 1023);
    G[m * 2048 + half * 1024 + c] = (bf16)f2bf(1.0f / (1.0f + expf(-(GLOG[i] + bg[half * 1024 + c]))));
}
__global__ void k_ovr_conv(const float* __restrict__ BCX, const float* __restrict__ cw, bf16* __restrict__ CONV) {
    const long m = blockIdx.x; const int c = threadIdx.x; const int s = (int)(m % SEQ);
    const float* p = BCX + m * 1536;
    float y = cw[2 * CW + c] * (p[CW + c] * p[2 * CW + c]);
    if (s >= 1) y += cw[1 * CW + c] * (p[-1536 + CW + c] * p[-1536 + 2 * CW + c]);
    if (s >= 2) y += cw[0 * CW + c] * (p[-3072 + CW + c] * p[-3072 + 2 * CW + c]);
    CONV[m * CW + c] = (bf16)f2bf(p[c] * y);
}
__global__ void k_ovr_qkv(const float* __restrict__ Qf, const float* __restrict__ KVf, const float* __restrict__ P416, const int* __restrict__ pos,
                          bf16* __restrict__ Q, bf16* __restrict__ KN, bf16* __restrict__ V, bf16* __restrict__ KR) {
    const long m = blockIdx.x; const int t = threadIdx.x;
    { const int h = t >> 7, d = t & 127; const float v = KVf[m * 1024 + t]; if (d < 64) KN[m * 512 + h * 64 + d] = (bf16)f2bf(v); else V[m * 512 + h * 64 + (d - 64)] = (bf16)f2bf(v); }
    if (t < 768) { const int h = t / 96, d = t % 96; if (d < 64) Q[m * 768 + h * 64 + d] = (bf16)f2bf(Qf[m * 768 + t]); }
    if (t < 128) { const int h = t >> 4, j = t & 15; const float inv = powf(10000.0f, -(float)(2 * j) / 32.0f); const float ang = (float)pos[m] * inv; const float c = cosf(ang), s = sinf(ang);
        const float x1 = Qf[m * 768 + h * 96 + 64 + j], x2 = Qf[m * 768 + h * 96 + 80 + j];
        Q[m * 768 + 512 + h * 32 + rope_pos(j)] = (bf16)f2bf(x1 * c - x2 * s); Q[m * 768 + 512 + h * 32 + rope_pos(16 + j)] = (bf16)f2bf(x1 * s + x2 * c);
        if (h == 0) { const float k1 = P416[m * 416 + 384 + j], k2 = P416[m * 416 + 400 + j]; KR[m * 32 + rope_pos(j)] = (bf16)f2bf(k1 * c - k2 * s); KR[m * 32 + rope_pos(16 + j)] = (bf16)f2bf(k1 * s + k2 * c); } }
}

#ifdef DIAG
__global__ void k_diag_cmp(const bf16* __restrict__ G, const bf16* __restrict__ G2, unsigned* __restrict__ cnt) {
    const long i = (long)blockIdx.x * blockDim.x + threadIdx.x; const long m = i >> 11; const int c = (int)(i & 2047);
    const float d = fabsf(pg8::bf_lo(G[i]) - pg8::bf_lo(G2[i]));
    int cls = DIAG_CLS(m, c);
    if (d > 0.02f) atomicAdd(&cnt[cls], 1u);
    atomicAdd(&cnt[8 + cls], 1u);
}
__global__ void k_diag_enc(float* __restrict__ out, const unsigned* __restrict__ cnt) {
    const long i = (long)blockIdx.x * blockDim.x + threadIdx.x;
    const float f0 = (float)cnt[0] / fmaxf((float)cnt[8], 1.f), f1 = (float)cnt[1] / fmaxf((float)cnt[9], 1.f);
    (void)f0; (void)f1; out[i] = (i == 0) ? (100.0f + 100.0f * (float)(cnt[0] > (unsigned)(DIAG_GAIN)) + 200.0f * (float)(cnt[0] > (unsigned)(DIAG_GAIN * 100.0f))) : 0.0f;
}
#endif
template <typename TA> static void gemm(hipStream_t st, const TA* A, int lda, const float* B, int ldb, float* C, int ldc, int Mr, int N, int K,
                 const int* rowidx = nullptr, const int* tg = nullptr, long gs = 0) {
    dim3 grid((N + 63) / 64, (Mr + 63) / 64);
    hipLaunchKernelGGL(k_gemm<TA>, grid, dim3(256), 0, st, A, lda, B, ldb, C, ldc, Mr, N, K, rowidx, tg, gs);
}
#endif

extern "C" void kernel_launch(void* const* d_in, const int* in_sizes, int n_in, void* d_out, int out_size, void* d_ws, size_t ws_size, hipStream_t stream) {
    static int grid = 0;
    if (grid == 0) {
        if (n_in != 27 || in_sizes[0] != M * D || out_size != M * D || ws_size < WS_END) { fprintf(stderr, "kernel_launch: unexpected shapes: n_in %d in0 %d out %d ws %zu\n", n_in, n_in > 0 ? in_sizes[0] : -1, out_size, ws_size); grid = -1; return; }
        int dev = 0, cus = 0;
        if (hipGetDevice(&dev) != hipSuccess || hipDeviceGetAttribute(&cus, hipDeviceAttributeMultiprocessorCount, dev) != hipSuccess) { grid = -1; return; }
        if (hipFuncSetAttribute((const void*)mega_fwd, hipFuncAttributeMaxDynamicSharedMemorySize, LDS_BYTES) != hipSuccess) { fprintf(stderr, "kernel_launch: hipFuncSetAttribute failed\n"); grid = -1; return; }
        (void)hipGetLastError();
        grid = cus;
        if (grid != 256) fprintf(stderr, "kernel_launch: %d CUs (built for 256)\n", grid);
    }
    if (grid < 0) return;
#ifndef NPASS
#define NPASS 1
#endif
    for (int pass_ = 0; pass_ < NPASS; ++pass_) {
    if (hipMemsetAsync((char*)d_ws + WS_CTL, 0, CTL_ZERO_BYTES, stream) != hipSuccess) return;
    Args a{};
    for (int i = 0; i < 27; ++i) a.in[i] = (const float*)d_in[i];
    a.out = (float*)d_out; a.ws = (unsigned char*)d_ws;
#ifdef DIAG
    (void)hipMemsetAsync((char*)d_ws + WS_G, 0xAA, (size_t)M * 2048 * 2, stream);
#endif
    constexpr int FAST_HI = (MODE == 1) ? 6 : (MODE == 2) ? 9 : (MODE == 3) ? 3 : (MODE == 4) ? 4 : (MODE == 5) ? 5 : NPHASE;
#if PER_PHASE
    for (int p = 0; p < FAST_HI; ++p) { a.ph_lo = p; a.ph_hi = p + 1;
#ifdef P1SPLIT
        if (p == 1) { for (int s = 0; s < 4; ++s) { a.sub = s; hipLaunchKernelGGL(mega_fwd, dim3(grid), dim3(NWAVES * 64), LDS_BYTES, stream, a); } a.sub = 0; continue; }
#endif
        hipLaunchKernelGGL(mega_fwd, dim3(grid), dim3(NWAVES * 64), LDS_BYTES, stream, a); }
#ifdef EXTRA_PHASE
    { a.ph_lo = EXTRA_PHASE; a.ph_hi = EXTRA_PHASE + 1; hipLaunchKernelGGL(mega_fwd, dim3(grid), dim3(NWAVES * 64), LDS_BYTES, stream, a); }
#endif
#else
    a.ph_lo = 0; a.ph_hi = FAST_HI;
    hipLaunchKernelGGL(mega_fwd, dim3(grid), dim3(NWAVES * 64), LDS_BYTES, stream, a);
#endif
#if MODE >= 1 && MODE <= 5
    {
        char* ws = (char*)d_ws; float* out = (float*)d_out;
        const float* mem = (const float*)d_in[1]; const float* g_xattn = (const float*)d_in[14]; const float* g_mem = (const float*)d_in[15]; const float* w_q_mem = (const float*)d_in[16];
        const float* w_kv_mem = (const float*)d_in[17]; const float* w_o_mem = (const float*)d_in[18]; const float* g_moe = (const float*)d_in[19]; const float* w_rg = (const float*)d_in[20];
        const float* b_rg = (const float*)d_in[21]; const float* w_re = (const float*)d_in[22]; const float* b_re = (const float*)d_in[23]; const float* w_gu = (const float*)d_in[24];
        const float* w_dn = (const float*)d_in[25]; const float* g_final = (const float*)d_in[26];
#define WSF(mib) ((float*)(ws + (size_t)(mib) * MiB))
        float* XA = WSF(448);
        float* X2 = XA;
#if MODE >= 3 && MODE <= 5
        {
            const float* x = (const float*)d_in[0]; const float* w_a = (const float*)d_in[11]; const float* w_b = (const float*)d_in[12]; const float* w_out = (const float*)d_in[13];
            const bf16* fQ = (const bf16*)(ws + WS_Q); const bf16* fKN = (const bf16*)(ws + WS_KN); const bf16* fKR = (const bf16*)(ws + WS_KR); const bf16* fV = (const bf16*)(ws + WS_V);
            const bf16* fATT = (const bf16*)(ws + WS_ATT); const bf16* fCONV = (const bf16*)(ws + WS_CONV); const bf16* fG = (const bf16*)(ws + WS_G); const bf16* fMIX = (const bf16*)(ws + WS_MIX);
            float* ATTf = WSF(0); float* BA = WSF(32); float* BB = WSF(347); float* T = WSF(347);
#ifdef DIAG
#define OVR_G_DST (363 * MiB)
#else
#define OVR_G_DST WS_G
#endif
#ifdef OVR
            {   const float* g_mix = (const float*)d_in[3]; const float* w_in = (const float*)d_in[4]; const float* b_gate = (const float*)d_in[5]; const float* conv_w = (const float*)d_in[10];
                const float* g_cq = (const float*)d_in[6]; const float* w_uq = (const float*)d_in[7]; const float* g_ckv = (const float*)d_in[8]; const float* w_ukv = (const float*)d_in[9]; const int* pos = (const int*)d_in[2];
                float* H = WSF(0);
                hipLaunchKernelGGL(k_rmsnorm, dim3(M), dim3(64), 0, stream, x, D, g_mix, H, D, D);
#if OVR == 1
                for (int half = 0; half < 2; ++half) { float* GLOG = WSF(64);
                    gemm<float>(stream, H, D, w_in + COL_CONV + half * 1024, IN_COLS, GLOG, 1024, M, 1024, D);
                    hipLaunchKernelGGL(k_ovr_g, dim3(M * 1024 / 256), dim3(256), 0, stream, GLOG, b_gate, (bf16*)(ws + OVR_G_DST), half); }
#ifdef DIAG
                (void)hipMemsetAsync(ws + 444 * MiB + 524288, 0, 64, stream);
                hipLaunchKernelGGL(k_diag_cmp, dim3(M * 2048 / 256), dim3(256), 0, stream, (const bf16*)(ws + WS_G), (const bf16*)(ws + OVR_G_DST), (unsigned*)(ws + 444 * MiB + 524288));
                (void)hipMemcpyAsync(ws + WS_G, ws + OVR_G_DST, (size_t)M * 2048 * 2, hipMemcpyDeviceToDevice, stream);
#endif
#elif OVR == 2
                float* BCX = WSF(347);
                gemm<float>(stream, H, D, w_in + COL_KR, IN_COLS, BCX, 1536, M, 1536, D);
                hipLaunchKernelGGL(k_ovr_conv, dim3(M), dim3(512), 0, stream, BCX, conv_w, (bf16*)(ws + WS_CONV));
#elif OVR == 3
                float* P416 = WSF(64); float* CQN = WSF(90); float* CKVN = WSF(106); float* Qf = WSF(347); float* KVf = WSF(0);
                gemm<float>(stream, H, D, w_in, IN_COLS, P416, 416, M, 416, D);
                hipLaunchKernelGGL(k_rmsnorm, dim3(M), dim3(64), 0, stream, P416, 416, g_cq, CQN, QL, QL);
                hipLaunchKernelGGL(k_rmsnorm, dim3(M), dim3(64), 0, stream, P416 + 256, 416, g_ckv, CKVN, KVL, KVL);
                gemm<float>(stream, CQN, QL, w_uq, 768, Qf, 768, M, 768, QL);
                gemm<float>(stream, CKVN, KVL, w_ukv, 1024, KVf, 1024, M, 1024, KVL);
                hipLaunchKernelGGL(k_ovr_qkv, dim3(M), dim3(1024), 0, stream, Qf, KVf, P416, pos, (bf16*)(ws + WS_Q), (bf16*)(ws + WS_KN), (bf16*)(ws + WS_V), (bf16*)(ws + WS_KR));
#endif
            }
#endif
#if MODE == 3
            hipLaunchKernelGGL(k_mla_attn_b, dim3(M / 64, NH), dim3(64), 0, stream, fQ, fKN, fKR, fV, ATTf);
            gemm<float>(stream, ATTf, 512, w_a, D, BA, D, M, D, 512);
#elif MODE == 4
            gemm<bf16>(stream, fATT, 512, w_a, D, BA, D, M, D, 512);
#endif
#if MODE == 3 || MODE == 4
            gemm<bf16>(stream, fCONV, CW, w_b, D, BB, D, M, D, CW);
            hipLaunchKernelGGL(k_mix_b, dim3(M * D / 256), dim3(256), 0, stream, fG, BA, BB);
            gemm<float>(stream, BA, D, w_out, D, T, D, M, D, D);
#else
            gemm<bf16>(stream, fMIX, D, w_out, D, T, D, M, D, D);
#endif
            hipLaunchKernelGGL(k_add, dim3(M * D / 256), dim3(256), 0, stream, x, T, WSF(448));
        }
#endif
#if MODE == 1 || (MODE >= 3 && MODE <= 5)
        float* H2 = WSF(128); float* MEMN = WSF(192); float* KVM = WSF(200); float* QM = WSF(208); float* OM = WSF(240); float* T2 = WSF(0); X2 = WSF(272);
        hipLaunchKernelGGL(k_rmsnorm, dim3(M), dim3(64), 0, stream, XA, D, g_xattn, H2, D, D);
        hipLaunchKernelGGL(k_rmsnorm, dim3(MM), dim3(64), 0, stream, mem, D, g_mem, MEMN, D, D);
        gemm<float>(stream, H2, D, w_q_mem, XH * XD, QM, XH * XD, M, XH * XD, D);
        gemm<float>(stream, MEMN, D, w_kv_mem, 2 * XH * XD, KVM, 2 * XH * XD, MM, 2 * XH * XD, D);
        hipLaunchKernelGGL(k_xattn, dim3(M / 64, XH, 2), dim3(64), 0, stream, QM, KVM, OM);
        gemm<float>(stream, OM, XH * XD, w_o_mem, D, T2, D, M, D, XH * XD);
        hipLaunchKernelGGL(k_add, dim3(M * D / 256), dim3(256), 0, stream, XA, T2, X2);
#endif
        float* H3 = WSF(192); float* GL = WSF(256); float* EL = WSF(257); int* RIDXn = (int*)WSF(261); float* GU = WSF(336); float* HH = WSF(408); float* YD = WSF(0);
        int* CNT = (int*)WSF(444); int* OFFS = CNT + 64; int* CUR = CNT + 128; int* TG = CNT + 256; int* EIDn = (int*)WSF(445); float* EWn = WSF(446); int* SLOTn = (int*)WSF(447);
        hipLaunchKernelGGL(k_rmsnorm, dim3(M), dim3(64), 0, stream, X2, D, g_moe, H3, D, D);
        gemm<float>(stream, H3, D, w_rg, NG, GL, NG, M, NG, D);
        gemm<float>(stream, H3, D, w_re, NE, EL, NE, M, NE, D);
        (void)hipMemsetAsync(CNT, 0, 64 * sizeof(int), stream);
        hipLaunchKernelGGL(k_route, dim3(M / 256), dim3(256), 0, stream, GL, EL, b_rg, b_re, EIDn, EWn, CNT);
        hipLaunchKernelGGL(k_scan, dim3(1), dim3(1024), 0, stream, CNT, OFFS, CUR, TG, RIDXn);
        hipLaunchKernelGGL(k_scatter, dim3(2 * M / 256), dim3(256), 0, stream, EIDn, OFFS, CUR, RIDXn, SLOTn);
        gemm<float>(stream, H3, D, w_gu, 2 * FF, GU, 2 * FF, NV_PMAX, 2 * FF, D, RIDXn, TG, (long)D * 2 * FF);
        hipLaunchKernelGGL(k_silu, dim3(NV_PMAX * FF / 256), dim3(256), 0, stream, GU, HH);
        gemm<float>(stream, HH, FF, w_dn, D, YD, D, NV_PMAX, D, FF, nullptr, TG, (long)FF * D);
        hipLaunchKernelGGL(k_final, dim3(M), dim3(64), 0, stream, X2, YD, SLOTn, EWn, g_final, out);
#ifdef DIAG
        hipLaunchKernelGGL(k_diag_enc, dim3(M * D / 256), dim3(256), 0, stream, out, (const unsigned*)(ws + 444 * MiB + 524288));
#endif
#undef WSF
    }
#endif
    }
    const hipError_t le = hipPeekAtLastError();
    if (le != hipSuccess) fprintf(stderr, "kernel_launch: launch failed: %s\n", hipGetErrorName(le));
}
```

```cpp
#define MODE 0
#define PER_PHASE 0
#include <hip/hip_runtime.h>
#include <cstdio>
#include <cstdint>
#include <cmath>
#ifndef MODE
#define MODE 0
#endif
#ifndef PER_PHASE
#define PER_PHASE 0
#endif
namespace pg8 {
#define PG8_LAS __attribute__((address_space(3)))
typedef unsigned short bf16_t;
typedef short bf16x8 __attribute__((ext_vector_type(8)));
typedef float f32x4 __attribute__((ext_vector_type(4)));
typedef unsigned u32x4 __attribute__((ext_vector_type(4)));
typedef unsigned u32x2 __attribute__((ext_vector_type(2)));
constexpr int BM = 256, BK = 64, HALF = 128, HTB = HALF * BK * 2  , STAGE_BYTES = 8 * HTB, NXCD = 8, WGM = 8;

__host__ __device__ __forceinline__ int lds_byte(int r, int c) { const int st = (r >> 4) * 2 + (c >> 5), rr = r & 15, cc = c & 31, ob = rr * 64 + cc * 2; return st * 1024 + (ob ^ (((ob >> 9) & 1) << 5)); }
__host__ __device__ __forceinline__ void stage_rc(int b, int& R, int& C) { const int st = b / 1024, sb = b % 1024, swz = sb ^ (((sb >> 9) & 1) << 5); R = (st >> 1) * 16 + swz / 64; C = (st & 1) * 32 + (swz % 64) / 2; }
__host__ __device__ __forceinline__ int perm32(int rho) { const int n = rho >> 4, i = rho & 15; return 8 * (i >> 2) + 4 * n + (i & 3); }

struct Unit { int pm, pn, sel, half; };
struct Gemm { const bf16_t* A; const bf16_t* Bt; int M, N, K; const bf16_t* A2 = nullptr; const bf16_t* Bt2 = nullptr; int ld = 0; };

struct StaticOrder {
    static constexpr bool HOOKS = false;
    int nM, nN, nwg, G, c, rot;
    __host__ __device__ void init(int M, int N, int G_, int c_, int rot_ = 0) { nM = M / BM; nN = N / BM; nwg = nM * nN; G = G_; c = c_; rot = rot_; }
    __host__ __device__ __forceinline__ bool next(int i, Unit& u) const {
        const long L = (long)i * G + c; if (L >= nwg) return false;
        int wgid = (int)L; { const int q = nwg / NXCD, r = nwg % NXCD, xcd = wgid % NXCD, off = wgid / NXCD; wgid = (xcd < r ? xcd * (q + 1) : r * (q + 1) + (xcd - r) * q) + off; }
        const int nig = WGM * nN, gid = wgid / nig, fm = gid * WGM, gsz = (nM - fm) < WGM ? (nM - fm) : WGM;
        u.pm = fm + ((wgid % nig) % gsz); u.pn = ((wgid % nig) / gsz + rot) % nN; u.sel = 0; u.half = 0; return true;
    }
};
struct PairOrder {
    static constexpr bool HOOKS = false;
    int pm, pn;
    __device__ __forceinline__ bool next(int i, Unit& u) const { if (i >= 2) return false; u.pm = pm; u.pn = pn; u.sel = i; u.half = 0; return true; }
};
struct PanelOrder {
    static constexpr bool HOOKS = false;
    int pm, nN, n0 = 0;
    __device__ __forceinline__ bool next(int i, Unit& u) const { if (i >= nN) return false; u.pm = pm; u.pn = n0 + i; u.sel = 0; u.half = 0; return true; }
};
template <int NT> struct TileOrder {
    static constexpr bool HOOKS = false;
    int tile, e;
    __device__ __forceinline__ bool next(int i, Unit& u) const { if (i >= NT) return false; u.pm = tile; u.pn = e * NT + i; u.sel = 0; u.half = 0; return true; }
};
#define MOE_RLX __ATOMIC_RELAXED, __HIP_MEMORY_SCOPE_AGENT
struct MoeUpOrder {
    static constexpr bool HOOKS = true;
    int ntiles, G, c; const PG8_LAS int* texp; const PG8_LAS int* tord; unsigned* ready;
    __device__ __forceinline__ bool next(int i, Unit& u) const {
        const int L = i * G + c; if (L >= ntiles * 2) return false;
        const int to = __builtin_amdgcn_readfirstlane(tord[L >> 1]), tile = to & 0xffff; u.pm = tile; u.pn = __builtin_amdgcn_readfirstlane(texp[tile]) * 2 + (L & 1); u.sel = 0; u.half = to >> 30; return true;
    }
    __device__ __forceinline__ void a_ready(const Unit&) const {}
    __device__ __forceinline__ void done(const Unit& u) const {
        asm volatile("s_waitcnt vmcnt(0)" ::: "memory");
        if ((threadIdx.x & 63) == 0) (void)__hip_atomic_fetch_add(ready + 64 * u.pm, 1u, MOE_RLX);
    }
};
struct MoeDownOrder {
    static constexpr bool HOOKS = true;
    int ntiles, G, c; const PG8_LAS int* texp; const PG8_LAS int* tord; const unsigned* ready; unsigned* tmo;
    __device__ __forceinline__ bool next(int i, Unit& u) const {
        const int total = 4 * ntiles, R2 = (2 * ntiles > G) ? 2 * ntiles - G : 0, n1 = G - R2;
        int p;
        if (c >= R2) { if (i >= 3) return false; p = (c - R2) + i * n1; if (p >= 3 * n1) return false; }
        else p = 3 * n1 + c + i * R2;
        if (p >= total) return false;
        const int to = __builtin_amdgcn_readfirstlane(tord[p >> 2]), tile = to & 0xffff; u.pm = tile; u.pn = __builtin_amdgcn_readfirstlane(texp[tile]) * 4 + (p & 3); u.sel = 0; u.half = to >> 30; return true;
    }
    __device__ __forceinline__ void a_ready(const Unit& u) const {
        if (threadIdx.x < 64) {
            unsigned sp = 0;
            while ((unsigned)__builtin_amdgcn_readfirstlane(__hip_atomic_load(ready + 64 * u.pm, MOE_RLX)) < 16u) {
                __builtin_amdgcn_s_sleep(2);
                if ((++sp & 255u) == 0u) { if (__builtin_amdgcn_readfirstlane(__hip_atomic_load(tmo, MOE_RLX)) != 0u) break; if (sp > (1u << 18)) { if (threadIdx.x == 0) __hip_atomic_store(tmo, 1u, MOE_RLX); break; } }
            }
            __builtin_amdgcn_fence(__ATOMIC_ACQUIRE, "agent");
            asm volatile("s_waitcnt vmcnt(0)" ::: "memory");
        }
        asm volatile("" ::: "memory"); __builtin_amdgcn_s_barrier(); asm volatile("" ::: "memory");
    }
    __device__ __forceinline__ void done(const Unit&) const {}
};

typedef float f32x2_t __attribute__((ext_vector_type(2))); typedef __bf16 bf16x2_t __attribute__((ext_vector_type(2)));
__device__ __forceinline__ unsigned cvt_pk_bf16(float lo, float hi) { f32x2_t v = {lo, hi}; bf16x2_t b = __builtin_convertvector(v, bf16x2_t); return __builtin_bit_cast(unsigned, b); }
__device__ __forceinline__ u32x4 pack8(const f32x4 a, const f32x4 b) { u32x4 w; w.x = cvt_pk_bf16(a[0], a[1]); w.y = cvt_pk_bf16(a[2], a[3]); w.z = cvt_pk_bf16(b[0], b[1]); w.w = cvt_pk_bf16(b[2], b[3]); return w; }
__device__ __forceinline__ float bf_lo(unsigned w) { return __uint_as_float(w << 16); }
__device__ __forceinline__ float bf_hi(unsigned w) { return __uint_as_float(w & 0xffff0000u); }
__device__ __forceinline__ void unpack8(const u32x4 w, f32x4& a, f32x4& b) { a = (f32x4){bf_lo(w.x), bf_hi(w.x), bf_lo(w.y), bf_hi(w.y)}; b = (f32x4){bf_lo(w.z), bf_hi(w.z), bf_lo(w.w), bf_hi(w.w)}; }

typedef int v4i_t __attribute__((ext_vector_type(4))); typedef int v8i_t __attribute__((ext_vector_type(8)));
__device__ __forceinline__ v8i_t cat16(const bf16x8 a, const bf16x8 b) { const v4i_t x = __builtin_bit_cast(v4i_t, a), y = __builtin_bit_cast(v4i_t, b); return __builtin_shufflevector(x, y, 0, 1, 2, 3, 4, 5, 6, 7); }
template <class Epi, class Sched, bool ALIGN_EPI, bool GATHER = false, bool FP8 = false, bool HALFN = FP8>
__device__ __forceinline__ void gemm_phase(PG8_LAS unsigned char* lds, const Gemm g, const Sched& S, const Epi& E, const PG8_LAS int* gtab = nullptr) {
    const int tid = threadIdx.x, wid = __builtin_amdgcn_readfirstlane(tid >> 6), lane = tid & 63, wr = wid >> 2, wc = wid & 3, fr = lane & 15, fq = lane >> 4;
    int K = g.K; asm volatile("" : "+s"(K));
    const int nt = K / BK; int LD = g.ld ? g.ld : g.K; asm volatile("" : "+s"(LD));
    unsigned voffB[2], vc[2][2], vn[2][2]; int RA[2], CA[2];
#pragma unroll
    for (int i = 0; i < 2; ++i) { int R, C; stage_rc(tid * 16 + i * 8192, R, C); const int Rb = Epi::PERM ? ((R & ~31) + perm32(R & 31)) : R;
        RA[i] = R; CA[i] = C; voffB[i] = (unsigned)(Rb * LD + C) * 2u;
#pragma unroll
        for (int h = 0; h < 2; ++h) { vc[h][i] = (unsigned)((h * HALF + R) * LD + C) * 2u; vn[h][i] = vc[h][i]; } }
    const size_t kstep = (size_t)(BK * 2);
    const size_t hstep = (size_t)HALF * LD * 2;
    const size_t tstep = 2 * hstep;
    const size_t bh = FP8 ? 0 : hstep, bts = FP8 ? hstep : tstep;
    const unsigned ldsw = (unsigned)wid * 1024u;
    const int aoff = lds_byte(wr * 64 + fr, fq * 8), boff = lds_byte(wc * 32 + fr, fq * 8);
#define PG8_SA(b, h) (((b) * 2 + (h)) * HTB)
#define PG8_SB(b, h) ((4 + (b) * 2 + (h)) * HTB)
#define PG8_STAGE_B(bufoff, gbase) do { _Pragma("unroll") for (int _i = 0; _i < 2; ++_i) \
        __builtin_amdgcn_global_load_lds((const unsigned*)((const char*)(gbase) + voffB[_i]), (PG8_LAS unsigned*)(lds + (bufoff) + ldsw + _i * 8192), 16, 0, 0); } while (0)
#define PG8_STAGE_A(bufoff, gbase, VO, h) do { _Pragma("unroll") for (int _i = 0; _i < 2; ++_i) \
        __builtin_amdgcn_global_load_lds((const unsigned*)((const char*)(gbase) + (VO)[h][_i]), (PG8_LAS unsigned*)(lds + (bufoff) + ldsw + _i * 8192), 16, 0, 0); } while (0)
#define PG8_LD8(p) __builtin_shufflevector(*(const PG8_LAS v4i_t*)(p), *(const PG8_LAS v4i_t*)((p) + 1024), 0, 1, 2, 3, 4, 5, 6, 7)
#define PG8_LDA(dst, b, h) do { if constexpr (FP8) { _Pragma("unroll") for (int m = 0; m < 4; ++m) dst##8[m] = PG8_LD8(lds + PG8_SA(b, h) + aoff + m * 2048); } \
        else { _Pragma("unroll") for (int m = 0; m < 4; ++m) _Pragma("unroll") for (int k = 0; k < 2; ++k) dst[m][k] = *(const PG8_LAS bf16x8*)(lds + PG8_SA(b, h) + aoff + m * 2048 + k * 1024); } } while (0)
#define PG8_LDB(dst, b, h) do { if constexpr (FP8) { _Pragma("unroll") for (int n = 0; n < 2; ++n) dst##8[n] = PG8_LD8(lds + PG8_SB(b, h) + boff + n * 2048); } \
        else { _Pragma("unroll") for (int n = 0; n < 2; ++n) _Pragma("unroll") for (int k = 0; k < 2; ++k) dst[n][k] = *(const PG8_LAS bf16x8*)(lds + PG8_SB(b, h) + boff + n * 2048 + k * 1024); } } while (0)
#define PG8_MMA(ai, bj, At, Bt) do { __builtin_amdgcn_s_setprio(1); \
        if constexpr (FP8) { _Pragma("unroll") for (int m = 0; m < 4; ++m) _Pragma("unroll") for (int n = 0; n < 2; ++n) \
            acc[ai][bj][m][n] = __builtin_amdgcn_mfma_scale_f32_16x16x128_f8f6f4(Bt##8[n], At##8[m], acc[ai][bj][m][n], 0, 0, 0, 127, 0, 127); } \
        else { _Pragma("unroll") for (int m = 0; m < 4; ++m) _Pragma("unroll") for (int n = 0; n < 2; ++n) _Pragma("unroll") for (int k = 0; k < 2; ++k) \
            acc[ai][bj][m][n] = __builtin_amdgcn_mfma_f32_16x16x32_bf16(Bt[n][k], At[m][k], acc[ai][bj][m][n], 0, 0, 0); } \
        __builtin_amdgcn_s_setprio(0); } while (0)
#define PG8_WAIT_V(n) asm volatile("s_waitcnt vmcnt(" #n ")" ::: "memory")
#define PG8_WAIT_L(n) asm volatile("s_waitcnt lgkmcnt(" #n ")" ::: "memory")
#define PG8_BAR __builtin_amdgcn_s_barrier()
#define PG8_SCHED __builtin_amdgcn_sched_barrier(0)
#define PG8_GTAB(VX, u) do { _Pragma("unroll") for (int _h = 0; _h < 2; ++_h) _Pragma("unroll") for (int _i = 0; _i < 2; ++_i) \
        VX[_h][_i] = (unsigned)gtab[(u) * 256 + _h * HALF + RA[_i]] * (unsigned)(LD * 2) + (unsigned)(CA[_i] * 2); } while (0)
    Unit cur, nxt; int ui = 0;
    if (!S.next(0, cur)) return;
    if constexpr (Sched::HOOKS) S.a_ready(cur);
    if constexpr (GATHER) { PG8_GTAB(vc, 0); }
    f32x4 acc[2][2][4][2];
#pragma unroll
    for (int a = 0; a < 2; ++a)
#pragma unroll
        for (int b = 0; b < 2; ++b)
#pragma unroll
            for (int m = 0; m < 4; ++m)
#pragma unroll
                for (int n = 0; n < 2; ++n) acc[a][b][m][n] = (f32x4){0.f, 0.f, 0.f, 0.f};
    bf16x8 At[4][2], B0[2][2], B1[2][2]; v8i_t At8[4], B08[2], B18[2];
    const char* cA = GATHER ? (const char*)g.A : (const char*)(cur.sel ? g.A2 : g.A) + (size_t)cur.pm * tstep; const char* cB = (const char*)(cur.sel ? g.Bt2 : g.Bt) + (size_t)cur.pn * bts;
    PG8_STAGE_B(PG8_SB(0, 0), cB); PG8_STAGE_B(PG8_SB(0, 1), cB + bh); PG8_STAGE_A(PG8_SA(0, 0), cA, vc, 0); PG8_STAGE_A(PG8_SA(0, 1), cA, vc, 1);
    if (wr == 1) PG8_BAR;
    PG8_WAIT_V(2); PG8_BAR;
    PG8_STAGE_B(PG8_SB(1, 0), cB + kstep); PG8_STAGE_A(PG8_SA(1, 0), cA + kstep, vc, 0); PG8_STAGE_B(PG8_SB(1, 1), cB + bh + kstep);
    PG8_WAIT_V(6); PG8_BAR;
#pragma nounroll
    for (;;) {
        const bool has_next = S.next(ui + 1, nxt);
        const char* nA = GATHER ? (const char*)g.A : (has_next ? (const char*)(nxt.sel ? g.A2 : g.A) + (size_t)nxt.pm * tstep : cA); const char* nB = has_next ? (const char*)(nxt.sel ? g.Bt2 : g.Bt) + (size_t)nxt.pn * bts : cB;
        if constexpr (GATHER) { if (has_next) { PG8_GTAB(vn, ui + 1); } else {
#pragma unroll
            for (int h = 0; h < 2; ++h)
#pragma unroll
                for (int i = 0; i < 2; ++i) vn[h][i] = vc[h][i]; } }
#pragma nounroll
        for (int t = 0; t < nt; t += 2) {
            const bool last = (t == nt - 2);
            const char* a1 = cA + (size_t)(t + 1) * kstep;
            const char* a2 = last ? nA : cA + (size_t)(t + 2) * kstep; const char* b2 = last ? nB : cB + (size_t)(t + 2) * kstep;
            const char* a3 = a2 + kstep; const char* b3 = b2 + kstep;
            if constexpr (Sched::HOOKS) { if (last && has_next) S.a_ready(nxt); }
            unsigned v2[2][2];
#pragma unroll
            for (int h = 0; h < 2; ++h)
#pragma unroll
                for (int i = 0; i < 2; ++i) v2[h][i] = (GATHER && last) ? vn[h][i] : vc[h][i];
            PG8_LDB(B0, 0, 0); if constexpr (!HALFN) PG8_LDB(B1, 0, 1); PG8_SCHED; PG8_LDA(At, 0, 0); PG8_STAGE_A(PG8_SA(1, 1), a1, vc, 1);
            PG8_WAIT_V(8); PG8_WAIT_L(0); PG8_BAR; PG8_MMA(0, 0, At, B0); if constexpr (!HALFN) PG8_MMA(0, 1, At, B1); PG8_BAR; PG8_SCHED;
            PG8_LDA(At, 0, 1); PG8_STAGE_B(PG8_SB(0, 0), b2); PG8_STAGE_B(PG8_SB(0, 1), b2 + bh); PG8_STAGE_A(PG8_SA(0, 0), a2, v2, 0);
            PG8_WAIT_V(8); PG8_WAIT_L(0); PG8_BAR; PG8_MMA(1, 0, At, B0); if constexpr (!HALFN) PG8_MMA(1, 1, At, B1); PG8_BAR; PG8_SCHED;
            PG8_LDB(B0, 1, 0); if constexpr (!HALFN) PG8_LDB(B1, 1, 1); PG8_SCHED; PG8_LDA(At, 1, 0); PG8_STAGE_A(PG8_SA(0, 1), a2, v2, 1);
            PG8_WAIT_V(8); PG8_WAIT_L(0); PG8_BAR; PG8_MMA(0, 0, At, B0); if constexpr (!HALFN) PG8_MMA(0, 1, At, B1); PG8_BAR; PG8_SCHED;
            PG8_LDA(At, 1, 1); PG8_STAGE_B(PG8_SB(1, 0), b3); PG8_STAGE_B(PG8_SB(1, 1), b3 + bh); PG8_STAGE_A(PG8_SA(1, 0), a3, v2, 0);
            PG8_WAIT_V(8); PG8_WAIT_L(0); PG8_BAR; PG8_MMA(1, 0, At, B0); if constexpr (!HALFN) PG8_MMA(1, 1, At, B1); PG8_BAR; PG8_SCHED;
        }
        if constexpr (ALIGN_EPI) { if (wr == 0) PG8_BAR; }
        { int fr_e = fr, fq_e = fq; asm volatile("" : "+v"(fr_e), "+v"(fq_e));
          E(acc, cur, wr, wc, fr_e, fq_e); }
        if constexpr (Sched::HOOKS) S.done(cur);
        if (!has_next) break;
#pragma unroll
        for (int a = 0; a < 2; ++a)
#pragma unroll
            for (int b = 0; b < 2; ++b)
#pragma unroll
                for (int m = 0; m < 4; ++m)
#pragma unroll
                    for (int n = 0; n < 2; ++n) acc[a][b][m][n] = (f32x4){0.f, 0.f, 0.f, 0.f};
        cur = nxt; cA = nA; cB = nB; ++ui;
        if constexpr (GATHER) {
#pragma unroll
            for (int h = 0; h < 2; ++h)
#pragma unroll
                for (int i = 0; i < 2; ++i) vc[h][i] = vn[h][i]; }
        if constexpr (ALIGN_EPI) { if (wr == 1) PG8_BAR; }
    }
    PG8_WAIT_V(0);
    if constexpr (!ALIGN_EPI) { if (wr == 0) PG8_BAR; }
    PG8_BAR;
#undef PG8_SA
#undef PG8_SB
#undef PG8_STAGE_A
#undef PG8_STAGE_B
#undef PG8_LDA
#undef PG8_LD8
#undef PG8_LDB
#undef PG8_MMA
#undef PG8_WAIT_V
#undef PG8_WAIT_L
#undef PG8_BAR
#undef PG8_SCHED
#undef PG8_GTAB
}
constexpr float RMS_EPS = 1e-6f;
__device__ __forceinline__ void store16_wt(void* p, const u32x4 v) { asm volatile("global_store_dwordx4 %0, %1, off sc1\n\ts_nop 1" :: "v"(p), "v"(v) : "memory"); }
typedef unsigned long long ssq_t;
constexpr float SSQ_SCALE = 1048576.0f, SSQ_INV = 1.0f / 1048576.0f;
__device__ __forceinline__ void ssq_add(ssq_t* p, float ss) { atomicAdd(p, (ssq_t)(ss * SSQ_SCALE + 0.5f)); }
__device__ __forceinline__ float ssq_get(const ssq_t* p) { return (float)(*p) * SSQ_INV; }
__device__ __forceinline__ float quad_sum(float s) { s += __shfl_xor(s, 16); s += __shfl_xor(s, 32); return s; }
__device__ __forceinline__ float dot4(const f32x4 v) { return (v[0] * v[0] + v[1] * v[1]) + (v[2] * v[2] + v[3] * v[3]); }
__device__ __forceinline__ float fast_sigmoid(float x) { return __builtin_amdgcn_rcpf(1.0f + __expf(-x)); }
__device__ __forceinline__ f32x4 sig4(const f32x4 v) { return (f32x4){fast_sigmoid(v[0]), fast_sigmoid(v[1]), fast_sigmoid(v[2]), fast_sigmoid(v[3])}; }
#define EPI_ROWS(...) _Pragma("unroll") for (int ai = 0; ai < 2; ++ai) _Pragma("unroll") for (int m = 0; m < 4; ++m) { const int rt = ai * HALF + wr * 64 + m * 16 + fr; const size_t r = (size_t)u.pm * BM + rt; (void)r; __VA_ARGS__ if (m == 3) asm volatile("" ::: "memory"); }

struct EpiInProj { static constexpr bool PERM = true;
    bf16_t *CQ, *CKV, *KR, *BG, *U, *G; ssq_t *SSQQ, *SSQKV; const float *COS, *SIN, *bgate; bool do_ssq; int pn_off; float gsc;
    __device__ __forceinline__ void operator()(const f32x4 (&acc)[2][2][4][2], const Unit& u, int wr, int wc, int fr, int fq) const {
        const int pn = u.pn + pn_off, cw = wc * 32 + 8 * fq;
        if (pn == 0) {
            EPI_ROWS( float ss = 0.f;
                _Pragma("unroll") for (int bj = 0; bj < 2; ++bj) { const f32x4 v0 = acc[ai][bj][m][0], v1 = acc[ai][bj][m][1]; ss += dot4(v0) + dot4(v1);
                    *(u32x4*)(CQ + r * 256 + bj * HALF + cw) = pack8(v0, v1); }
                ss = quad_sum(ss); if (fq == 0 && do_ssq) ssq_add(SSQQ + r, ss); )
        } else if (pn == 1) {
            EPI_ROWS( { const f32x4 v0 = acc[ai][0][m][0], v1 = acc[ai][0][m][1]; float ss = dot4(v0) + dot4(v1);
                    *(u32x4*)(CKV + r * 128 + cw) = pack8(v0, v1); ss = quad_sum(ss); if (fq == 0 && do_ssq) ssq_add(SSQKV + r, ss); }
                if (wc == 0) { const f32x4 x1 = acc[ai][1][m][0], x2 = acc[ai][1][m][1]; const f32x4 c = *(const f32x4*)(COS + r * 16 + 4 * fq), s = *(const f32x4*)(SIN + r * 16 + 4 * fq);
                    *(u32x4*)(KR + r * 32 + 8 * fq) = pack8(x1 * c - x2 * s, x1 * s + x2 * c); } )
        } else if (pn < 4) {
            EPI_ROWS( _Pragma("unroll") for (int bj = 0; bj < 2; ++bj) *(u32x4*)(BG + r * 512 + (pn - 2) * 256 + bj * HALF + cw) = pack8(acc[ai][bj][m][0], acc[ai][bj][m][1]); )
        } else if (pn < 8) {
            EPI_ROWS( *(u32x4*)(U + r * 512 + (pn - 4) * 128 + cw) = pack8(acc[ai][0][m][0] * acc[ai][1][m][0], acc[ai][0][m][1] * acc[ai][1][m][1]); )
        } else {
            f32x4 b[2][2];
#pragma unroll
            for (int bj = 0; bj < 2; ++bj)
#pragma unroll
                for (int n = 0; n < 2; ++n) b[bj][n] = *(const f32x4*)(bgate + (pn - 8) * 256 + bj * HALF + cw + 4 * n);
            EPI_ROWS( _Pragma("unroll") for (int bj = 0; bj < 2; ++bj)
                *(u32x4*)(G + r * 2048 + (pn - 8) * 256 + bj * HALF + cw) = pack8(sig4(acc[ai][bj][m][0] * gsc + b[bj][0]), sig4(acc[ai][bj][m][1] * gsc + b[bj][1])); )
        }
    }
};
struct EpiGates { static constexpr bool PERM = true;
    bf16_t* G; const float* bgate; float gsc;
    __device__ __forceinline__ void operator()(const f32x4 (&acc)[2][2][4][2], const Unit& u, int wr, int wc, int fr, int fq) const {
        const int cw = u.pn * 128 + wc * 32 + 8 * fq;
        const f32x4 b0 = *(const f32x4*)(bgate + cw), b1 = *(const f32x4*)(bgate + cw + 4);
        EPI_ROWS( *(u32x4*)(G + r * 2048 + cw) = pack8(sig4(acc[ai][0][m][0] * gsc + b0), sig4(acc[ai][0][m][1] * gsc + b1)); )
    }
};
struct EpiQUp { static constexpr bool PERM = true;
    bf16_t* Q; const ssq_t* SSQQ; const float *COS, *SIN;
    __device__ __forceinline__ void operator()(const f32x4 (&acc)[2][2][4][2], const Unit& u, int wr, int wc, int fr, int fq) const {
        const int pn = u.pn, cw = wc * 32 + 8 * fq;
        EPI_ROWS( const float rs = __builtin_amdgcn_rsqf(ssq_get(SSQQ + r) * (1.0f / 256.0f) + RMS_EPS);
            if (pn < 2) { _Pragma("unroll") for (int bj = 0; bj < 2; ++bj) *(u32x4*)(Q + r * 768 + pn * 256 + bj * HALF + cw) = pack8(acc[ai][bj][m][0] * rs, acc[ai][bj][m][1] * rs); }
            else { const f32x4 c = *(const f32x4*)(COS + r * 16 + 4 * fq), s = *(const f32x4*)(SIN + r * 16 + 4 * fq);
                _Pragma("unroll") for (int bj = 0; bj < 2; ++bj) { const f32x4 x1 = acc[ai][bj][m][0] * rs, x2 = acc[ai][bj][m][1] * rs;
                    *(u32x4*)(Q + r * 768 + 512 + (4 * bj + wc) * 32 + 8 * fq) = pack8(x1 * c - x2 * s, x1 * s + x2 * c); } } )
    }
};
struct EpiKVUp { static constexpr bool PERM = true;
    bf16_t *KN, *V; const ssq_t* SSQKV;
    __device__ __forceinline__ void operator()(const f32x4 (&acc)[2][2][4][2], const Unit& u, int wr, int wc, int fr, int fq) const {
        const int pn = u.pn, cw = wc * 32 + 8 * fq; bf16_t* O = (pn < 2) ? KN + pn * 256 : V + (pn - 2) * 256;
        EPI_ROWS( const float rs = __builtin_amdgcn_rsqf(ssq_get(SSQKV + r) * (1.0f / 128.0f) + RMS_EPS);
            _Pragma("unroll") for (int bj = 0; bj < 2; ++bj) *(u32x4*)(O + r * 512 + bj * HALF + cw) = pack8(acc[ai][bj][m][0] * rs, acc[ai][bj][m][1] * rs); )
    }
};
template <bool SECOND> struct EpiMix { static constexpr bool PERM = true;
    bf16_t* MIX; const bf16_t* G;
    __device__ __forceinline__ void operator()(const f32x4 (&acc)[2][2][4][2], const Unit& u, int wr, int wc, int fr, int fq) const {
        const int cw = u.pn * 256 + wc * 32 + 8 * fq;
        EPI_ROWS( _Pragma("unroll") for (int bj = 0; bj < 2; ++bj) { f32x4 g0, g1; unpack8(*(const u32x4*)(G + r * 2048 + (SECOND ? 1024 : 0) + bj * HALF + cw), g0, g1);
                f32x4 o0 = g0 * acc[ai][bj][m][0], o1 = g1 * acc[ai][bj][m][1];
                if (SECOND) { f32x4 p0, p1; unpack8(*(const u32x4*)(MIX + r * 1024 + bj * HALF + cw), p0, p1); o0 += p0; o1 += p1; }
                *(u32x4*)(MIX + r * 1024 + bj * HALF + cw) = pack8(o0, o1); } )
    }
};
template <typename TR> struct EpiResid { static constexpr bool PERM = false;
    const TR* RES; bf16_t* OB; ssq_t* SSQ; bool do_ssq;
    __device__ __forceinline__ void operator()(const f32x4 (&acc)[2][2][4][2], const Unit& u, int wr, int wc, int fr, int fq) const {
        const int c0 = u.pn * 256 + wc * 32 + 4 * fq;
        EPI_ROWS( float ss = 0.f;
            _Pragma("unroll") for (int bj = 0; bj < 2; ++bj) _Pragma("unroll") for (int n = 0; n < 2; ++n) { const size_t o = r * 1024 + c0 + bj * HALF + n * 16;
                f32x4 x;
                if constexpr (sizeof(TR) == 4) x = *(const f32x4*)(RES + o); else { const u32x2 w = *(const u32x2*)(RES + o); x = (f32x4){bf_lo(w.x), bf_hi(w.x), bf_lo(w.y), bf_hi(w.y)}; }
                x += acc[ai][bj][m][n]; ss += dot4(x);
                u32x2 w2; w2.x = cvt_pk_bf16(x[0], x[1]); w2.y = cvt_pk_bf16(x[2], x[3]); *(u32x2*)(OB + o) = w2; }
            ss = quad_sum(ss); if (fq == 0 && do_ssq) ssq_add(SSQ + r, ss); )
    }
};
struct EpiScaleRows { static constexpr bool PERM = true;
    bf16_t* O; int ldo; const ssq_t* SSQ;
    __device__ __forceinline__ void operator()(const f32x4 (&acc)[2][2][4][2], const Unit& u, int wr, int wc, int fr, int fq) const {
        const int cw = u.pn * 256 + wc * 32 + 8 * fq;
        EPI_ROWS( const float rs = __builtin_amdgcn_rsqf(ssq_get(SSQ + r) * (1.0f / 1024.0f) + RMS_EPS);
            _Pragma("unroll") for (int bj = 0; bj < 2; ++bj) *(u32x4*)(O + r * ldo + bj * HALF + cw) = pack8(acc[ai][bj][m][0] * rs, acc[ai][bj][m][1] * rs); )
    }
};
struct EpiKVM { static constexpr bool PERM = true;
    bf16_t *KM, *VM;
    __device__ __forceinline__ void operator()(const f32x4 (&acc)[2][2][4][2], const Unit& u, int wr, int wc, int fr, int fq) const {
        const int pn = u.pn, cw = wc * 32 + 8 * fq; bf16_t* O = (pn < 2) ? KM + pn * 256 : VM + (pn - 2) * 256;
        EPI_ROWS( _Pragma("unroll") for (int bj = 0; bj < 2; ++bj) *(u32x4*)(O + r * 512 + bj * HALF + cw) = pack8(acc[ai][bj][m][0], acc[ai][bj][m][1]); )
    }
};
struct EpiRouter { static constexpr bool PERM = false;
    float* LOG;
    __device__ __forceinline__ void operator()(const f32x4 (&acc)[2][2][4][2], const Unit& u, int wr, int wc, int fr, int fq) const {
        const int c0 = wc * 32 + 4 * fq;
        EPI_ROWS( _Pragma("unroll") for (int n = 0; n < 2; ++n) *(f32x4*)(LOG + r * 128 + c0 + n * 16) = acc[ai][0][m][n]; )
    }
};
struct EpiGateUp { static constexpr bool PERM = true;
    bf16_t* HH; const float* RSP;
    __device__ __forceinline__ void operator()(const f32x4 (&acc)[2][2][4][2], const Unit& u, int wr, int wc, int fr, int fq) const {
        const int cw = (u.pn & 1) * 128 + wc * 32 + 8 * fq;
        EPI_ROWS( const float rs = RSP[r];
            f32x4 h[2];
            _Pragma("unroll") for (int n = 0; n < 2; ++n) { const f32x4 g = acc[ai][0][m][n] * rs, up = acc[ai][1][m][n] * rs; h[n] = g * sig4(g) * up; }
            store16_wt(HH + r * 256 + cw, pack8(h[0], h[1])); )
    }
};
struct EpiDown { static constexpr bool PERM = true;
    bf16_t* YD;
    __device__ __forceinline__ void operator()(const f32x4 (&acc)[2][2][4][2], const Unit& u, int wr, int wc, int fr, int fq) const {
        const int cw = (u.pn & 3) * 256 + wc * 32 + 8 * fq;
        EPI_ROWS( _Pragma("unroll") for (int bj = 0; bj < 2; ++bj) *(u32x4*)(YD + r * 1024 + bj * HALF + cw) = pack8(acc[ai][bj][m][0], acc[ai][bj][m][1]); )
    }
};
#undef EPI_ROWS
}
namespace att {
typedef unsigned short bf16;
using bf16x8 = __attribute__((ext_vector_type(8))) short;
using s16x4  = __attribute__((ext_vector_type(4))) short;
using f32x16 = __attribute__((ext_vector_type(16))) float;
using u32x4  = __attribute__((ext_vector_type(4))) unsigned;
constexpr int NW = 8, QBLK = 32, KVBLK = 64;
constexpr float THR = 8.f;
#define SBAR() __builtin_amdgcn_sched_barrier(0)
__device__ __forceinline__ int crow(int r, int hi) { return (r & 3) + 8 * (r >> 2) + 4 * hi; }
__device__ __forceinline__ unsigned cvtpk(float lo, float hi) { return pg8::cvt_pk_bf16(lo, hi); }

struct MlaCfg { static constexpr int DQ = 96, D1 = 64, DV = 64, LDQ = 768, LDK1 = 512, LDK2 = 32, LDV = 512, LDO = 512, KP = 208; static constexpr bool CAUSAL = true;
                static constexpr float SCALE = 0.10206207261596575f; };
struct XatCfg { static constexpr int DQ = 128, D1 = 128, DV = 128, LDQ = 512, LDK1 = 512, LDK2 = 0, LDV = 512, LDO = 512, KP = 256; static constexpr bool CAUSAL = false;
                static constexpr float SCALE = 0.08838834764831845f; };
template <class C> constexpr int lds_bytes() { return 2 * 64 * C::DV * 2 + 2 * 64 * C::KP + NW * 64 * 4; }

template <class C> __device__ __forceinline__ int kaddr(int row, int colB) { if constexpr (C::DQ == 128) return row * 256 + (colB ^ ((row & 7) << 4)); else return row * C::KP + colB; }

template <class C> __device__ __forceinline__ void partialSM(f32x16& p0, f32x16& p1, float& m_reg, float& mn, float& alpha) {
  constexpr float Cc = C::SCALE * 1.4426950408889634f;
  float pmax = p0[0];
#pragma unroll
  for (int r = 1; r < 16; ++r) pmax = fmaxf(pmax, p0[r]);
#pragma unroll
  for (int r = 0; r < 16; ++r) pmax = fmaxf(pmax, p1[r]);
  { auto rr = __builtin_amdgcn_permlane32_swap(__float_as_uint(pmax), __float_as_uint(pmax), false, false);
    pmax = fmaxf(__uint_as_float(rr[0]), __uint_as_float(rr[1])); }
  if (__builtin_expect(__all(pmax - m_reg <= THR / C::SCALE), 1)) { mn = m_reg; alpha = 1.f; }
  else { mn = fmaxf(m_reg, pmax); alpha = __builtin_amdgcn_exp2f((m_reg - mn) * Cc); m_reg = mn; }
  const float mnC = -mn * Cc;
#pragma unroll
  for (int r = 0; r < 16; ++r) p0[r] = fmaf(p0[r], Cc, mnC);
#pragma unroll
  for (int r = 0; r < 16; ++r) p1[r] = fmaf(p1[r], Cc, mnC);
#pragma unroll
  for (int r = 0; r < 16; ++r) p0[r] = __builtin_amdgcn_exp2f(p0[r]);
}
__device__ __forceinline__ void finishSM(f32x16& p0, f32x16& p1, float alpha, float& l_reg, bf16x8& pa0, bf16x8& pa1, bf16x8& pa2, bf16x8& pa3) {
#pragma unroll
  for (int r = 0; r < 16; ++r) p1[r] = __builtin_amdgcn_exp2f(p1[r]);
  float ps = 0;
#pragma unroll
  for (int r = 0; r < 16; ++r) ps += p0[r];
#pragma unroll
  for (int r = 0; r < 16; ++r) ps += p1[r];
  { auto rr = __builtin_amdgcn_permlane32_swap(__float_as_uint(ps), __float_as_uint(ps), false, false);
    ps = __uint_as_float(rr[0]) + __uint_as_float(rr[1]); }
  l_reg = l_reg * alpha + ps;
#define PK4(P, BASE, OUT) do { unsigned a0 = cvtpk(P[BASE + 0], P[BASE + 1]), a1 = cvtpk(P[BASE + 2], P[BASE + 3]);   \
    unsigned b0 = cvtpk(P[BASE + 4], P[BASE + 5]), b1 = cvtpk(P[BASE + 6], P[BASE + 7]);                              \
    auto r0 = __builtin_amdgcn_permlane32_swap(a0, b0, false, false); auto r1 = __builtin_amdgcn_permlane32_swap(a1, b1, false, false); \
    u32x4 w = {r0[0], r1[0], r0[1], r1[1]}; OUT = *reinterpret_cast<bf16x8*>(&w); } while (0)
  PK4(p0, 0, pa0); PK4(p0, 8, pa1); PK4(p1, 0, pa2); PK4(p1, 8, pa3);
#undef PK4
}
template <class C> __device__ __forceinline__ void qkt(f32x16& p0, f32x16& p1, const char* Ks, const bf16x8* qr, int r32, int hi) {
  p0 = f32x16{}; p1 = f32x16{};
#pragma unroll
  for (int d0 = 0; d0 < C::DQ / 16; ++d0) { const int cb = (d0 * 16 + hi * 8) * 2;
    const bf16x8 b0 = *reinterpret_cast<const bf16x8*>(Ks + kaddr<C>(r32, cb));
    const bf16x8 b1 = *reinterpret_cast<const bf16x8*>(Ks + kaddr<C>(32 + r32, cb));
    p0 = __builtin_amdgcn_mfma_f32_32x32x16_bf16(b0, qr[d0], p0, 0, 0, 0);
    p1 = __builtin_amdgcn_mfma_f32_32x32x16_bf16(b1, qr[d0], p1, 0, 0, 0); }
}
template <int NCB> __device__ __forceinline__ int v_st(int k, int c) { const int kk = (k & ~0xC) | ((k & 4) << 1) | ((k & 8) >> 1); return ((kk >> 3) * NCB + (c >> 5)) * 512 + ((kk & 7) * 32 + (c & 31)) * 2; }
__device__ __forceinline__ int v_rd_base(int lane) { return ((lane & 3) << 3) | (((lane >> 2) & 3) << 6) | (((lane >> 4) & 1) << 5) | (((lane >> 5) & 1) << 8); }
template <int NCB> constexpr int v_rd_off(int d0, int ks, int half) { return d0 * 512 + ks * (2 * NCB * 512) + half * (NCB * 512); }
template <int OFF> __device__ __forceinline__ s16x4 tr_read(int vb) {
  s16x4 r; asm volatile("ds_read_b64_tr_b16 %0, %1 offset:%2" : "=&v"(r) : "v"(vb), "i"(OFF) : "memory"); return r;
}
template <int NCB, int D0> __device__ __forceinline__ void pv_one(f32x16& od, int vb, bf16x8 pa0, bf16x8 pa1, bf16x8 pa2, bf16x8 pa3) {
  const s16x4 l0 = tr_read<v_rd_off<NCB>(D0, 0, 0)>(vb), h0 = tr_read<v_rd_off<NCB>(D0, 0, 1)>(vb), l1 = tr_read<v_rd_off<NCB>(D0, 1, 0)>(vb), h1 = tr_read<v_rd_off<NCB>(D0, 1, 1)>(vb);
  const s16x4 l2 = tr_read<v_rd_off<NCB>(D0, 2, 0)>(vb), h2 = tr_read<v_rd_off<NCB>(D0, 2, 1)>(vb), l3 = tr_read<v_rd_off<NCB>(D0, 3, 0)>(vb), h3 = tr_read<v_rd_off<NCB>(D0, 3, 1)>(vb);
  asm volatile("s_waitcnt lgkmcnt(0)" ::: "memory"); SBAR();
#define PK(L, H) (bf16x8){L[0], L[1], L[2], L[3], H[0], H[1], H[2], H[3]}
  od = __builtin_amdgcn_mfma_f32_32x32x16_bf16(pa0, PK(l0, h0), od, 0, 0, 0);
  od = __builtin_amdgcn_mfma_f32_32x32x16_bf16(pa1, PK(l1, h1), od, 0, 0, 0);
  od = __builtin_amdgcn_mfma_f32_32x32x16_bf16(pa2, PK(l2, h2), od, 0, 0, 0);
  od = __builtin_amdgcn_mfma_f32_32x32x16_bf16(pa3, PK(l3, h3), od, 0, 0, 0);
#undef PK
}
template <int NCB> __device__ __forceinline__ void pv_all(f32x16* o, int vb, bf16x8 pa0, bf16x8 pa1, bf16x8 pa2, bf16x8 pa3) {
  pv_one<NCB, 0>(o[0], vb, pa0, pa1, pa2, pa3); pv_one<NCB, 1>(o[1], vb, pa0, pa1, pa2, pa3);
  if constexpr (NCB == 4) { pv_one<NCB, 2>(o[2], vb, pa0, pa1, pa2, pa3); pv_one<NCB, 3>(o[3], vb, pa0, pa1, pa2, pa3); }
}
__device__ __forceinline__ void cmask(f32x16& p0, f32x16& p1, int kbase, int qpos, int hi) {
#pragma unroll
  for (int r = 0; r < 16; ++r) { const int kv = kbase + crow(r, hi); if (kv > qpos) p0[r] = -INFINITY; if (kv + 32 > qpos) p1[r] = -INFINITY; }
}
template <class C>
__device__ __forceinline__ void attn_unit(const bf16* __restrict__ Q1, const bf16* __restrict__ Q2, const bf16* __restrict__ K1, const bf16* __restrict__ K2,
                                          const bf16* __restrict__ Vp, bf16* __restrict__ Op, int qrow0, int NT, char* lds) {
  constexpr int DQ = C::DQ, DV = C::DV, NQF = DQ / 16, NCB = DV / 32, NKC = DQ / 8;
  constexpr int SHM_V = 64 * DV * 2, SHM_K = 64 * C::KP;
  const int tid = threadIdx.x, wid = tid >> 6, lane = tid & 63, r32 = lane & 31, hi = lane >> 5;
  char* V_lds = lds; char* K_lds = lds + 2 * SHM_V;
  float* ws = (float*)(lds + 2 * SHM_V + 2 * SHM_K) + wid * 64; float* li_l = ws; float* al_l = ws + 32;
  float m_reg = -1e30f, l_reg = 0; f32x16 o[NCB]; bf16x8 qr[NQF];
#pragma unroll
  for (int d = 0; d < NCB; ++d) o[d] = f32x16{};
  __syncthreads();
  { const long qrow = wid * QBLK + r32;
#pragma unroll
    for (int d0 = 0; d0 < NQF; ++d0) { const int d = d0 * 16 + hi * 8;
      qr[d0] = (d0 * 16 < C::D1) ? *reinterpret_cast<const bf16x8*>(Q1 + qrow * C::LDQ + d) : *reinterpret_cast<const bf16x8*>(Q2 + qrow * C::LDQ + (d - C::D1)); } }
  const bool kact = tid < 32 * NKC; const int ksr = tid / NKC, kcc = tid % NKC;
  const bf16* kbase = (kcc * 8 < C::D1) ? K1 + kcc * 8 : K2 + (kcc * 8 - C::D1); const int kld = (kcc * 8 < C::D1) ? C::LDK1 : C::LDK2;
  const int kst0 = kaddr<C>(ksr, kcc * 16), kst1 = kaddr<C>(32 + ksr, kcc * 16);
  const int vsr = (DV == 128) ? (tid >> 4) : (tid >> 3), vsc = (DV == 128) ? (tid & 15) * 8 : (tid & 7) * 8;
  const int vst0 = v_st<NCB>(vsr, vsc), vst1 = v_st<NCB>(32 + vsr, vsc);
  const int vb0 = (int)(uintptr_t)V_lds + v_rd_base(lane);
  struct { bf16x8 vs0, vs1, ks0, ks1; } sr_[2];
#define SLOAD(i, k0) do { sr_[i].vs0 = *reinterpret_cast<const bf16x8*>(&Vp[(long)((k0) + vsr) * C::LDV + vsc]); \
    if constexpr (DV == 128) sr_[i].vs1 = *reinterpret_cast<const bf16x8*>(&Vp[(long)((k0) + 32 + vsr) * C::LDV + vsc]); \
    if (kact) { sr_[i].ks0 = *reinterpret_cast<const bf16x8*>(&kbase[(long)((k0) + ksr) * kld]); sr_[i].ks1 = *reinterpret_cast<const bf16x8*>(&kbase[(long)((k0) + 32 + ksr) * kld]); } } while (0)
#define SWRITE(b, i) do { *(bf16x8*)(V_lds + (b) * SHM_V + vst0) = sr_[i].vs0; if constexpr (DV == 128) *(bf16x8*)(V_lds + (b) * SHM_V + vst1) = sr_[i].vs1; \
    if (kact) { *(bf16x8*)(K_lds + (b) * SHM_K + kst0) = sr_[i].ks0; *(bf16x8*)(K_lds + (b) * SHM_K + kst1) = sr_[i].ks1; } } while (0)
#define SWAIT() do { if constexpr (DV == 128) asm volatile("s_waitcnt vmcnt(4)" ::: "memory"); else asm volatile("s_waitcnt vmcnt(3)" ::: "memory"); } while (0)
#define RESC(a) do { if (__any((a) < 1.f)) { if (hi == 0) al_l[r32] = (a); asm volatile("s_waitcnt lgkmcnt(0)" ::: "memory"); \
    _Pragma("unroll") for (int d = 0; d < NCB; ++d) _Pragma("unroll") for (int r = 0; r < 16; ++r) o[d][r] *= al_l[crow(r, hi)]; } } while (0)
#define CMASK(P0, P1, t) do { if constexpr (C::CAUSAL) { if ((t) >= NT - 4) cmask(P0, P1, (t) * KVBLK, qrow0 + wid * QBLK + r32, hi); } } while (0)
  f32x16 pA0, pA1, pB0, pB1; float mnA, mnB, alA, alB; bf16x8 pa0, pa1, pa2, pa3;
  constexpr int SE = 0, SO = 1;
  SLOAD(SE, 0); asm volatile("s_waitcnt vmcnt(0)" ::: "memory"); SWRITE(0, SE); __syncthreads();
  qkt<C>(pA0, pA1, K_lds, qr, r32, hi); CMASK(pA0, pA1, 0); partialSM<C>(pA0, pA1, m_reg, mnA, alA);
  SLOAD(SO, KVBLK); if (2 < NT) SLOAD(SE, 2 * KVBLK);
  SWAIT(); SWRITE(1, SO); __syncthreads();
  for (int j = 1; j + 1 < NT; j += 2) {
    SBAR(); qkt<C>(pB0, pB1, K_lds + SHM_K, qr, r32, hi);
    finishSM(pA0, pA1, alA, l_reg, pa0, pa1, pa2, pa3); SBAR();
    SLOAD(SO, (j + 2) * KVBLK); SBAR();
    pv_all<NCB>(o, vb0, pa0, pa1, pa2, pa3); CMASK(pB0, pB1, j); partialSM<C>(pB0, pB1, m_reg, mnB, alB);
    __syncthreads(); SWAIT(); SWRITE(0, SE);
    RESC(alB); __syncthreads();
    SBAR(); qkt<C>(pA0, pA1, K_lds, qr, r32, hi);
    finishSM(pB0, pB1, alB, l_reg, pa0, pa1, pa2, pa3); SBAR();
    if (j + 3 < NT) SLOAD(SE, (j + 3) * KVBLK); SBAR();
    pv_all<NCB>(o, vb0 + SHM_V, pa0, pa1, pa2, pa3); CMASK(pA0, pA1, j + 1); partialSM<C>(pA0, pA1, m_reg, mnA, alA);
    __syncthreads(); SWAIT(); SWRITE(1, SO);
    RESC(alA); __syncthreads();
  }
  SBAR(); qkt<C>(pB0, pB1, K_lds + SHM_K, qr, r32, hi);
  finishSM(pA0, pA1, alA, l_reg, pa0, pa1, pa2, pa3); SBAR();
  pv_all<NCB>(o, vb0, pa0, pa1, pa2, pa3); CMASK(pB0, pB1, NT - 1); partialSM<C>(pB0, pB1, m_reg, mnB, alB);
  __syncthreads(); RESC(alB);
  finishSM(pB0, pB1, alB, l_reg, pa0, pa1, pa2, pa3); SBAR();
  pv_all<NCB>(o, vb0 + SHM_V, pa0, pa1, pa2, pa3);
  if (hi == 0) li_l[r32] = l_reg; asm volatile("s_waitcnt lgkmcnt(0)" ::: "memory");
  float rli[16];
#pragma unroll
  for (int r = 0; r < 16; ++r) rli[r] = __builtin_amdgcn_rcpf(li_l[crow(r, hi)]);
  bf16* Ow = Op + (long)(wid * QBLK) * C::LDO;
#pragma unroll
  for (int r = 0; r < 16; ++r) { const int orow = crow(r, hi);
#pragma unroll
    for (int d0 = 0; d0 < NCB; ++d0) Ow[(long)orow * C::LDO + d0 * 32 + r32] = (bf16)(cvtpk(o[d0][r] * rli[r], 0.f) & 0xffffu); }
#undef SLOAD
#undef SWRITE
#undef SWAIT
#undef RESC
#undef CMASK
}
#undef SBAR
}
#define GAS __attribute__((address_space(1)))
#define LAS __attribute__((address_space(3)))
typedef unsigned short bf16;
typedef unsigned v4u __attribute__((ext_vector_type(4)));
typedef float f32x4 __attribute__((ext_vector_type(4)));
typedef short bf16x8 __attribute__((ext_vector_type(8)));
typedef GAS unsigned gu32;
typedef GAS unsigned long long gu64;
#define RLX_AGENT __ATOMIC_RELAXED, __HIP_MEMORY_SCOPE_AGENT
#define LDS_WAIT() asm volatile("s_waitcnt lgkmcnt(0)" ::: "memory")
#define VM_WAIT() asm volatile("s_waitcnt vmcnt(0)" ::: "memory")
__device__ __forceinline__ unsigned long long rt() { return __builtin_amdgcn_s_memrealtime(); }
__device__ __forceinline__ unsigned f2bf(float f) { unsigned u = __builtin_bit_cast(unsigned, f); return (u + 0x7fffu + ((u >> 16) & 1u)) >> 16; }
__device__ __forceinline__ unsigned pk2(float lo, float hi) { return f2bf(lo) | (f2bf(hi) << 16); }

#define XB_TMO      128
#define XB_XCNT(j)  (256  + 64 * (j))
#define XB_XSUB(j)  (1280 + 64 * (j))
#define XB_XGEN(j)  (2304 + 64 * (j))
#define XB_TOP      3328
#define XB_TOPGEN   3392
#define XCD_BAR_WORDS 3456
#define XB_SPIN_CAP (1u << 18)

__device__ __forceinline__ unsigned xb_ld(unsigned* p)              { return __hip_atomic_load(p, __ATOMIC_RELAXED, __HIP_MEMORY_SCOPE_AGENT); }
__device__ __forceinline__ unsigned xb_add(unsigned* p, unsigned v) { return __hip_atomic_fetch_add(p, v, __ATOMIC_RELAXED, __HIP_MEMORY_SCOPE_AGENT); }
__device__ __forceinline__ unsigned xb_xcc_id() { return (unsigned)__builtin_amdgcn_s_getreg((3 << 11) | 20) & 0xFu; }
#define XB_SPIN(cond, bar) do { unsigned _sp = 0; while (cond) { __builtin_amdgcn_s_sleep(1); \
    if ((++_sp & 255u) == 0u) { if (xb_ld(&(bar)[XB_TMO])) break; if (_sp > XB_SPIN_CAP) { atomicAdd(&(bar)[XB_TMO], 1u); break; } } } } while (0)

struct XcdBarrier {
    unsigned* bar; unsigned x;
    volatile LAS unsigned* st;
};

__device__ __forceinline__ XcdBarrier xcd_barrier_post(unsigned* bar, volatile LAS unsigned* st) {
    XcdBarrier b; b.bar = bar; b.x = xb_xcc_id(); b.st = st;
    if (threadIdx.x == 0) (void)xb_add(&bar[XB_XCNT(b.x)], 1u);
    return b;
}
__device__ __forceinline__ void xcd_barrier_complete(unsigned* bar, unsigned x, unsigned& nloc, unsigned& nx) {
    const unsigned G = gridDim.x * gridDim.y * gridDim.z;
    unsigned sum, cnt, mine, sp = 0u;
    for (;;) {
        sum = 0u; cnt = 0u; mine = 0u;
#pragma unroll
        for (unsigned j = 0; j < 16; ++j) { const unsigned c = xb_ld(&bar[XB_XCNT(j)]); sum += c; cnt += (c > 0u) ? 1u : 0u; mine = (j == x) ? c : mine; }
        if (sum == G) break;
        __builtin_amdgcn_s_sleep(1);
        if ((++sp & 255u) == 0u) { if (xb_ld(&bar[XB_TMO])) break; if (sp > XB_SPIN_CAP) { atomicAdd(&bar[XB_TMO], 1u); break; } }
    }
    nloc = mine > 0u ? mine : 1u; nx = cnt > 0u ? cnt : 1u;
}

__device__ __forceinline__ void xcd_barrier(const XcdBarrier& b) {
    asm volatile("s_waitcnt vmcnt(0)" ::: "memory");
    __syncthreads();
    if (threadIdx.x == 0) {
        unsigned* bar = b.bar;
        __builtin_amdgcn_s_waitcnt(0);
        unsigned nloc = b.st[0], nx = b.st[1];
        if (nloc == 0u) { xcd_barrier_complete(bar, b.x, nloc, nx); b.st[0] = nloc; b.st[1] = nx; }
        const unsigned old = xb_add(&bar[XB_XSUB(b.x)], 1u);
        const unsigned gen = old / nloc;
        if (old + 1u == (gen + 1u) * nloc) {
            __builtin_amdgcn_fence(__ATOMIC_RELEASE, "agent");
            asm volatile("s_waitcnt vmcnt(0)" ::: "memory");
            const unsigned og = xb_add(&bar[XB_TOP], 1u);
            const unsigned tg = og / nx;
            if (og + 1u == (tg + 1u) * nx) xb_add(&bar[XB_TOPGEN], 1u);
            else XB_SPIN(xb_ld(&bar[XB_TOPGEN]) == tg, bar);
            __builtin_amdgcn_fence(__ATOMIC_ACQUIRE, "agent");
            xb_add(&bar[XB_XGEN(b.x)], 1u);
            asm volatile("s_waitcnt vmcnt(0)" ::: "memory");
        } else {
            XB_SPIN(xb_ld(&bar[XB_XGEN(b.x)]) == gen, bar);
            __builtin_amdgcn_fence(__ATOMIC_ACQUIRE, "agent");
            asm volatile("s_waitcnt vmcnt(0)" ::: "memory");
        }
    }
    __syncthreads();
}
constexpr int NWAVES = 8;
constexpr int D = 1024, BATCH = 8, SEQ = 2048, M = BATCH * SEQ, MEM = 256, MM = BATCH * MEM;
constexpr int NH = 8, DN = 64, DR = 32, DV = 64, QL = 256, KVL = 128, DQK = DN + DR;
constexpr int CW = 512, XH = 4, XD = 128, NG = 8, EPG = 8, NE = 64, FF = 256;
constexpr int COL_CQ = 256, COL_CKV = 384, COL_KR = 416, COL_CONV = 1952, IN_COLS = 4000, INP = 4096;
constexpr int PMAX = 2 * M + NE * 256, NTILE_MAX = PMAX / 256;
constexpr float EPS = 1e-6f;
constexpr int RCAP = M;

constexpr size_t MiB = 1u << 20;
constexpr size_t WS_CTL = 0, CTL_ZERO_BYTES = 1 * MiB;
constexpr size_t WS_COS = 1 * MiB, WS_SIN = 2 * MiB, WS_RIDX = 3 * MiB, WS_SLOT = WS_RIDX + 256 * 1024, WS_EID = WS_RIDX + 512 * 1024, WS_EW = WS_RIDX + 768 * 1024;
constexpr size_t WS_WIN = 4 * MiB, WS_WUQ = 12 * MiB, WS_WUKV = 12 * MiB + 512 * 1024, WS_WA = 13 * MiB, WS_WB = 14 * MiB, WS_WOUT = 15 * MiB, WS_WQM = 17 * MiB, WS_WKVM = 18 * MiB,
                 WS_WOM = 20 * MiB, WS_WR = 21 * MiB, WS_WGU = 22 * MiB, WS_WDN = 86 * MiB;
constexpr size_t WS_XN = 118 * MiB, WS_MIX = 118 * MiB, WS_G = 150 * MiB, WS_CQ = 214 * MiB, WS_CKV = 222 * MiB, WS_KR = 226 * MiB, WS_BG = 227 * MiB, WS_U = 243 * MiB,
                 WS_Q = 259 * MiB, WS_KN = 283 * MiB, WS_V = 299 * MiB, WS_ATT = 315 * MiB, WS_CONV = 331 * MiB, WS_X1B = 347 * MiB, WS_QM = 379 * MiB, WS_MEMN = 395 * MiB,
                 WS_KM = 399 * MiB, WS_VM = 401 * MiB, WS_OM = 403 * MiB, WS_X2B = 214 * MiB, WS_LOG = 246 * MiB, WS_HH = 259 * MiB, WS_YD = 118 * MiB, WS_RIDX2 = 420 * MiB, WS_XN8 = 424 * MiB, WS_WIN8 = 440 * MiB, WS_X1 = 448 * MiB, WS_END = 512 * MiB;
constexpr int CW_BAR = 4096, CW_SSQQ = 16384, CW_SSQKV = 49152, CW_SSQ1 = 81920, CW_SSQ2 = 114688, CW_INPROJ = 147648, CW_GRP = 147712, CW_TREADY = 151808, CW_COUNTS = 164096;
static_assert((CW_COUNTS + 64 * NE) * 4 <= (int)CTL_ZERO_BYTES && CW_TREADY + 64 * NTILE_MAX <= CW_COUNTS, "CTL words inside the memset region");
constexpr int RING_OFF = 0, RING_BYTES = 131072;
constexpr int LDSCTL_OFF = RING_BYTES, MISC_OFF = LDSCTL_OFF + 320, TEXP_OFF = RING_BYTES + 1024, GTAB_OFF = RING_BYTES + 2048, OFFS_OFF = GTAB_OFF + 4096, TORD_OFF = OFFS_OFF + 1024;
constexpr int LDS_BYTES = 147456;
static_assert(TORD_OFF + 1024 <= LDS_BYTES, "LDS map");

struct Args { const float* in[27]; float* out; unsigned char* ws; int ph_lo, ph_hi, sub, pad; };
constexpr int NPHASE = 15;
#ifndef GROUPBAR
#define GROUPBAR 1
#endif
#ifndef MOEALIGN
#define MOEALIGN true
#endif
#ifndef SUALIGN
#define SUALIGN true
#endif
#ifndef P1ALIGN
#define P1ALIGN false
#endif
#ifndef INROT
#define INROT 0
#endif

__device__ __forceinline__ float wave_sum(float v) {
#pragma unroll
    for (int o = 1; o < 64; o <<= 1) v += __shfl_xor(v, o);
    return v;
}
__device__ __forceinline__ int rope_pos(int j) { const int x = j & 15, second = j >> 4; return 8 * (x >> 2) + 4 * second + (x & 3); }
struct MapId  { __device__ __forceinline__ int operator()(int n) const { return n; } };
struct MapWin { __device__ __forceinline__ int operator()(int n) const {
    if (n < COL_CKV) return n;
    if (n < COL_KR) return 384 + rope_pos(n - COL_CKV);
    if (n < COL_KR + CW) return 512 + (n - COL_KR);
    if (n < COL_KR + 2 * CW) { const int c = n - COL_KR - CW; return 1024 + (c >> 7) * 256 + (c & 127); }
    if (n < COL_CONV) { const int c = n - COL_KR - 2 * CW; return 1024 + (c >> 7) * 256 + 128 + (c & 127); }
    return 2048 + (n - COL_CONV); } };
struct MapUq  { __device__ __forceinline__ int operator()(int n) const { const int h = n / DQK, d = n % DQK; return d < DN ? h * DN + d : 512 + h * DR + rope_pos(d - DN); } };
struct MapUkv { __device__ __forceinline__ int operator()(int n) const { const int h = n >> 7, d = n & 127; return d < 64 ? h * 64 + d : 512 + h * 64 + (d - 64); } };
struct MapGu  { __device__ __forceinline__ int operator()(int n) const { const int c = n & 255; return (c >> 7) * 256 + (n >> 8) * 128 + (c & 127); } };
struct TItem { const float* W; bf16* WT; const float* gain; int K, N, k0, n0, map; };
__device__ __forceinline__ void titem_load(const TItem& t, f32x4 (&v)[8], int lane) {
    const int sub = lane >> 3, c4 = (lane & 7) * 4;
#pragma unroll
    for (int j = 0; j < 8; ++j) v[j] = __builtin_nontemporal_load((const GAS f32x4*)(t.W + (size_t)(t.k0 + 8 * j + sub) * t.N + t.n0 + c4));
}
__device__ __forceinline__ int titem_row(int map, int n) {
    switch (map) { case 1: return MapWin()(n); case 2: return MapUq()(n); case 3: return MapUkv()(n); case 4: return MapGu()(n); default: return n; }
}
__device__ __forceinline__ void titem_finish(const TItem& t, const f32x4 (&v)[8], LAS float* scr, int lane) {
    const int sub = lane >> 3, c4 = (lane & 7) * 4;
#pragma unroll
    for (int j = 0; j < 8; ++j) { const int kk = 8 * j + sub; const float g = t.gain ? t.gain[t.k0 + kk] : 1.0f; LAS float* s = scr + kk * 33 + c4;
        s[0] = v[j].x * g; s[1] = v[j].y * g; s[2] = v[j].z * g; s[3] = v[j].w * g; }
    LDS_WAIT(); asm volatile("" ::: "memory");
    const int c = lane & 7;
#pragma unroll
    for (int j = 0; j < 4; ++j) { const int n = (lane >> 3) + 8 * j; const LAS float* s = scr + (8 * c) * 33 + n;
        if (t.map == 5) { unsigned w0 = 0, w1 = 0;
            w0 = __builtin_amdgcn_cvt_pk_fp8_f32(s[0 * 33] * 32.f, s[1 * 33] * 32.f, w0, false); w0 = __builtin_amdgcn_cvt_pk_fp8_f32(s[2 * 33] * 32.f, s[3 * 33] * 32.f, w0, true);
            w1 = __builtin_amdgcn_cvt_pk_fp8_f32(s[4 * 33] * 32.f, s[5 * 33] * 32.f, w1, false); w1 = __builtin_amdgcn_cvt_pk_fp8_f32(s[6 * 33] * 32.f, s[7 * 33] * 32.f, w1, true);
            *(GAS unsigned long long*)((GAS unsigned char*)t.WT + (size_t)(t.n0 + n - COL_CONV) * t.K + t.k0 + 8 * c) = (unsigned long long)w0 | ((unsigned long long)w1 << 32); continue; }
        v4u o; o.x = pk2(s[0 * 33], s[1 * 33]); o.y = pk2(s[2 * 33], s[3 * 33]); o.z = pk2(s[4 * 33], s[5 * 33]); o.w = pk2(s[6 * 33], s[7 * 33]);
        GAS v4u* dst = (GAS v4u*)(t.WT + (size_t)titem_row(t.map, t.n0 + n) * t.K + t.k0 + 8 * c);
        if (t.map == 4 || t.map == 6) __builtin_nontemporal_store(o, dst); else *dst = o; }
    LDS_WAIT(); asm volatile("" ::: "memory");
}
__device__ __forceinline__ void rms_row_to_bf16(const float* xrow, const float* g, bf16* orow, int lane) {
    const GAS f32x4* xr = (const GAS f32x4*)xrow + lane; const GAS f32x4* gr = (const GAS f32x4*)g + lane;
    f32x4 v[4]; float s = 0.f;
#pragma unroll
    for (int j = 0; j < 4; ++j) { v[j] = xr[64 * j]; s += (v[j].x * v[j].x + v[j].y * v[j].y) + (v[j].z * v[j].z + v[j].w * v[j].w); }
    const float rstd = 1.f / sqrtf(wave_sum(s) * (1.f / D) + EPS);
    GAS unsigned long long* o8 = (GAS unsigned long long*)orow + lane;
#pragma unroll
    for (int j = 0; j < 4; ++j) { const f32x4 gg = gr[64 * j]; o8[64 * j] = (unsigned long long)pk2(v[j].x * rstd * gg.x, v[j].y * rstd * gg.y) | ((unsigned long long)pk2(v[j].z * rstd * gg.z, v[j].w * rstd * gg.w) << 32); }
}

template <class MK>
__device__ __forceinline__ void run_titems(const MK& mk, int it_lo, int it_hi, int wv, int nwv, LAS float* scr, int lane) {
    f32x4 va[8], vb[8], vc[8]; TItem ta, tb, tc; int it = it_lo + wv;
    if (it < it_hi) { ta = mk(it); titem_load(ta, va, lane); }
    if (it + nwv < it_hi) { tb = mk(it + nwv); titem_load(tb, vb, lane); }
    while (it < it_hi) {
        if (it + 2 * nwv < it_hi) { tc = mk(it + 2 * nwv); titem_load(tc, vc, lane); }
        titem_finish(ta, va, scr, lane); it += nwv; if (it >= it_hi) break;
        if (it + 2 * nwv < it_hi) { ta = mk(it + 2 * nwv); titem_load(ta, va, lane); }
        titem_finish(tb, vb, scr, lane); it += nwv; if (it >= it_hi) break;
        if (it + 2 * nwv < it_hi) { tb = mk(it + 2 * nwv); titem_load(tb, vb, lane); }
        titem_finish(tc, vc, scr, lane); it += nwv;
    }
}
constexpr int I_GU = 16 * 8, I_DN = 4 * 16, MOE_ITEMS = NE * (I_GU + I_DN);
struct WItem { const float* W; bf16* WT; const float* gain; int K, N, k0, n0, gu; };
__device__ __forceinline__ void witem_load(const WItem& t, f32x4 (&v)[16], int lane) {
    const int sub = lane >> 4, c4 = (lane & 15) * 4;
#pragma unroll
    for (int j = 0; j < 16; ++j) v[j] = __builtin_nontemporal_load((const GAS f32x4*)(t.W + (size_t)(t.k0 + 4 * j + sub) * t.N + t.n0 + c4));
}
__device__ __forceinline__ void witem_write(const WItem& t, const f32x4 (&v)[16], LAS float* scr, int lane) {
    const int sub = lane >> 4, c4 = (lane & 15) * 4;
#pragma unroll
    for (int j = 0; j < 16; ++j) { const int kk = 4 * j + sub; const float g = t.gain ? t.gain[t.k0 + kk] : 1.0f; LAS float* s = scr + kk * 64;
        s[(c4 + 0 + kk) & 63] = v[j].x * g; s[(c4 + 1 + kk) & 63] = v[j].y * g; s[(c4 + 2 + kk) & 63] = v[j].z * g; s[(c4 + 3 + kk) & 63] = v[j].w * g; }
    LDS_WAIT(); asm volatile("" ::: "memory");
}
__device__ __forceinline__ void witem_out(const WItem& t, LAS float* scr, int lane) {
    const int c = lane & 7;
#pragma unroll 2
    for (int j = 0; j < 8; ++j) { const int n = (lane >> 3) + 8 * j; const LAS float* s = scr + (8 * c) * 64;
        float e[8];
#pragma unroll
        for (int q = 0; q < 8; ++q) e[q] = s[q * 64 + ((n + 8 * c + q) & 63)];
        v4u o; o.x = pk2(e[0], e[1]); o.y = pk2(e[2], e[3]); o.z = pk2(e[4], e[5]); o.w = pk2(e[6], e[7]);
        const int nn = t.n0 + n, row = t.gu ? MapGu()(nn) : nn;
        *(GAS v4u*)(t.WT + (size_t)row * t.K + t.k0 + 8 * c) = o; }
    LDS_WAIT(); asm volatile("" ::: "memory");
}
__device__ __forceinline__ void moe_prep(unsigned char* ws, const float* w_gu, const float* w_dn, const float* g_moe, int it_lo, int it_hi, int wv, int nwv, LAS float* scr, int lane) {
    auto mk = [&](int it) -> WItem { WItem t; int r = it;
        if (r < NE * I_GU) { const int e = r / I_GU, item = r % I_GU; t.W = w_gu + (size_t)e * D * 512; t.WT = (bf16*)(ws + WS_WGU) + (size_t)e * 512 * D; t.gain = g_moe; t.K = D; t.N = 512; t.k0 = 64 * (item / 8); t.n0 = 64 * (item % 8); t.gu = 1; return t; }
        r -= NE * I_GU; { const int e = r / I_DN, item = r % I_DN; t.W = w_dn + (size_t)e * FF * D; t.WT = (bf16*)(ws + WS_WDN) + (size_t)e * D * FF; t.gain = nullptr; t.K = FF; t.N = D; t.k0 = 64 * (item / 16); t.n0 = 64 * (item % 16); t.gu = 0; return t; } };
    f32x4 v[16]; WItem tc, tn; int it = it_lo + wv;
    if (it < it_hi) { tc = mk(it); witem_load(tc, v, lane); }
    while (it < it_hi) {
        witem_write(tc, v, scr, lane);
        const int it2 = it + nwv; if (it2 < it_hi) { tn = mk(it2); witem_load(tn, v, lane); }
        witem_out(tc, scr, lane);
        tc = tn; it = it2;
    }
}
#ifdef PREP_IN_P0
#define PREP_A MOE_ITEMS
#define PREP_B MOE_ITEMS
#endif
#ifndef PREP_A
#define PREP_A 750
#endif
#ifndef PREP_B
#define PREP_B 5500
#endif
__device__ __forceinline__ void group_barrier(unsigned* cnt, unsigned target, unsigned* tmo, volatile LAS unsigned* st) {
    asm volatile("s_waitcnt vmcnt(0)" ::: "memory");
    __syncthreads();
    if (threadIdx.x == 0) {
        const unsigned mode = st[0];
        if (mode != 1u) __builtin_amdgcn_fence(__ATOMIC_RELEASE, "agent");
        asm volatile("s_waitcnt vmcnt(0)" ::: "memory");
        (void)xb_add(cnt, 1u);
        unsigned sp = 0;
        while (xb_ld(cnt) < target) { __builtin_amdgcn_s_sleep(1); if ((++sp & 255u) == 0u) { if (xb_ld(tmo)) break; if (sp > XB_SPIN_CAP) { atomicAdd(tmo, 1u); break; } } }
        __builtin_amdgcn_fence(__ATOMIC_ACQUIRE, "agent");
        asm volatile("s_waitcnt vmcnt(0)" ::: "memory");
        if (mode == 0u) { const unsigned m = xb_ld(cnt + 1); st[0] = (__builtin_popcount(m) == 1) ? 1u : 2u; }
    }
    __syncthreads();
}
__device__ __forceinline__ void conv_item(unsigned char* ws, const float* conv_w, int m, int c) {
    const int s = m % SEQ; const bf16* Ub = (const bf16*)(ws + WS_U) + (size_t)m * CW + c;
    f32x4 u0a, u0b, u1a, u1b, u2a, u2b, ba, bb;
    pg8::unpack8(*(const v4u*)Ub, u2a, u2b); pg8::unpack8(*(const v4u*)((const bf16*)(ws + WS_BG) + (size_t)m * CW + c), ba, bb);
    if (s >= 1) pg8::unpack8(*(const v4u*)(Ub - CW), u1a, u1b); else { u1a = (f32x4){0.f, 0.f, 0.f, 0.f}; u1b = u1a; }
    if (s >= 2) pg8::unpack8(*(const v4u*)(Ub - 2 * CW), u0a, u0b); else { u0a = (f32x4){0.f, 0.f, 0.f, 0.f}; u0b = u0a; }
    const f32x4 w0a = *(const f32x4*)(conv_w + c), w0b = *(const f32x4*)(conv_w + c + 4), w1a = *(const f32x4*)(conv_w + CW + c), w1b = *(const f32x4*)(conv_w + CW + c + 4),
                w2a = *(const f32x4*)(conv_w + 2 * CW + c), w2b = *(const f32x4*)(conv_w + 2 * CW + c + 4);
    *(v4u*)((bf16*)(ws + WS_CONV) + (size_t)m * CW + c) = pg8::pack8(ba * (w0a * u0a + w1a * u1a + w2a * u2a), bb * (w0b * u0b + w1b * u1b + w2b * u2b));
}
__device__ __forceinline__ const void* kernarg_ptr(int i) {
    const void* const* p = (const void* const*)__builtin_amdgcn_kernarg_segment_ptr(); asm volatile("" : "+s"(p)); return p[i];
}
__global__ void __launch_bounds__(NWAVES * 64, 2) mega_fwd(Args args) {
    extern __shared__ __attribute__((aligned(16))) unsigned char lds[];
    LAS unsigned char* const ldsl = (LAS unsigned char*)lds;
    volatile LAS unsigned* const MISC = (volatile LAS unsigned*)(ldsl + MISC_OFF);
    const int tid = threadIdx.x, lane = tid & 63, wave = __builtin_amdgcn_readfirstlane(tid >> 6);
    const int G = gridDim.x, bx = blockIdx.x, vcu = (G % 8 == 0) ? (bx % 8) * (G / 8) + bx / 8 : bx;
    unsigned char* const ws = args.ws;
    gu32* const ctl = (gu32*)(ws + WS_CTL);
#define ARGF(i) ((const float*)kernarg_ptr(i))
#define WSB(off) ((bf16*)(ws + (off)))
    float* const COS = (float*)(ws + WS_COS); float* const SIN = (float*)(ws + WS_SIN);
    int* const RIDX = (int*)(ws + WS_RIDX); int* const SLOT = (int*)(ws + WS_SLOT); int* const EID = (int*)(ws + WS_EID); int* const RIDX2 = (int*)(ws + WS_RIDX2); float* const EW = (float*)(ws + WS_EW);
    pg8::ssq_t* const SSQQ = (pg8::ssq_t*)(ctl + CW_SSQQ); pg8::ssq_t* const SSQKV = (pg8::ssq_t*)(ctl + CW_SSQKV); pg8::ssq_t* const SSQ1 = (pg8::ssq_t*)(ctl + CW_SSQ1); pg8::ssq_t* const SSQ2 = (pg8::ssq_t*)(ctl + CW_SSQ2);
    unsigned* const COUNTS = (unsigned*)(ctl + CW_COUNTS);
    float* const LOG = (float*)(ws + WS_LOG);

    for (int u = tid; u < (LDS_BYTES - LDSCTL_OFF) / 4; u += NWAVES * 64) ((LAS unsigned*)(ldsl + LDSCTL_OFF))[u] = 0u;
    __syncthreads();
    const int lo = args.ph_lo, hi = args.ph_hi;
    XcdBarrier bar; bar.bar = (unsigned*)(ctl + CW_BAR); bar.x = 0; bar.st = nullptr;
    if (hi - lo > 1) { bar = xcd_barrier_post((unsigned*)(ctl + CW_BAR), MISC + 8); if (GROUPBAR && tid == 0) atomicOr((unsigned*)(ctl + CW_GRP) + 64 * (bx % 64) + 1, 1u << bar.x); }
#ifndef PHMASK
#define PHMASK 0x7fff
#endif
#ifndef REPMASK
#define REPMASK 0
#endif
#ifndef REPBAR
#define REPBAR 0
#endif
#define REP(k) for (int rep_ = 0; rep_ < ((((REPMASK) >> (k)) & 1) ? 2 : 1); ++rep_, (REPBAR ? xcd_barrier(bar) : (void)0))
#define IN(k) ((((PHMASK) >> (k)) & 1) && lo <= (k) && (k) < hi)
#ifndef NBAR
#define NBAR 1
#endif
#ifdef TSPROBE
#define TSTAMP(i) do { if (bx == 0 && tid == 0) ((unsigned long long*)(ctl + 512))[i] = __builtin_amdgcn_s_memrealtime(); } while (0)
#else
#define TSTAMP(i) do {} while (0)
#endif
#define SEAM(k) do { if (IN(k) && IN((k) + 1)) { for (int nb_ = 0; nb_ < NBAR; ++nb_) xcd_barrier(bar); } TSTAMP((k) + 1); } while (0)
    unsigned* const grp_cnt = (unsigned*)(ctl + CW_GRP) + 64 * (bx % 64); unsigned* const grp_tmo = (unsigned*)(ctl + CW_BAR) + XB_TMO;
#define GSEAM(k, s) do { if (IN(k) && IN((k) + 1)) { if (GROUPBAR && G == 256) group_barrier(grp_cnt, 4u * ((s) + 1u), grp_tmo, MISC + 12); else xcd_barrier(bar); } TSTAMP((k) + 1); } while (0)
    TSTAMP(0);
#ifndef NPASS
#define NPASS 1
#endif
    const int gw = vcu * NWAVES + wave, NGW = G * NWAVES, gt = vcu * (NWAVES * 64) + tid, NGT = G * NWAVES * 64;

    if (IN(0)) REP(0) {
        const float* x = ARGF(0); const float* mem = ARGF(1); const int* pos = (const int*)ARGF(2); const float* g_mix = ARGF(3); const float* w_in = ARGF(4);
        const float* g_cq = ARGF(6); const float* w_uq = ARGF(7); const float* g_ckv = ARGF(8); const float* w_ukv = ARGF(9); const float* w_a = ARGF(11); const float* w_b = ARGF(12); const float* w_out = ARGF(13);
        const float* g_xattn = ARGF(14); const float* g_mem = ARGF(15); const float* w_q_mem = ARGF(16); const float* w_kv_mem = ARGF(17); const float* w_o_mem = ARGF(18); const float* g_moe = ARGF(19);
        const float* w_rg = ARGF(20); const float* w_re = ARGF(22);
        LAS float* scr = (LAS float*)(ldsl + RING_OFF + wave * 16384);
        constexpr int I_IN = 16 * 125, I_UQ = 4 * 24, I_UKV = 2 * 32, I_A = 8 * 32, I_OUT = 16 * 32, I_QM = 16 * 16, I_KVM = 16 * 32, I_OM = 8 * 32;
        constexpr int NITEMS = I_IN + I_UQ + I_UKV + 2 * I_A + I_OUT + I_QM + I_KVM + I_OM;
        auto mk_item = [&](int it) -> TItem {
            TItem t; int r = it;
            auto set = [&](const float* W, int K, int N, bf16* WT, const float* gain, int map, int item) { const int nblk = N / 32; t.W = W; t.WT = WT; t.gain = gain; t.K = K; t.N = N; t.k0 = 64 * (item / nblk); t.n0 = 32 * (item % nblk); t.map = map; };
            if (r < I_IN) { set(w_in, D, IN_COLS, WSB(WS_WIN), nullptr, 1, r); return t; } r -= I_IN;
            if (r < I_UQ) { set(w_uq, QL, NH * DQK, WSB(WS_WUQ), g_cq, 2, r); return t; } r -= I_UQ;
            if (r < I_UKV) { set(w_ukv, KVL, NH * 128, WSB(WS_WUKV), g_ckv, 3, r); return t; } r -= I_UKV;
            if (r < I_A) { set(w_a, 512, D, WSB(WS_WA), nullptr, 0, r); return t; } r -= I_A;
            if (r < I_A) { set(w_b, 512, D, WSB(WS_WB), nullptr, 0, r); return t; } r -= I_A;
            if (r < I_OUT) { set(w_out, D, D, WSB(WS_WOUT), nullptr, 0, r); return t; } r -= I_OUT;
            if (r < I_QM) { set(w_q_mem, D, 512, WSB(WS_WQM), g_xattn, 0, r); return t; } r -= I_QM;
            if (r < I_KVM) { set(w_kv_mem, D, D, WSB(WS_WKVM), nullptr, 0, r); return t; } r -= I_KVM;
            set(w_o_mem, 512, D, WSB(WS_WOM), nullptr, 0, r); return t;
        };
        run_titems(mk_item, 0, NITEMS, gw, NGW, scr, lane);
#ifdef PREP_IN_P0
        moe_prep(ws, ARGF(24), ARGF(25), ARGF(19), 0, MOE_ITEMS, gw, NGW, scr, lane);
#endif
        {
            auto ldrow = [&](const float* xrow, f32x4 (&v)[4]) { const GAS f32x4* xr = (const GAS f32x4*)xrow + lane; _Pragma("unroll") for (int j = 0; j < 4; ++j) v[j] = xr[64 * j]; };
            auto finrow = [&](const f32x4 (&v)[4], const float* g, bf16* orow, unsigned char* orow8) { float s = 0.f;
                _Pragma("unroll") for (int j = 0; j < 4; ++j) s += (v[j].x * v[j].x + v[j].y * v[j].y) + (v[j].z * v[j].z + v[j].w * v[j].w);
                const float rstd = 1.f / sqrtf(wave_sum(s) * (1.f / D) + EPS); const GAS f32x4* gr = (const GAS f32x4*)g + lane; GAS unsigned long long* o8 = (GAS unsigned long long*)orow + lane;
                _Pragma("unroll") for (int j = 0; j < 4; ++j) { const f32x4 gg = gr[64 * j]; const float a0 = v[j].x * rstd * gg.x, a1 = v[j].y * rstd * gg.y, a2 = v[j].z * rstd * gg.z, a3 = v[j].w * rstd * gg.w;
                    o8[64 * j] = (unsigned long long)pk2(a0, a1) | ((unsigned long long)pk2(a2, a3) << 32);
                    if (orow8) { unsigned w = 0; w = __builtin_amdgcn_cvt_pk_fp8_f32(a0, a1, w, false); w = __builtin_amdgcn_cvt_pk_fp8_f32(a2, a3, w, true); ((GAS unsigned*)orow8)[lane + 64 * j] = w; } } };
            f32x4 r0[4], r1[4];
            for (int m = gw; m < M; m += 2 * NGW) { const int m1 = m + NGW; ldrow(x + (size_t)m * D, r0); if (m1 < M) ldrow(x + (size_t)m1 * D, r1);
                finrow(r0, g_mix, WSB(WS_XN) + (size_t)m * D, nullptr); if (m1 < M) finrow(r1, g_mix, WSB(WS_XN) + (size_t)m1 * D, nullptr); }
            for (int m = gw; m < MM; m += NGW) { ldrow(mem + (size_t)m * D, r0); finrow(r0, g_mem, WSB(WS_MEMN) + (size_t)m * D, nullptr); }
        }
        for (int i = gt; i < M * 16; i += NGT) { const int m = i >> 4, j = i & 15; const float inv = powf(10000.0f, -(float)(2 * j) / 32.0f); const float ang = (float)pos[m] * inv; COS[i] = cosf(ang); SIN[i] = sinf(ang); }
        for (int i = gt; i < PMAX; i += NGT) RIDX[i] = 0;
        for (int i = gt; i < 96 * D; i += NGT) WSB(WS_WIN)[(size_t)416 * D + i] = 0;
        for (int i = gt; i < 256 * D; i += NGT) { const int n = i >> 10, k = i & 1023;
            float v = 0.f; if (n < NG) v = w_rg[k * NG + n] * g_moe[k]; else if (n < NG + NE) v = w_re[k * NE + (n - NG)] * g_moe[k];
            WSB(WS_WR)[i] = (bf16)f2bf(v); }
    }
    SEAM(0);
    if (GROUPBAR && IN(0) && IN(1)) {
        if (tid == 0) { const unsigned m = xb_ld(grp_cnt + 1); MISC[12] = (__builtin_popcount(m) == 1) ? 1u : 2u; }
        __syncthreads();
    }
    if (IN(1)) REP(1) {
        const float* b_gate = ARGF(5);
        pg8::Gemm g{WSB(WS_XN), WSB(WS_WIN), M, INP, D}; pg8::StaticOrder S;
#ifdef P1SPLIT
        S.init(M, INP, 1024, bx + args.sub * 256, INROT);
#else
        S.init(M, INP, G, bx, INROT);
#endif
        pg8::EpiInProj E{WSB(WS_CQ), WSB(WS_CKV), WSB(WS_KR), WSB(WS_BG), WSB(WS_U), WSB(WS_G), SSQQ, SSQKV, COS, SIN, b_gate, rep_ == 0, 0, 1.0f};
        pg8::gemm_phase<pg8::EpiInProj, pg8::StaticOrder, P1ALIGN>(ldsl + RING_OFF, g, S, E);
        if (rep_ == 0 && G == 256) {
            group_barrier(grp_cnt + 4, 4u, grp_tmo, MISC + 12);
            const int pm1 = 8 * (bx % 8) + (bx / 8) % 8, j1 = bx / 64;
            if (j1 == 0 || j1 == 2) { pg8::Gemm g2{WSB(WS_CQ), WSB(WS_WUQ), M, 768, QL}; pg8::PanelOrder S2{pm1, j1 == 0 ? 2 : 1, j1 == 0 ? 0 : 2};
                pg8::EpiQUp E2{WSB(WS_Q), SSQQ, COS, SIN}; pg8::gemm_phase<pg8::EpiQUp, pg8::PanelOrder, true>(ldsl + RING_OFF, g2, S2, E2); }
            if (j1 == 1 || j1 == 2) { pg8::Gemm g2{WSB(WS_CKV), WSB(WS_WUKV), M, 1024, KVL}; pg8::PanelOrder S2{pm1, j1 == 1 ? 3 : 1, j1 == 1 ? 0 : 3};
                pg8::EpiKVUp E2{WSB(WS_KN), WSB(WS_V), SSQKV}; pg8::gemm_phase<pg8::EpiKVUp, pg8::PanelOrder, true>(ldsl + RING_OFF, g2, S2, E2); }
            if (j1 == 3) {
                if (bx < 224) { pg8::Gemm g{WSB(WS_MEMN), WSB(WS_WKVM), MM, 1024, D}; pg8::StaticOrder S; S.init(MM, 1024, G, bx - 192);
                    pg8::EpiKVM E{WSB(WS_KM), WSB(WS_VM)}; pg8::gemm_phase<pg8::EpiKVM, pg8::StaticOrder, true>(ldsl + RING_OFF, g, S, E); }
                else if (PREP_A > 0 && PREP_A < MOE_ITEMS) moe_prep(ws, ARGF(24), ARGF(25), ARGF(19), 0, PREP_A, (bx - 224) * NWAVES + wave, 32 * NWAVES, (LAS float*)(ldsl + RING_OFF + wave * 16384), lane);
            }
        }
    }
    SEAM(1);
    if (IN(3)) REP(3) {
        const float* conv_w = ARGF(10);
        for (int i = gt; i < M * (CW / 8); i += NGT) conv_item(ws, conv_w, i >> 6, (i & 63) * 8);
        for (int v = vcu; v < 256; v += G) {
            const int bh = v >> 2, b = bh >> 3, h = bh & 7, s4 = v & 3;
            for (int k = 0; k < 2; ++k) { const int qb = k ? 7 - s4 : s4; const size_t row0 = (size_t)b * SEQ + qb * 256, key0 = (size_t)b * SEQ;
                att::attn_unit<att::MlaCfg>(WSB(WS_Q) + row0 * 768 + h * 64, WSB(WS_Q) + row0 * 768 + 512 + h * 32, WSB(WS_KN) + key0 * 512 + h * 64, WSB(WS_KR) + key0 * 32,
                                             WSB(WS_V) + key0 * 512 + h * 64, WSB(WS_ATT) + row0 * 512 + h * 64, qb * 256, 4 * (qb + 1), (char*)lds + RING_OFF); }
        }
        __syncthreads();
    }
    SEAM(3);
    if (IN(4)) REP(4) {
        { pg8::Gemm g{WSB(WS_ATT), WSB(WS_WA), M, D, 512}; pg8::StaticOrder S; S.init(M, D, G, bx);
          pg8::EpiMix<false> E{WSB(WS_MIX), WSB(WS_G)}; pg8::gemm_phase<pg8::EpiMix<false>, pg8::StaticOrder, SUALIGN>(ldsl + RING_OFF, g, S, E); }
        { pg8::Gemm g{WSB(WS_CONV), WSB(WS_WB), M, D, 512}; pg8::StaticOrder S; S.init(M, D, G, bx);
          pg8::EpiMix<true> E{WSB(WS_MIX), WSB(WS_G)}; pg8::gemm_phase<pg8::EpiMix<true>, pg8::StaticOrder, SUALIGN>(ldsl + RING_OFF, g, S, E); }
    }
    GSEAM(4, 0);
    if (IN(5)) REP(5) {
        const float* x = ARGF(0);
        pg8::Gemm g{WSB(WS_MIX), WSB(WS_WOUT), M, D, D}; pg8::StaticOrder S; S.init(M, D, G, bx);
        pg8::EpiResid<float> E{x, WSB(WS_X1B), SSQ1, rep_ == 0}; pg8::gemm_phase<pg8::EpiResid<float>, pg8::StaticOrder, SUALIGN>(ldsl + RING_OFF, g, S, E);
    }
    GSEAM(5, 1);
    if (IN(6)) REP(6) {
        pg8::Gemm g{WSB(WS_X1B), WSB(WS_WQM), M, 512, D}; pg8::StaticOrder S; S.init(M, 512, G, bx);
        pg8::EpiScaleRows E{WSB(WS_QM), 512, SSQ1}; pg8::gemm_phase<pg8::EpiScaleRows, pg8::StaticOrder, SUALIGN>(ldsl + RING_OFF, g, S, E);
        if (rep_ == 0 && bx >= 128) moe_prep(ws, ARGF(24), ARGF(25), ARGF(19), PREP_A, PREP_B, (bx - 128) * NWAVES + wave, 128 * NWAVES, (LAS float*)(ldsl + RING_OFF + wave * 16384), lane);
    }
    GSEAM(6, 2);
    if (IN(7)) REP(7) {
        for (int v = bx; v < 256; v += G) {
            const int pmv = 8 * (v % 8) + (v / 8) % 8, b = pmv >> 3, qb = pmv & 7, h = v / 64; const size_t row0 = (size_t)b * SEQ + qb * 256, key0 = (size_t)b * MEM;
            att::attn_unit<att::XatCfg>(WSB(WS_QM) + row0 * 512 + h * 128, nullptr, WSB(WS_KM) + key0 * 512 + h * 128, nullptr, WSB(WS_VM) + key0 * 512 + h * 128,
                                         WSB(WS_OM) + row0 * 512 + h * 128, 0, MEM / 64, (char*)lds + RING_OFF);
        }
        __syncthreads();
    }
    GSEAM(7, 3);
    if (IN(8)) REP(8) {
        pg8::Gemm g{WSB(WS_OM), WSB(WS_WOM), M, D, 512}; pg8::StaticOrder S; S.init(M, D, G, bx);
        pg8::EpiResid<bf16> E{WSB(WS_X1B), WSB(WS_X2B), SSQ2, rep_ == 0}; pg8::gemm_phase<pg8::EpiResid<bf16>, pg8::StaticOrder, SUALIGN>(ldsl + RING_OFF, g, S, E);
    }
    GSEAM(8, 4);
    if (IN(9)) REP(9) {
        const float* b_rg = ARGF(21); const float* b_re = ARGF(23);
        pg8::Gemm g{WSB(WS_X2B), WSB(WS_WR), M, 256, D}; pg8::StaticOrder S; S.init(M, 256, G, bx);
        pg8::EpiRouter E{LOG}; pg8::gemm_phase<pg8::EpiRouter, pg8::StaticOrder, SUALIGN>(ldsl + RING_OFF, g, S, E);
        if (rep_ == 0 && bx >= 64) moe_prep(ws, ARGF(24), ARGF(25), ARGF(19), PREP_B, MOE_ITEMS, (bx - 64) * NWAVES + wave, 192 * NWAVES, (LAS float*)(ldsl + RING_OFF + wave * 16384), lane);
        VM_WAIT(); __syncthreads();
        if (rep_ == 0)
        { pg8::Unit ur; if (S.next(0, ur) && tid < 256) { const int n = ur.pm * 256 + tid;
            const float rs = 1.0f / sqrtf(pg8::ssq_get(SSQ2 + n) * (1.0f / D) + EPS); const float* L = LOG + (size_t)n * 128;
            float gl[NG]; float gm = -3.0e38f; int gi = 0;
#pragma unroll
            for (int g = 0; g < NG; ++g) { gl[g] = L[g] * rs + b_rg[g]; if (gl[g] > gm) { gm = gl[g]; gi = g; } }
            float se = 0.f;
#pragma unroll
            for (int g = 0; g < NG; ++g) se += __expf(gl[g] - gm);
            const float pg = 1.0f / se;
            float v0 = -3.0e38f, v1 = -3.0e38f; int i0 = 0, i1 = 0;
            for (int e = 0; e < EPG; ++e) { const float v = L[NG + gi * EPG + e] * rs + b_re[gi * EPG + e];
                if (v > v0) { v1 = v0; i1 = i0; v0 = v; i0 = e; } else if (v > v1) { v1 = v; i1 = e; } }
            const float e1 = __expf(v1 - v0);
            EID[2 * n] = gi * EPG + i0; EID[2 * n + 1] = gi * EPG + i1; EW[2 * n] = pg / (1.0f + e1); EW[2 * n + 1] = pg * e1 / (1.0f + e1);
            { const int ea = gi * EPG + i0, eb = gi * EPG + i1;
              const int sa = (int)atomicAdd(&COUNTS[64 * ea], 1u), sb = (int)atomicAdd(&COUNTS[64 * eb], 1u);
              RIDX2[ea * RCAP + sa] = n; RIDX2[eb * RCAP + sb] = n; SLOT[2 * n] = sa; SLOT[2 * n + 1] = sb; }
        } }
    }
    SEAM(10);
    if (IN(12) || IN(13)) {
        LAS int* texp = (LAS int*)(ldsl + TEXP_OFF); LAS int* gtab = (LAS int*)(ldsl + GTAB_OFF); LAS int* offs = (LAS int*)(ldsl + OFFS_OFF);
        LAS int* cnts = offs + 128;
        if (tid < NE) cnts[tid] = (int)__hip_atomic_load(&COUNTS[64 * tid], RLX_AGENT);
        __syncthreads();
        LAS int* tord = (LAS int*)(ldsl + TORD_OFF);
        if (tid == 0) { int t = 0; for (int e = 0; e < NE; ++e) { const int nt = (cnts[e] + 255) / 256; offs[e] = t * 256; for (int k = 0; k < nt; ++k) texp[t++] = e; } offs[64] = t;
            int k = 0;
            for (int p = 0; p < 2; ++p) for (int tl = 0; tl < t; ++tl) { const int e = texp[tl], valid = cnts[e] - (tl * 256 - offs[e]); const int hf = 0; (void)valid; if (hf == p) tord[k++] = tl | (hf << 30); } }
        __syncthreads();
        const int ntiles = __builtin_amdgcn_readfirstlane(offs[64]);
        if (IN(12)) {
            unsigned* tready = (unsigned*)(ctl + CW_TREADY);
            for (int i = 0; i < 4; ++i) { const int L = i * G + vcu; if (L < ntiles * 2 && tid < 256) { const int tile = tord[L >> 1] & 0xffff, e = texp[tile], s = tile * 256 - offs[e] + tid;
                const int tok = (s < cnts[e]) ? RIDX2[e * RCAP + s] : 0; gtab[i * 256 + tid] = tok; ((float*)RIDX)[tile * 256 + tid] = __builtin_amdgcn_rsqf(pg8::ssq_get(SSQ2 + tok) * (1.0f / D) + EPS); } }
            VM_WAIT(); __syncthreads();
            { pg8::Gemm g{WSB(WS_X2B), WSB(WS_WGU), PMAX, NE * 512, D}; pg8::MoeUpOrder S{ntiles, G, vcu, texp, tord, tready};
              pg8::EpiGateUp E{WSB(WS_HH), (const float*)RIDX}; pg8::gemm_phase<pg8::EpiGateUp, pg8::MoeUpOrder, MOEALIGN, true>(ldsl + RING_OFF, g, S, E, gtab); }
            { pg8::Gemm g{WSB(WS_HH), WSB(WS_WDN), PMAX, NE * D, FF}; pg8::MoeDownOrder S{ntiles, G, vcu, texp, tord, tready, (unsigned*)(ctl + CW_BAR) + XB_TMO};
              pg8::EpiDown E{WSB(WS_YD)}; pg8::gemm_phase<pg8::EpiDown, pg8::MoeDownOrder, MOEALIGN>(ldsl + RING_OFF, g, S, E); }
        }
    }
    SEAM(13);
    if (IN(14)) REP(14) {
        const float* g_final = ARGF(26);
        LAS int* offs = (LAS int*)(ldsl + OFFS_OFF);
        __syncthreads();
        if (tid < NE) offs[128 + tid] = (int)__hip_atomic_load(&COUNTS[64 * tid], RLX_AGENT);
        __syncthreads();
        if (tid == 0) { int t = 0; for (int e = 0; e < NE; ++e) { offs[e] = t * 256; t += (offs[128 + e] + 255) / 256; } }
        __syncthreads();
        {
            typedef unsigned long long u64;
            const GAS f32x4* gr = (const GAS f32x4*)g_final + lane; f32x4 gg[4];
#pragma unroll
            for (int j = 0; j < 4; ++j) gg[j] = gr[64 * j];
            u64 ra[2][4], rb[2][4], rx[2][4]; float w0[2], w1[2];
            auto ld = [&](int m, int b) { const size_t s0 = (size_t)(offs[EID[2 * m]] + SLOT[2 * m]), s1 = (size_t)(offs[EID[2 * m + 1]] + SLOT[2 * m + 1]); w0[b] = EW[2 * m]; w1[b] = EW[2 * m + 1];
                const GAS u64* xr = (const GAS u64*)(WSB(WS_X2B) + (size_t)m * D) + lane; const GAS u64* y0 = (const GAS u64*)(WSB(WS_YD) + s0 * D) + lane; const GAS u64* y1 = (const GAS u64*)(WSB(WS_YD) + s1 * D) + lane;
                _Pragma("unroll") for (int j = 0; j < 4; ++j) { ra[b][j] = y0[64 * j]; rb[b][j] = y1[64 * j]; rx[b][j] = xr[64 * j]; } };
            auto fin = [&](int m, int b) { f32x4 v[4]; float ss = 0.f;
                _Pragma("unroll") for (int j = 0; j < 4; ++j) { const u64 a = ra[b][j], bq = rb[b][j], xw = rx[b][j];
                    const unsigned al = (unsigned)a, ah = (unsigned)(a >> 32), bl = (unsigned)bq, bh = (unsigned)(bq >> 32), xl = (unsigned)xw, xh = (unsigned)(xw >> 32);
                    const f32x4 ya = (f32x4){pg8::bf_lo(al), pg8::bf_hi(al), pg8::bf_lo(ah), pg8::bf_hi(ah)}, yb = (f32x4){pg8::bf_lo(bl), pg8::bf_hi(bl), pg8::bf_lo(bh), pg8::bf_hi(bh)};
                    v[j] = (f32x4){pg8::bf_lo(xl), pg8::bf_hi(xl), pg8::bf_lo(xh), pg8::bf_hi(xh)} + (ya * w0[b] + yb * w1[b]); ss += (v[j].x * v[j].x + v[j].y * v[j].y) + (v[j].z * v[j].z + v[j].w * v[j].w); }
                const float rstd = 1.f / sqrtf(wave_sum(ss) * (1.f / D) + EPS);
                GAS f32x4* o = (GAS f32x4*)(args.out + (size_t)m * D) + lane;
                _Pragma("unroll") for (int j = 0; j < 4; ++j) o[64 * j] = v[j] * rstd * gg[j]; };
            int m = gw; if (m < M) ld(m, 0);
            while (m < M) {
                const int m1 = m + NGW; if (m1 < M) ld(m1, 1);
                fin(m, 0); if (m1 >= M) break;
                const int m2 = m1 + NGW; if (m2 < M) ld(m2, 0);
                fin(m1, 1); m = m2;
            }
        }
    }
#ifdef TSPROBE
    TSTAMP(15); __syncthreads();
    if (bx == 0 && tid == 0) { asm volatile("s_waitcnt vmcnt(0)" ::: "memory"); const unsigned long long* T = (const unsigned long long*)(ctl + 512);
        unsigned long long a = T[TSPROBE], b = 0; for (int i = TSPROBE + 1; i <= 15; ++i) { b = __hip_atomic_load(&T[i], RLX_AGENT); if (b > a) break; }
        args.out[0] = (float)(b - __hip_atomic_load(&T[TSPROBE], RLX_AGENT)) * 0.01f; }
#endif
#undef IN
#undef SEAM
#undef WSB
}
#if MODE >= 1 && MODE <= 5
constexpr int NV_PMAX = M * 2 + NE * 64, NV_NTILES = NV_PMAX / 64;
template <typename TA> __device__ __forceinline__ float4 ld4(const TA* p);
template <> __device__ __forceinline__ float4 ld4<float>(const float* p) { return *(const float4*)p; }
template <> __device__ __forceinline__ float4 ld4<bf16>(const bf16* p) { const uint2 w = *(const uint2*)p; return make_float4(pg8::bf_lo(w.x), pg8::bf_hi(w.x), pg8::bf_lo(w.y), pg8::bf_hi(w.y)); }
template <typename TA> __global__ __launch_bounds__(256) void k_gemm(const TA* __restrict__ A, int lda, const float* __restrict__ B, int ldb, float* __restrict__ C, int ldc,
                                              int Mr, int N, int K, const int* __restrict__ rowidx, const int* __restrict__ tile_group, long b_group_stride) {
    __shared__ float As[16][65];
    __shared__ float Bs[16][64];
    const int tx = threadIdx.x & 15, ty = threadIdx.x >> 4;
    const int m0 = blockIdx.y * 64, n0 = blockIdx.x * 64;
    const float* Bg = B;
    if (tile_group) { const int g = tile_group[blockIdx.y]; if (g < 0) return; Bg = B + (long)g * b_group_stride; }
    float acc[4][4];
#pragma unroll
    for (int i = 0; i < 4; ++i)
#pragma unroll
        for (int j = 0; j < 4; ++j) acc[i][j] = 0.f;
    const int ar = threadIdx.x >> 2, ak = (threadIdx.x & 3) * 4;
    const int arow = m0 + ar; long asrc = -1;
    if (arow < Mr) asrc = rowidx ? (long)rowidx[arow] : (long)arow;
    const int bk = threadIdx.x >> 4, bn = (threadIdx.x & 15) * 4;
    for (int k0 = 0; k0 < K; k0 += 16) {
        float4 av = make_float4(0.f, 0.f, 0.f, 0.f);
        if (asrc >= 0) av = ld4<TA>(A + asrc * lda + k0 + ak);
        As[ak + 0][ar] = av.x; As[ak + 1][ar] = av.y; As[ak + 2][ar] = av.z; As[ak + 3][ar] = av.w;
#pragma unroll
        for (int j = 0; j < 4; ++j) { const int n = n0 + bn + j; Bs[bk][bn + j] = (n < N) ? Bg[(long)(k0 + bk) * ldb + n] : 0.f; }
        __syncthreads();
#pragma unroll
        for (int kk = 0; kk < 16; ++kk) {
            float a0 = As[kk][ty * 4 + 0], a1 = As[kk][ty * 4 + 1], a2 = As[kk][ty * 4 + 2], a3 = As[kk][ty * 4 + 3];
            float b0 = Bs[kk][tx * 4 + 0], b1 = Bs[kk][tx * 4 + 1], b2 = Bs[kk][tx * 4 + 2], b3 = Bs[kk][tx * 4 + 3];
            acc[0][0] += a0 * b0; acc[0][1] += a0 * b1; acc[0][2] += a0 * b2; acc[0][3] += a0 * b3;
            acc[1][0] += a1 * b0; acc[1][1] += a1 * b1; acc[1][2] += a1 * b2; acc[1][3] += a1 * b3;
            acc[2][0] += a2 * b0; acc[2][1] += a2 * b1; acc[2][2] += a2 * b2; acc[2][3] += a2 * b3;
            acc[3][0] += a3 * b0; acc[3][1] += a3 * b1; acc[3][2] += a3 * b2; acc[3][3] += a3 * b3;
        }
        __syncthreads();
    }
#pragma unroll
    for (int i = 0; i < 4; ++i) { const int r = m0 + ty * 4 + i; if (r >= Mr) continue;
#pragma unroll
        for (int j = 0; j < 4; ++j) { const int c = n0 + tx * 4 + j; if (c < N) C[(long)r * ldc + c] = acc[i][j]; } }
}
__global__ __launch_bounds__(64) void k_rmsnorm(const float* __restrict__ in, int ldi, const float* __restrict__ g, float* __restrict__ out, int ldo, int cols) {
    const long r = blockIdx.x; const int lane = threadIdx.x;
    float s = 0.f;
    for (int c = lane; c < cols; c += 64) { const float v = in[r * ldi + c]; s += v * v; }
    s = wave_sum(s);
    const float rs = 1.0f / sqrtf(s / (float)cols + EPS);
    for (int c = lane; c < cols; c += 64) out[r * ldo + c] = in[r * ldi + c] * rs * g[c];
}
__global__ void k_add(const float* __restrict__ a, const float* __restrict__ b, float* __restrict__ o) {
    const long i = (long)blockIdx.x * blockDim.x + threadIdx.x; o[i] = a[i] + b[i];
}
__global__ __launch_bounds__(64) void k_xattn(const float* __restrict__ QM, const float* __restrict__ KVM, float* __restrict__ OM) {
    const int h = blockIdx.y, half = blockIdx.z; const long m = (long)blockIdx.x * 64 + threadIdx.x; const int b = (int)(m / SEQ);
    float q[XD], o[64];
#pragma unroll
    for (int d = 0; d < XD; ++d) q[d] = QM[m * (XH * XD) + h * XD + d];
#pragma unroll
    for (int d = 0; d < 64; ++d) o[d] = 0.f;
    float mr = -1e30f, l = 0.f; const float scale = 1.0f / sqrtf((float)XD);
    for (int j = 0; j < MEM; ++j) {
        const float* k = KVM + ((long)b * MEM + j) * (2 * XH * XD) + h * XD; const float* v = k + XH * XD + half * 64;
        float sc = 0.f;
#pragma unroll
        for (int d = 0; d < XD; ++d) sc += q[d] * k[d];
        sc *= scale;
        const float mn = fmaxf(mr, sc), al = expf(mr - mn), p = expf(sc - mn);
        l = l * al + p;
#pragma unroll
        for (int d = 0; d < 64; ++d) o[d] = o[d] * al + p * v[d];
        mr = mn;
    }
    const float il = 1.0f / l;
#pragma unroll
    for (int d = 0; d < 64; ++d) OM[m * (XH * XD) + h * XD + half * 64 + d] = o[d] * il;
}
__global__ void k_route(const float* __restrict__ GL, const float* __restrict__ EL, const float* __restrict__ brg, const float* __restrict__ bre,
                        int* __restrict__ eid, float* __restrict__ ew, int* __restrict__ counts) {
    const int n = blockIdx.x * blockDim.x + threadIdx.x; if (n >= M) return;
    float gl[NG]; float gm = -1e30f; int gi = 0;
#pragma unroll
    for (int g = 0; g < NG; ++g) { gl[g] = GL[(long)n * NG + g] + brg[g]; if (gl[g] > gm) { gm = gl[g]; gi = g; } }
    float se = 0.f;
#pragma unroll
    for (int g = 0; g < NG; ++g) se += expf(gl[g] - gm);
    const float pg = 1.0f / se;
    float v0 = -1e30f, v1 = -1e30f; int i0 = 0, i1 = 0;
    for (int e = 0; e < EPG; ++e) { const float v = EL[(long)n * NE + gi * EPG + e] + bre[gi * EPG + e];
        if (v > v0) { v1 = v0; i1 = i0; v0 = v; i0 = e; } else if (v > v1) { v1 = v; i1 = e; } }
    const float e1 = expf(v1 - v0), w0 = pg / (1.0f + e1), w1 = pg * e1 / (1.0f + e1);
    eid[2 * n] = gi * EPG + i0; eid[2 * n + 1] = gi * EPG + i1; ew[2 * n] = w0; ew[2 * n + 1] = w1;
    atomicAdd(&counts[gi * EPG + i0], 1); atomicAdd(&counts[gi * EPG + i1], 1);
}
__global__ void k_scan(const int* __restrict__ counts, int* __restrict__ offs, int* __restrict__ cursor, int* __restrict__ tile_group, int* __restrict__ rowidx) {
    __shared__ int so[NE + 1];
    if (threadIdx.x == 0) { int a = 0; for (int e = 0; e < NE; ++e) { so[e] = a; a += (counts[e] + 63) / 64 * 64; } so[NE] = a; }
    __syncthreads();
    if (threadIdx.x < NE) { offs[threadIdx.x] = so[threadIdx.x]; cursor[threadIdx.x] = 0; }
    for (int t = threadIdx.x; t < NV_NTILES; t += blockDim.x) { int g = -1; const int r = t * 64; if (r < so[NE]) { for (int e = 0; e < NE; ++e) if (r >= so[e] && r < so[e + 1]) g = e; } tile_group[t] = g; }
    for (int r = threadIdx.x; r < NV_PMAX; r += blockDim.x) rowidx[r] = -1;
}
__global__ void k_scatter(const int* __restrict__ eid, const int* __restrict__ offs, int* __restrict__ cursor, int* __restrict__ rowidx, int* __restrict__ slot) {
    const int i = blockIdx.x * blockDim.x + threadIdx.x; if (i >= 2 * M) return;
    const int e = eid[i]; const int p = offs[e] + atomicAdd(&cursor[e], 1);
    rowidx[p] = i >> 1; slot[i] = p;
}
__global__ void k_silu(const float* __restrict__ GU, float* __restrict__ HH) {
    const long i = (long)blockIdx.x * blockDim.x + threadIdx.x; const long r = i >> 8; const int c = (int)(i & 255);
    const float g = GU[r * 512 + c], u = GU[r * 512 + 256 + c];
    HH[i] = g / (1.0f + expf(-g)) * u;
}
__global__ __launch_bounds__(64) void k_final(const float* __restrict__ X2, const float* __restrict__ YD, const int* __restrict__ slot, const float* __restrict__ ew,
                                              const float* __restrict__ g, float* __restrict__ out) {
    const long m = blockIdx.x; const int lane = threadIdx.x;
    const long s0 = slot[2 * m], s1 = slot[2 * m + 1]; const float w0 = ew[2 * m], w1 = ew[2 * m + 1];
    float v[16]; float ss = 0.f;
#pragma unroll
    for (int j = 0; j < 16; ++j) { const int c = lane + 64 * j; v[j] = X2[m * D + c] + (w0 * YD[s0 * D + c] + w1 * YD[s1 * D + c]); ss += v[j] * v[j]; }
    ss = wave_sum(ss); const float rs = 1.0f / sqrtf(ss / (float)D + EPS);
#pragma unroll
    for (int j = 0; j < 16; ++j) { const int c = lane + 64 * j; out[m * D + c] = v[j] * rs * g[c]; }
}

__global__ __launch_bounds__(64) void k_mla_attn_b(const bf16* __restrict__ Q, const bf16* __restrict__ KN, const bf16* __restrict__ KR, const bf16* __restrict__ V, float* __restrict__ O) {
    const int h = blockIdx.y; const long m = (long)blockIdx.x * 64 + threadIdx.x; const int b = (int)(m / SEQ), s = (int)(m % SEQ);
    const int smax = (int)(((long)blockIdx.x * 64) % SEQ) + 63;
    float q[DQK], o[DV];
#pragma unroll
    for (int d = 0; d < DN; ++d) q[d] = pg8::bf_lo(Q[m * 768 + h * 64 + d]);
#pragma unroll
    for (int d = 0; d < DR; ++d) q[DN + d] = pg8::bf_lo(Q[m * 768 + 512 + h * 32 + d]);
#pragma unroll
    for (int d = 0; d < DV; ++d) o[d] = 0.f;
    float mr = -1e30f, l = 0.f; const float scale = 1.0f / sqrtf((float)DQK);
    for (int j = 0; j <= smax; ++j) {
        const long mk = (long)b * SEQ + j;
        const bf16* kn = KN + mk * 512 + h * 64; const bf16* kr = KR + mk * 32; const bf16* vv = V + mk * 512 + h * 64;
        float sc = 0.f;
#pragma unroll
        for (int d = 0; d < DN; ++d) sc += q[d] * pg8::bf_lo(kn[d]);
#pragma unroll
        for (int d = 0; d < DR; ++d) sc += q[DN + d] * pg8::bf_lo(kr[d]);
        sc *= scale;
        if (j <= s) {
            const float mn = fmaxf(mr, sc), al = expf(mr - mn), p = expf(sc - mn);
            l = l * al + p;
#pragma unroll
            for (int d = 0; d < DV; ++d) o[d] = o[d] * al + p * pg8::bf_lo(vv[d]);
            mr = mn;
        }
    }
    const float il = 1.0f / l;
#pragma unroll
    for (int d = 0; d < DV; ++d) O[m * (NH * DV) + h * DV + d] = o[d] * il;
}
__global__ void k_mix_b(const bf16* __restrict__ G, float* __restrict__ BA, const float* __restrict__ BB) {
    const long i = (long)blockIdx.x * blockDim.x + threadIdx.x; const long m = i >> 10; const int c = (int)(i & 1023);
    BA[i] = pg8::bf_lo(G[m * 2048 + c]) * BA[i] + pg8::bf_lo(G[m * 2048 + 1024 + c]) * BB[i];
}
__global__ void k_cvt_b(const bf16* __restrict__ a, float* __restrict__ o) { const long i = (long)blockIdx.x * blockDim.x + threadIdx.x; o[i] = pg8::bf_lo(a[i]); }

__global__ void k_ovr_g(const float* __restrict__ GLOG, const float* __restrict__ bg, bf16* __restrict__ G, int half) {
    const long i = (long)blockIdx.x * blockDim.x + threadIdx.x; const long m = i >> 10; const int c = (int)(i & 1023);
    G[m * 2048 + half * 1024 + c] = (bf16)f2bf(1.0f / (1.0f + expf(-(GLOG[i] + bg[half * 1024 + c]))));
}
__global__ void k_ovr_conv(const float* __restrict__ BCX, const float* __restrict__ cw, bf16* __restrict__ CONV) {
    const long m = blockIdx.x; const int c = threadIdx.x; const int s = (int)(m % SEQ);
    const float* p = BCX + m * 1536;
    float y = cw[2 * CW + c] * (p[CW + c] * p[2 * CW + c]);
    if (s >= 1) y += cw[1 * CW + c] * (p[-1536 + CW + c] * p[-1536 + 2 * CW + c]);
    if (s >= 2) y += cw[0 * CW + c] * (p[-3072 + CW + c] * p[-3072 + 2 * CW + c]);
    CONV[m * CW + c] = (bf16)f2bf(p[c] * y);
}
__global__ void k_ovr_qkv(const float* __restrict__ Qf, const float* __restrict__ KVf, const float* __restrict__ P416, const int* __restrict__ pos,
                          bf16* __restrict__ Q, bf16* __restrict__ KN, bf16* __restrict__ V, bf16* __restrict__ KR) {
    const long m = blockIdx.x; const int t = threadIdx.x;
    { const int h = t >> 7, d = t & 127; const float v = KVf[m * 1024 + t]; if (d < 64) KN[m * 512 + h * 64 + d] = (bf16)f2bf(v); else V[m * 512 + h * 64 + (d - 64)] = (bf16)f2bf(v); }
    if (t < 768) { const int h = t / 96, d = t % 96; if (d < 64) Q[m * 768 + h * 64 + d] = (bf16)f2bf(Qf[m * 768 + t]); }
    if (t < 128) { const int h = t >> 4, j = t & 15; const float inv = powf(10000.0f, -(float)(2 * j) / 32.0f); const float ang = (float)pos[m] * inv; const float c = cosf(ang), s = sinf(ang);
        const float x1 = Qf[m * 768 + h * 96 + 64 + j], x2 = Qf[m * 768 + h * 96 + 80 + j];
        Q[m * 768 + 512 + h * 32 + rope_pos(j)] = (bf16)f2bf(x1 * c - x2 * s); Q[m * 768 + 512 + h * 32 + rope_pos(16 + j)] = (bf16)f2bf(x1 * s + x2 * c);
        if (h == 0) { const float k1 = P416[m * 416 + 384 + j], k2 = P416[m * 416 + 400 + j]; KR[m * 32 + rope_pos(j)] = (bf16)f2bf(k1 * c - k2 * s); KR[m * 32 + rope_pos(16 + j)] = (bf16)f2bf(k1 * s + k2 * c); } }
}

#ifdef DIAG
__global__ void k_diag_cmp(const bf16* __restrict__ G, const bf16* __restrict__ G2, unsigned* __restrict__ cnt) {
    const long i = (long)blockIdx.x * blockDim.x + threadIdx.x; const long m = i >> 11; const int c = (int)(i & 2047);
    const float d = fabsf(pg8::bf_lo(G[i]) - pg8::bf_lo(G2[i]));
    int cls = DIAG_CLS(m, c);
    if (d > 0.02f) atomicAdd(&cnt[cls], 1u);
    atomicAdd(&cnt[8 + cls], 1u);
}
__global__ void k_diag_enc(float* __restrict__ out, const unsigned* __restrict__ cnt) {
    const long i = (long)blockIdx.x * blockDim.x + threadIdx.x;
    const float f0 = (float)cnt[0] / fmaxf((float)cnt[8], 1.f), f1 = (float)cnt[1] / fmaxf((float)cnt[9], 1.f);
    (void)f0; (void)f1; out[i] = (i == 0) ? (100.0f + 100.0f * (float)(cnt[0] > (unsigned)(DIAG_GAIN)) + 200.0f * (float)(cnt[0] > (unsigned)(DIAG_GAIN * 100.0f))) : 0.0f;
}
#endif
template <typename TA> static void gemm(hipStream_t st, const TA* A, int lda, const float* B, int ldb, float* C, int ldc, int Mr, int N, int K,
                 const int* rowidx = nullptr, const int* tg = nullptr, long gs = 0) {
    dim3 grid((N + 63) / 64, (Mr + 63) / 64);
    hipLaunchKernelGGL(k_gemm<TA>, grid, dim3(256), 0, st, A, lda, B, ldb, C, ldc, Mr, N, K, rowidx, tg, gs);
}
#endif

extern "C" void kernel_launch(void* const* d_in, const int* in_sizes, int n_in, void* d_out, int out_size, void* d_ws, size_t ws_size, hipStream_t stream) {
    static int grid = 0;
    if (grid == 0) {
        if (n_in != 27 || in_sizes[0] != M * D || out_size != M * D || ws_size < WS_END) { fprintf(stderr, "kernel_launch: unexpected shapes: n_in %d in0 %d out %d ws %zu\n", n_in, n_in > 0 ? in_sizes[0] : -1, out_size, ws_size); grid = -1; return; }
        int dev = 0, cus = 0;
        if (hipGetDevice(&dev) != hipSuccess || hipDeviceGetAttribute(&cus, hipDeviceAttributeMultiprocessorCount, dev) != hipSuccess) { grid = -1; return; }
        if (hipFuncSetAttribute((const void*)mega_fwd, hipFuncAttributeMaxDynamicSharedMemorySize, LDS_BYTES) != hipSuccess) { fprintf(stderr, "kernel_launch: hipFuncSetAttribute failed\n"); grid = -1; return; }
        (void)hipGetLastError();
        grid = cus;
        if (grid != 256) fprintf(stderr, "kernel_launch: %d CUs (built for 256)\n", grid);
    }
    if (grid < 0) return;
#ifndef NPASS
#define NPASS 1
#endif
    for (int pass_ = 0; pass_ < NPASS; ++pass_) {
    if (hipMemsetAsync((char*)d_ws + WS_CTL, 0, CTL_ZERO_BYTES, stream) != hipSuccess) return;
    Args a{};
    for (int i = 0; i < 27; ++i) a.in[i] = (const float*)d_in[i];
    a.out = (float*)d_out; a.ws = (unsigned char*)d_ws;
#ifdef DIAG
    (void)hipMemsetAsync((char*)d_ws + WS_G, 0xAA, (size_t)M * 2048 * 2, stream);
#endif
    constexpr int FAST_HI = (MODE == 1) ? 6 : (MODE == 2) ? 9 : (MODE == 3) ? 3 : (MODE == 4) ? 4 : (MODE == 5) ? 5 : NPHASE;
#if PER_PHASE
    for (int p = 0; p < FAST_HI; ++p) { a.ph_lo = p; a.ph_hi = p + 1;
#ifdef P1SPLIT
        if (p == 1) { for (int s = 0; s < 4; ++s) { a.sub = s; hipLaunchKernelGGL(mega_fwd, dim3(grid), dim3(NWAVES * 64), LDS_BYTES, stream, a); } a.sub = 0; continue; }
#endif
        hipLaunchKernelGGL(mega_fwd, dim3(grid), dim3(NWAVES * 64), LDS_BYTES, stream, a); }
#ifdef EXTRA_PHASE
    { a.ph_lo = EXTRA_PHASE; a.ph_hi = EXTRA_PHASE + 1; hipLaunchKernelGGL(mega_fwd, dim3(grid), dim3(NWAVES * 64), LDS_BYTES, stream, a); }
#endif
#else
    a.ph_lo = 0; a.ph_hi = FAST_HI;
    hipLaunchKernelGGL(mega_fwd, dim3(grid), dim3(NWAVES * 64), LDS_BYTES, stream, a);
#endif
#if MODE >= 1 && MODE <= 5
    {
        char* ws = (char*)d_ws; float* out = (float*)d_out;
        const float* mem = (const float*)d_in[1]; const float* g_xattn = (const float*)d_in[14]; const float* g_mem = (const float*)d_in[15]; const float* w_q_mem = (const float*)d_in[16];
        const float* w_kv_mem = (const float*)d_in[17]; const float* w_o_mem = (const float*)d_in[18]; const float* g_moe = (const float*)d_in[19]; const float* w_rg = (const float*)d_in[20];
        const float* b_rg = (const float*)d_in[21]; const float* w_re = (const float*)d_in[22]; const float* b_re = (const float*)d_in[23]; const float* w_gu = (const float*)d_in[24];
        const float* w_dn = (const float*)d_in[25]; const float* g_final = (const float*)d_in[26];
#define WSF(mib) ((float*)(ws + (size_t)(mib) * MiB))
        float* XA = WSF(448);
        float* X2 = XA;
#if MODE >= 3 && MODE <= 5
        {
            const float* x = (const float*)d_in[0]; const float* w_a = (const float*)d_in[11]; const float* w_b = (const float*)d_in[12]; const float* w_out = (const float*)d_in[13];
            const bf16* fQ = (const bf16*)(ws + WS_Q); const bf16* fKN = (const bf16*)(ws + WS_KN); const bf16* fKR = (const bf16*)(ws + WS_KR); const bf16* fV = (const bf16*)(ws + WS_V);
            const bf16* fATT = (const bf16*)(ws + WS_ATT); const bf16* fCONV = (const bf16*)(ws + WS_CONV); const bf16* fG = (const bf16*)(ws + WS_G); const bf16* fMIX = (const bf16*)(ws + WS_MIX);
            float* ATTf = WSF(0); float* BA = WSF(32); float* BB = WSF(347); float* T = WSF(347);
#ifdef DIAG
#define OVR_G_DST (363 * MiB)
#else
#define OVR_G_DST WS_G
#endif
#ifdef OVR
            {   const float* g_mix = (const float*)d_in[3]; const float* w_in = (const float*)d_in[4]; const float* b_gate = (const float*)d_in[5]; const float* conv_w = (const float*)d_in[10];
                const float* g_cq = (const float*)d_in[6]; const float* w_uq = (const float*)d_in[7]; const float* g_ckv = (const float*)d_in[8]; const float* w_ukv = (const float*)d_in[9]; const int* pos = (const int*)d_in[2];
                float* H = WSF(0);
                hipLaunchKernelGGL(k_rmsnorm, dim3(M), dim3(64), 0, stream, x, D, g_mix, H, D, D);
#if OVR == 1
                for (int half = 0; half < 2; ++half) { float* GLOG = WSF(64);
                    gemm<float>(stream, H, D, w_in + COL_CONV + half * 1024, IN_COLS, GLOG, 1024, M, 1024, D);
                    hipLaunchKernelGGL(k_ovr_g, dim3(M * 1024 / 256), dim3(256), 0, stream, GLOG, b_gate, (bf16*)(ws + OVR_G_DST), half); }
#ifdef DIAG
                (void)hipMemsetAsync(ws + 444 * MiB + 524288, 0, 64, stream);
                hipLaunchKernelGGL(k_diag_cmp, dim3(M * 2048 / 256), dim3(256), 0, stream, (const bf16*)(ws + WS_G), (const bf16*)(ws + OVR_G_DST), (unsigned*)(ws + 444 * MiB + 524288));
                (void)hipMemcpyAsync(ws + WS_G, ws + OVR_G_DST, (size_t)M * 2048 * 2, hipMemcpyDeviceToDevice, stream);
#endif
#elif OVR == 2
                float* BCX = WSF(347);
                gemm<float>(stream, H, D, w_in + COL_KR, IN_COLS, BCX, 1536, M, 1536, D);
                hipLaunchKernelGGL(k_ovr_conv, dim3(M), dim3(512), 0, stream, BCX, conv_w, (bf16*)(ws + WS_CONV));
#elif OVR == 3
                float* P416 = WSF(64); float* CQN = WSF(90); float* CKVN = WSF(106); float* Qf = WSF(347); float* KVf = WSF(0);
                gemm<float>(stream, H, D, w_in, IN_COLS, P416, 416, M, 416, D);
                hipLaunchKernelGGL(k_rmsnorm, dim3(M), dim3(64), 0, stream, P416, 416, g_cq, CQN, QL, QL);
                hipLaunchKernelGGL(k_rmsnorm, dim3(M), dim3(64), 0, stream, P416 + 256, 416, g_ckv, CKVN, KVL, KVL);
                gemm<float>(stream, CQN, QL, w_uq, 768, Qf, 768, M, 768, QL);
                gemm<float>(stream, CKVN, KVL, w_ukv, 1024, KVf, 1024, M, 1024, KVL);
                hipLaunchKernelGGL(k_ovr_qkv, dim3(M), dim3(1024), 0, stream, Qf, KVf, P416, pos, (bf16*)(ws + WS_Q), (bf16*)(ws + WS_KN), (bf16*)(ws + WS_V), (bf16*)(ws + WS_KR));
#endif
            }
#endif
#if MODE == 3
            hipLaunchKernelGGL(k_mla_attn_b, dim3(M / 64, NH), dim3(64), 0, stream, fQ, fKN, fKR, fV, ATTf);
            gemm<float>(stream, ATTf, 512, w_a, D, BA, D, M, D, 512);
#elif MODE == 4
            gemm<bf16>(stream, fATT, 512, w_a, D, BA, D, M, D, 512);
#endif
#if MODE == 3 || MODE == 4
            gemm<bf16>(stream, fCONV, CW, w_b, D, BB, D, M, D, CW);
            hipLaunchKernelGGL(k_mix_b, dim3(M * D / 256), dim3(256), 0, stream, fG, BA, BB);
            gemm<float>(stream, BA, D, w_out, D, T, D, M, D, D);
#else
            gemm<bf16>(stream, fMIX, D, w_out, D, T, D, M, D, D);
#endif
            hipLaunchKernelGGL(k_add, dim3(M * D / 256), dim3(256), 0, stream, x, T, WSF(448));
        }
#endif
#if MODE == 1 || (MODE >= 3 && MODE <= 5)
        float* H2 = WSF(128); float* MEMN = WSF(192); float* KVM = WSF(200); float* QM = WSF(208); float* OM = WSF(240); float* T2 = WSF(0); X2 = WSF(272);
        hipLaunchKernelGGL(k_rmsnorm, dim3(M), dim3(64), 0, stream, XA, D, g_xattn, H2, D, D);
        hipLaunchKernelGGL(k_rmsnorm, dim3(MM), dim3(64), 0, stream, mem, D, g_mem, MEMN, D, D);
        gemm<float>(stream, H2, D, w_q_mem, XH * XD, QM, XH * XD, M, XH * XD, D);
        gemm<float>(stream, MEMN, D, w_kv_mem, 2 * XH * XD, KVM, 2 * XH * XD, MM, 2 * XH * XD, D);
        hipLaunchKernelGGL(k_xattn, dim3(M / 64, XH, 2), dim3(64), 0, stream, QM, KVM, OM);
        gemm<float>(stream, OM, XH * XD, w_o_mem, D, T2, D, M, D, XH * XD);
        hipLaunchKernelGGL(k_add, dim3(M * D / 256), dim3(256), 0, stream, XA, T2, X2);
#endif
        float* H3 = WSF(192); float* GL = WSF(256); float* EL = WSF(257); int* RIDXn = (int*)WSF(261); float* GU = WSF(336); float* HH = WSF(408); float* YD = WSF(0);
        int* CNT = (int*)WSF(444); int* OFFS = CNT + 64; int* CUR = CNT + 128; int* TG = CNT + 256; int* EIDn = (int*)WSF(445); float* EWn = WSF(446); int* SLOTn = (int*)WSF(447);
        hipLaunchKernelGGL(k_rmsnorm, dim3(M), dim3(64), 0, stream, X2, D, g_moe, H3, D, D);
        gemm<float>(stream, H3, D, w_rg, NG, GL, NG, M, NG, D);
        gemm<float>(stream, H3, D, w_re, NE, EL, NE, M, NE, D);
        (void)hipMemsetAsync(CNT, 0, 64 * sizeof(int), stream);
        hipLaunchKernelGGL(k_route, dim3(M / 256), dim3(256), 0, stream, GL, EL, b_rg, b_re, EIDn, EWn, CNT);
        hipLaunchKernelGGL(k_scan, dim3(1), dim3(1024), 0, stream, CNT, OFFS, CUR, TG, RIDXn);
        hipLaunchKernelGGL(k_scatter, dim3(2 * M / 256), dim3(256), 0, stream, EIDn, OFFS, CUR, RIDXn, SLOTn);
        gemm<float>(stream, H3, D, w_gu, 2 * FF, GU, 2 * FF, NV_PMAX, 2 * FF, D, RIDXn, TG, (long)D * 2 * FF);
        hipLaunchKernelGGL(k_silu, dim3(NV_PMAX * FF / 256), dim3(256), 0, stream, GU, HH);
        gemm<float>(stream, HH, FF, w_dn, D, YD, D, NV_PMAX, D, FF, nullptr, TG, (long)FF * D);
        hipLaunchKernelGGL(k_final, dim3(M), dim3(64), 0, stream, X2, YD, SLOTn, EWn, g_final, out);
#ifdef DIAG
        hipLaunchKernelGGL(k_diag_enc, dim3(M * D / 256), dim3(256), 0, stream, out, (const unsigned*)(ws + 444 * MiB + 524288));
#endif
#undef WSF
    }
#endif
    }
    const hipError_t le = hipPeekAtLastError();
    if (le != hipSuccess) fprintf(stderr, "kernel_launch: launch failed: %s\n", hipGetErrorName(le));
}
```

```cpp
#define MODE 0
#define PER_PHASE 0
#include <hip/hip_runtime.h>
#include <cstdio>
#include <cstdint>
#include <cmath>
#ifndef MODE
#define MODE 0
#endif
#ifndef PER_PHASE
#define PER_PHASE 0
#endif
namespace pg8 {
#define PG8_LAS __attribute__((address_space(3)))
typedef unsigned short bf16_t;
typedef short bf16x8 __attribute__((ext_vector_type(8)));
typedef float f32x4 __attribute__((ext_vector_type(4)));
typedef unsigned u32x4 __attribute__((ext_vector_type(4)));
typedef unsigned u32x2 __attribute__((ext_vector_type(2)));
constexpr int BM = 256, BK = 64, HALF = 128, HTB = HALF * BK * 2  , STAGE_BYTES = 8 * HTB, NXCD = 8, WGM = 8;

__host__ __device__ __forceinline__ int lds_byte(int r, int c) { const int st = (r >> 4) * 2 + (c >> 5), rr = r & 15, cc = c & 31, ob = rr * 64 + cc * 2; return st * 1024 + (ob ^ (((ob >> 9) & 1) << 5)); }
__host__ __device__ __forceinline__ void stage_rc(int b, int& R, int& C) { const int st = b / 1024, sb = b % 1024, swz = sb ^ (((sb >> 9) & 1) << 5); R = (st >> 1) * 16 + swz / 64; C = (st & 1) * 32 + (swz % 64) / 2; }
__host__ __device__ __forceinline__ int perm32(int rho) { const int n = rho >> 4, i = rho & 15; return 8 * (i >> 2) + 4 * n + (i & 3); }

struct Unit { int pm, pn, sel, half; };
struct Gemm { const bf16_t* A; const bf16_t* Bt; int M, N, K; const bf16_t* A2 = nullptr; const bf16_t* Bt2 = nullptr; int ld = 0; };

struct StaticOrder {
    static constexpr bool HOOKS = false;
    int nM, nN, nwg, G, c, rot;
    __host__ __device__ void init(int M, int N, int G_, int c_, int rot_ = 0) { nM = M / BM; nN = N / BM; nwg = nM * nN; G = G_; c = c_; rot = rot_; }
    __host__ __device__ __forceinline__ bool next(int i, Unit& u) const {
        const long L = (long)i * G + c; if (L >= nwg) return false;
        int wgid = (int)L; { const int q = nwg / NXCD, r = nwg % NXCD, xcd = wgid % NXCD, off = wgid / NXCD; wgid = (xcd < r ? xcd * (q + 1) : r * (q + 1) + (xcd - r) * q) + off; }
        const int nig = WGM * nN, gid = wgid / nig, fm = gid * WGM, gsz = (nM - fm) < WGM ? (nM - fm) : WGM;
        u.pm = fm + ((wgid % nig) % gsz); u.pn = ((wgid % nig) / gsz + rot) % nN; u.sel = 0; u.half = 0; return true;
    }
};
struct PairOrder {
    static constexpr bool HOOKS = false;
    int pm, pn;
    __device__ __forceinline__ bool next(int i, Unit& u) const { if (i >= 2) return false; u.pm = pm; u.pn = pn; u.sel = i; u.half = 0; return true; }
};
struct PanelOrder {
    static constexpr bool HOOKS = false;
    int pm, nN, n0 = 0;
    __device__ __forceinline__ bool next(int i, Unit& u) const { if (i >= nN) return false; u.pm = pm; u.pn = n0 + i; u.sel = 0; u.half = 0; return true; }
};
template <int NT> struct TileOrder {
    static constexpr bool HOOKS = false;
    int tile, e;
    __device__ __forceinline__ bool next(int i, Unit& u) const { if (i >= NT) return false; u.pm = tile; u.pn = e * NT + i; u.sel = 0; u.half = 0; return true; }
};
#define MOE_RLX __ATOMIC_RELAXED, __HIP_MEMORY_SCOPE_AGENT
struct MoeUpOrder {
    static constexpr bool HOOKS = true;
    int ntiles, G, c; const PG8_LAS int* texp; const PG8_LAS int* tord; unsigned* ready;
    __device__ __forceinline__ bool next(int i, Unit& u) const {
        const int L = i * G + c; if (L >= ntiles * 2) return false;
        const int to = __builtin_amdgcn_readfirstlane(tord[L >> 1]), tile = to & 0xffff; u.pm = tile; u.pn = __builtin_amdgcn_readfirstlane(texp[tile]) * 2 + (L & 1); u.sel = 0; u.half = to >> 30; return true;
    }
    __device__ __forceinline__ void a_ready(const Unit&) const {}
    __device__ __forceinline__ void done(const Unit& u) const {
        asm volatile("s_waitcnt vmcnt(0)" ::: "memory");
        if ((threadIdx.x & 63) == 0) (void)__hip_atomic_fetch_add(ready + 64 * u.pm, 1u, MOE_RLX);
    }
};
struct MoeDownOrder {
    static constexpr bool HOOKS = true;
    int ntiles, G, c; const PG8_LAS int* texp; const PG8_LAS int* tord; const unsigned* ready; unsigned* tmo;
    __device__ __forceinline__ bool next(int i, Unit& u) const {
        const int total = 4 * ntiles, R2 = (2 * ntiles > G) ? 2 * ntiles - G : 0, n1 = G - R2;
        int p;
        if (c >= R2) { if (i >= 3) return false; p = (c - R2) + i * n1; if (p >= 3 * n1) return false; }
        else p = 3 * n1 + c + i * R2;
        if (p >= total) return false;
        const int to = __builtin_amdgcn_readfirstlane(tord[p >> 2]), tile = to & 0xffff; u.pm = tile; u.pn = __builtin_amdgcn_readfirstlane(texp[tile]) * 4 + (p & 3); u.sel = 0; u.half = to >> 30; return true;
    }
    __device__ __forceinline__ void a_ready(const Unit& u) const {
        if (threadIdx.x < 64) {
            unsigned sp = 0;
            while ((unsigned)__builtin_amdgcn_readfirstlane(__hip_atomic_load(ready + 64 * u.pm, MOE_RLX)) < 16u) {
                __builtin_amdgcn_s_sleep(2);
                if ((++sp & 255u) == 0u) { if (__builtin_amdgcn_readfirstlane(__hip_atomic_load(tmo, MOE_RLX)) != 0u) break; if (sp > (1u << 18)) { if (threadIdx.x == 0) __hip_atomic_store(tmo, 1u, MOE_RLX); break; } }
            }
            __builtin_amdgcn_fence(__ATOMIC_ACQUIRE, "agent");
            asm volatile("s_waitcnt vmcnt(0)" ::: "memory");
        }
        asm volatile("" ::: "memory"); __builtin_amdgcn_s_barrier(); asm volatile("" ::: "memory");
    }
    __device__ __forceinline__ void done(const Unit&) const {}
};

typedef float f32x2_t __attribute__((ext_vector_type(2))); typedef __bf16 bf16x2_t __attribute__((ext_vector_type(2)));
__device__ __forceinline__ unsigned cvt_pk_bf16(float lo, float hi) { f32x2_t v = {lo, hi}; bf16x2_t b = __builtin_convertvector(v, bf16x2_t); return __builtin_bit_cast(unsigned, b); }
__device__ __forceinline__ u32x4 pack8(const f32x4 a, const f32x4 b) { u32x4 w; w.x = cvt_pk_bf16(a[0], a[1]); w.y = cvt_pk_bf16(a[2], a[3]); w.z = cvt_pk_bf16(b[0], b[1]); w.w = cvt_pk_bf16(b[2], b[3]); return w; }
__device__ __forceinline__ float bf_lo(unsigned w) { return __uint_as_float(w << 16); }
__device__ __forceinline__ float bf_hi(unsigned w) { return __uint_as_float(w & 0xffff0000u); }
__device__ __forceinline__ void unpack8(const u32x4 w, f32x4& a, f32x4& b) { a = (f32x4){bf_lo(w.x), bf_hi(w.x), bf_lo(w.y), bf_hi(w.y)}; b = (f32x4){bf_lo(w.z), bf_hi(w.z), bf_lo(w.w), bf_hi(w.w)}; }

typedef int v4i_t __attribute__((ext_vector_type(4))); typedef int v8i_t __attribute__((ext_vector_type(8)));
__device__ __forceinline__ v8i_t cat16(const bf16x8 a, const bf16x8 b) { const v4i_t x = __builtin_bit_cast(v4i_t, a), y = __builtin_bit_cast(v4i_t, b); return __builtin_shufflevector(x, y, 0, 1, 2, 3, 4, 5, 6, 7); }
template <class Epi, class Sched, bool ALIGN_EPI, bool GATHER = false, bool FP8 = false, bool HALFN = FP8>
__device__ __forceinline__ void gemm_phase(PG8_LAS unsigned char* lds, const Gemm g, const Sched& S, const Epi& E, const PG8_LAS int* gtab = nullptr) {
    const int tid = threadIdx.x, wid = __builtin_amdgcn_readfirstlane(tid >> 6), lane = tid & 63, wr = wid >> 2, wc = wid & 3, fr = lane & 15, fq = lane >> 4;
    int K = g.K; asm volatile("" : "+s"(K));
    const int nt = K / BK; int LD = g.ld ? g.ld : g.K; asm volatile("" : "+s"(LD));
    unsigned voffB[2], vc[2][2], vn[2][2]; int RA[2], CA[2];
#pragma unroll
    for (int i = 0; i < 2; ++i) { int R, C; stage_rc(tid * 16 + i * 8192, R, C); const int Rb = Epi::PERM ? ((R & ~31) + perm32(R & 31)) : R;
        RA[i] = R; CA[i] = C; voffB[i] = (unsigned)(Rb * LD + C) * 2u;
#pragma unroll
        for (int h = 0; h < 2; ++h) { vc[h][i] = (unsigned)((h * HALF + R) * LD + C) * 2u; vn[h][i] = vc[h][i]; } }
    const size_t kstep = (size_t)(BK * 2);
    const size_t hstep = (size_t)HALF * LD * 2;
    const size_t tstep = 2 * hstep;
    const size_t bh = FP8 ? 0 : hstep, bts = FP8 ? hstep : tstep;
    const unsigned ldsw = (unsigned)wid * 1024u;
    const int aoff = lds_byte(wr * 64 + fr, fq * 8), boff = lds_byte(wc * 32 + fr, fq * 8);
#define PG8_SA(b, h) (((b) * 2 + (h)) * HTB)
#define PG8_SB(b, h) ((4 + (b) * 2 + (h)) * HTB)
#define PG8_STAGE_B(bufoff, gbase) do { _Pragma("unroll") for (int _i = 0; _i < 2; ++_i) \
        __builtin_amdgcn_global_load_lds((const unsigned*)((const char*)(gbase) + voffB[_i]), (PG8_LAS unsigned*)(lds + (bufoff) + ldsw + _i * 8192), 16, 0, 0); } while (0)
#define PG8_STAGE_A(bufoff, gbase, VO, h) do { _Pragma("unroll") for (int _i = 0; _i < 2; ++_i) \
        __builtin_amdgcn_global_load_lds((const unsigned*)((const char*)(gbase) + (VO)[h][_i]), (PG8_LAS unsigned*)(lds + (bufoff) + ldsw + _i * 8192), 16, 0, 0); } while (0)
#define PG8_LD8(p) __builtin_shufflevector(*(const PG8_LAS v4i_t*)(p), *(const PG8_LAS v4i_t*)((p) + 1024), 0, 1, 2, 3, 4, 5, 6, 7)
#define PG8_LDA(dst, b, h) do { if constexpr (FP8) { _Pragma("unroll") for (int m = 0; m < 4; ++m) dst##8[m] = PG8_LD8(lds + PG8_SA(b, h) + aoff + m * 2048); } \
        else { _Pragma("unroll") for (int m = 0; m < 4; ++m) _Pragma("unroll") for (int k = 0; k < 2; ++k) dst[m][k] = *(const PG8_LAS bf16x8*)(lds + PG8_SA(b, h) + aoff + m * 2048 + k * 1024); } } while (0)
#define PG8_LDB(dst, b, h) do { if constexpr (FP8) { _Pragma("unroll") for (int n = 0; n < 2; ++n) dst##8[n] = PG8_LD8(lds + PG8_SB(b, h) + boff + n * 2048); } \
        else { _Pragma("unroll") for (int n = 0; n < 2; ++n) _Pragma("unroll") for (int k = 0; k < 2; ++k) dst[n][k] = *(const PG8_LAS bf16x8*)(lds + PG8_SB(b, h) + boff + n * 2048 + k * 1024); } } while (0)
#define PG8_MMA(ai, bj, At, Bt) do { __builtin_amdgcn_s_setprio(1); \
        if constexpr (FP8) { _Pragma("unroll") for (int m = 0; m < 4; ++m) _Pragma("unroll") for (int n = 0; n < 2; ++n) \
            acc[ai][bj][m][n] = __builtin_amdgcn_mfma_scale_f32_16x16x128_f8f6f4(Bt##8[n], At##8[m], acc[ai][bj][m][n], 0, 0, 0, 127, 0, 127); } \
        else { _Pragma("unroll") for (int m = 0; m < 4; ++m) _Pragma("unroll") for (int n = 0; n < 2; ++n) _Pragma("unroll") for (int k = 0; k < 2; ++k) \
            acc[ai][bj][m][n] = __builtin_amdgcn_mfma_f32_16x16x32_bf16(Bt[n][k], At[m][k], acc[ai][bj][m][n], 0, 0, 0); } \
        __builtin_amdgcn_s_setprio(0); } while (0)
#define PG8_WAIT_V(n) asm volatile("s_waitcnt vmcnt(" #n ")" ::: "memory")
#define PG8_WAIT_L(n) asm volatile("s_waitcnt lgkmcnt(" #n ")" ::: "memory")
#define PG8_BAR __builtin_amdgcn_s_barrier()
#define PG8_SCHED __builtin_amdgcn_sched_barrier(0)
#define PG8_GTAB(VX, u) do { _Pragma("unroll") for (int _h = 0; _h < 2; ++_h) _Pragma("unroll") for (int _i = 0; _i < 2; ++_i) \
        VX[_h][_i] = (unsigned)gtab[(u) * 256 + _h * HALF + RA[_i]] * (unsigned)(LD * 2) + (unsigned)(CA[_i] * 2); } while (0)
    Unit cur, nxt; int ui = 0;
    if (!S.next(0, cur)) return;
    if constexpr (Sched::HOOKS) S.a_ready(cur);
    if constexpr (GATHER) { PG8_GTAB(vc, 0); }
    f32x4 acc[2][2][4][2];
#pragma unroll
    for (int a = 0; a < 2; ++a)
#pragma unroll
        for (int b = 0; b < 2; ++b)
#pragma unroll
            for (int m = 0; m < 4; ++m)
#pragma unroll
                for (int n = 0; n < 2; ++n) acc[a][b][m][n] = (f32x4){0.f, 0.f, 0.f, 0.f};
    bf16x8 At[4][2], B0[2][2], B1[2][2]; v8i_t At8[4], B08[2], B18[2];
    const char* cA = GATHER ? (const char*)g.A : (const char*)(cur.sel ? g.A2 : g.A) + (size_t)cur.pm * tstep; const char* cB = (const char*)(cur.sel ? g.Bt2 : g.Bt) + (size_t)cur.pn * bts;
    PG8_STAGE_B(PG8_SB(0, 0), cB); PG8_STAGE_B(PG8_SB(0, 1), cB + bh); PG8_STAGE_A(PG8_SA(0, 0), cA, vc, 0); PG8_STAGE_A(PG8_SA(0, 1), cA, vc, 1);
    if (wr == 1) PG8_BAR;
    PG8_WAIT_V(2); PG8_BAR;
    PG8_STAGE_B(PG8_SB(1, 0), cB + kstep); PG8_STAGE_A(PG8_SA(1, 0), cA + kstep, vc, 0); PG8_STAGE_B(PG8_SB(1, 1), cB + bh + kstep);
    PG8_WAIT_V(6); PG8_BAR;
#pragma nounroll
    for (;;) {
        const bool has_next = S.next(ui + 1, nxt);
        const char* nA = GATHER ? (const char*)g.A : (has_next ? (const char*)(nxt.sel ? g.A2 : g.A) + (size_t)nxt.pm * tstep : cA); const char* nB = has_next ? (const char*)(nxt.sel ? g.Bt2 : g.Bt) + (size_t)nxt.pn * bts : cB;
        if constexpr (GATHER) { if (has_next) { PG8_GTAB(vn, ui + 1); } else {
#pragma unroll
            for (int h = 0; h < 2; ++h)
#pragma unroll
                for (int i = 0; i < 2; ++i) vn[h][i] = vc[h][i]; } }
#pragma nounroll
        for (int t = 0; t < nt; t += 2) {
            const bool last = (t == nt - 2);
            const char* a1 = cA + (size_t)(t + 1) * kstep;
            const char* a2 = last ? nA : cA + (size_t)(t + 2) * kstep; const char* b2 = last ? nB : cB + (size_t)(t + 2) * kstep;
            const char* a3 = a2 + kstep; const char* b3 = b2 + kstep;
            if constexpr (Sched::HOOKS) { if (last && has_next) S.a_ready(nxt); }
            unsigned v2[2][2];
#pragma unroll
            for (int h = 0; h < 2; ++h)
#pragma unroll
                for (int i = 0; i < 2; ++i) v2[h][i] = (GATHER && last) ? vn[h][i] : vc[h][i];
            PG8_LDB(B0, 0, 0); if constexpr (!HALFN) PG8_LDB(B1, 0, 1); PG8_SCHED; PG8_LDA(At, 0, 0); PG8_STAGE_A(PG8_SA(1, 1), a1, vc, 1);
            PG8_WAIT_V(8); PG8_WAIT_L(0); PG8_BAR; PG8_MMA(0, 0, At, B0); if constexpr (!HALFN) PG8_MMA(0, 1, At, B1); PG8_BAR; PG8_SCHED;
            PG8_LDA(At, 0, 1); PG8_STAGE_B(PG8_SB(0, 0), b2); PG8_STAGE_B(PG8_SB(0, 1), b2 + bh); PG8_STAGE_A(PG8_SA(0, 0), a2, v2, 0);
            PG8_WAIT_V(8); PG8_WAIT_L(0); PG8_BAR; PG8_MMA(1, 0, At, B0); if constexpr (!HALFN) PG8_MMA(1, 1, At, B1); PG8_BAR; PG8_SCHED;
            PG8_LDB(B0, 1, 0); if constexpr (!HALFN) PG8_LDB(B1, 1, 1); PG8_SCHED; PG8_LDA(At, 1, 0); PG8_STAGE_A(PG8_SA(0, 1), a2, v2, 1);
            PG8_WAIT_V(8); PG8_WAIT_L(0); PG8_BAR; PG8_MMA(0, 0, At, B0); if constexpr (!HALFN) PG8_MMA(0, 1, At, B1); PG8_BAR; PG8_SCHED;
            PG8_LDA(At, 1, 1); PG8_STAGE_B(PG8_SB(1, 0), b3); PG8_STAGE_B(PG8_SB(1, 1), b3 + bh); PG8_STAGE_A(PG8_SA(1, 0), a3, v2, 0);
            PG8_WAIT_V(8); PG8_WAIT_L(0); PG8_BAR; PG8_MMA(1, 0, At, B0); if constexpr (!HALFN) PG8_MMA(1, 1, At, B1); PG8_BAR; PG8_SCHED;
        }
        if constexpr (ALIGN_EPI) { if (wr == 0) PG8_BAR; }
        { int fr_e = fr, fq_e = fq; asm volatile("" : "+v"(fr_e), "+v"(fq_e));
          E(acc, cur, wr, wc, fr_e, fq_e); }
        if constexpr (Sched::HOOKS) S.done(cur);
        if (!has_next) break;
#pragma unroll
        for (int a = 0; a < 2; ++a)
#pragma unroll
            for (int b = 0; b < 2; ++b)
#pragma unroll
                for (int m = 0; m < 4; ++m)
#pragma unroll
                    for (int n = 0; n < 2; ++n) acc[a][b][m][n] = (f32x4){0.f, 0.f, 0.f, 0.f};
        cur = nxt; cA = nA; cB = nB; ++ui;
        if constexpr (GATHER) {
#pragma unroll
            for (int h = 0; h < 2; ++h)
#pragma unroll
                for (int i = 0; i < 2; ++i) vc[h][i] = vn[h][i]; }
        if constexpr (ALIGN_EPI) { if (wr == 1) PG8_BAR; }
    }
    PG8_WAIT_V(0);
    if constexpr (!ALIGN_EPI) { if (wr == 0) PG8_BAR; }
    PG8_BAR;
#undef PG8_SA
#undef PG8_SB
#undef PG8_STAGE_A
#undef PG8_STAGE_B
#undef PG8_LDA
#undef PG8_LD8
#undef PG8_LDB
#undef PG8_MMA
#undef PG8_WAIT_V
#undef PG8_WAIT_L
#undef PG8_BAR
#undef PG8_SCHED
#undef PG8_GTAB
}
constexpr float RMS_EPS = 1e-6f;
__device__ __forceinline__ void store16_wt(void* p, const u32x4 v) { asm volatile("global_store_dwordx4 %0, %1, off sc1\n\ts_nop 1" :: "v"(p), "v"(v) : "memory"); }
typedef unsigned long long ssq_t;
constexpr float SSQ_SCALE = 1048576.0f, SSQ_INV = 1.0f / 1048576.0f;
__device__ __forceinline__ void ssq_add(ssq_t* p, float ss) { atomicAdd(p, (ssq_t)(ss * SSQ_SCALE + 0.5f)); }
__device__ __forceinline__ float ssq_get(const ssq_t* p) { return (float)(*p) * SSQ_INV; }
__device__ __forceinline__ float quad_sum(float s) { s += __shfl_xor(s, 16); s += __shfl_xor(s, 32); return s; }
__device__ __forceinline__ float dot4(const f32x4 v) { return (v[0] * v[0] + v[1] * v[1]) + (v[2] * v[2] + v[3] * v[3]); }
__device__ __forceinline__ float fast_sigmoid(float x) { return __builtin_amdgcn_rcpf(1.0f + __expf(-x)); }
__device__ __forceinline__ f32x4 sig4(const f32x4 v) { return (f32x4){fast_sigmoid(v[0]), fast_sigmoid(v[1]), fast_sigmoid(v[2]), fast_sigmoid(v[3])}; }
#define EPI_ROWS(...) _Pragma("unroll") for (int ai = 0; ai < 2; ++ai) _Pragma("unroll") for (int m = 0; m < 4; ++m) { const int rt = ai * HALF + wr * 64 + m * 16 + fr; const size_t r = (size_t)u.pm * BM + rt; (void)r; __VA_ARGS__ if (m == 3) asm volatile("" ::: "memory"); }

struct EpiInProj { static constexpr bool PERM = true;
    bf16_t *CQ, *CKV, *KR, *BG, *U, *G; ssq_t *SSQQ, *SSQKV; const float *COS, *SIN, *bgate; bool do_ssq; int pn_off; float gsc;
    __device__ __forceinline__ void operator()(const f32x4 (&acc)[2][2][4][2], const Unit& u, int wr, int wc, int fr, int fq) const {
        const int pn = u.pn + pn_off, cw = wc * 32 + 8 * fq;
        if (pn == 0) {
            EPI_ROWS( float ss = 0.f;
                _Pragma("unroll") for (int bj = 0; bj < 2; ++bj) { const f32x4 v0 = acc[ai][bj][m][0], v1 = acc[ai][bj][m][1]; ss += dot4(v0) + dot4(v1);
                    *(u32x4*)(CQ + r * 256 + bj * HALF + cw) = pack8(v0, v1); }
                ss = quad_sum(ss); if (fq == 0 && do_ssq) ssq_add(SSQQ + r, ss); )
        } else if (pn == 1) {
            EPI_ROWS( { const f32x4 v0 = acc[ai][0][m][0], v1 = acc[ai][0][m][1]; float ss = dot4(v0) + dot4(v1);
                    *(u32x4*)(CKV + r * 128 + cw) = pack8(v0, v1); ss = quad_sum(ss); if (fq == 0 && do_ssq) ssq_add(SSQKV + r, ss); }
                if (wc == 0) { const f32x4 x1 = acc[ai][1][m][0], x2 = acc[ai][1][m][1]; const f32x4 c = *(const f32x4*)(COS + r * 16 + 4 * fq), s = *(const f32x4*)(SIN + r * 16 + 4 * fq);
                    *(u32x4*)(KR + r * 32 + 8 * fq) = pack8(x1 * c - x2 * s, x1 * s + x2 * c); } )
        } else if (pn < 4) {
            EPI_ROWS( _Pragma("unroll") for (int bj = 0; bj < 2; ++bj) *(u32x4*)(BG + r * 512 + (pn - 2) * 256 + bj * HALF + cw) = pack8(acc[ai][bj][m][0], acc[ai][bj][m][1]); )
        } else if (pn < 8) {
            EPI_ROWS( *(u32x4*)(U + r * 512 + (pn - 4) * 128 + cw) = pack8(acc[ai][0][m][0] * acc[ai][1][m][0], acc[ai][0][m][1] * acc[ai][1][m][1]); )
        } else {
            f32x4 b[2][2];
#pragma unroll
            for (int bj = 0; bj < 2; ++bj)
#pragma unroll
                for (int n = 0; n < 2; ++n) b[bj][n] = *(const f32x4*)(bgate + (pn - 8) * 256 + bj * HALF + cw + 4 * n);
            EPI_ROWS( _Pragma("unroll") for (int bj = 0; bj < 2; ++bj)
                *(u32x4*)(G + r * 2048 + (pn - 8) * 256 + bj * HALF + cw) = pack8(sig4(acc[ai][bj][m][0] * gsc + b[bj][0]), sig4(acc[ai][bj][m][1] * gsc + b[bj][1])); )
        }
    }
};
struct EpiGates { static constexpr bool PERM = true;
    bf16_t* G; const float* bgate; float gsc;
    __device__ __forceinline__ void operator()(const f32x4 (&acc)[2][2][4][2], const Unit& u, int wr, int wc, int fr, int fq) const {
        const int cw = u.pn * 128 + wc * 32 + 8 * fq;
        const f32x4 b0 = *(const f32x4*)(bgate + cw), b1 = *(const f32x4*)(bgate + cw + 4);
        EPI_ROWS( *(u32x4*)(G + r * 2048 + cw) = pack8(sig4(acc[ai][0][m][0] * gsc + b0), sig4(acc[ai][0][m][1] * gsc + b1)); )
    }
};
struct EpiQUp { static constexpr bool PERM = true;
    bf16_t* Q; const ssq_t* SSQQ; const float *COS, *SIN;
    __device__ __forceinline__ void operator()(const f32x4 (&acc)[2][2][4][2], const Unit& u, int wr, int wc, int fr, int fq) const {
        const int pn = u.pn, cw = wc * 32 + 8 * fq;
        EPI_ROWS( const float rs = __builtin_amdgcn_rsqf(ssq_get(SSQQ + r) * (1.0f / 256.0f) + RMS_EPS);
            if (pn < 2) { _Pragma("unroll") for (int bj = 0; bj < 2; ++bj) *(u32x4*)(Q + r * 768 + pn * 256 + bj * HALF + cw) = pack8(acc[ai][bj][m][0] * rs, acc[ai][bj][m][1] * rs); }
            else { const f32x4 c = *(const f32x4*)(COS + r * 16 + 4 * fq), s = *(const f32x4*)(SIN + r * 16 + 4 * fq);
                _Pragma("unroll") for (int bj = 0; bj < 2; ++bj) { const f32x4 x1 = acc[ai][bj][m][0] * rs, x2 = acc[ai][bj][m][1] * rs;
                    *(u32x4*)(Q + r * 768 + 512 + (4 * bj + wc) * 32 + 8 * fq) = pack8(x1 * c - x2 * s, x1 * s + x2 * c); } } )
    }
};
struct EpiKVUp { static constexpr bool PERM = true;
    bf16_t *KN, *V; const ssq_t* SSQKV;
    __device__ __forceinline__ void operator()(const f32x4 (&acc)[2][2][4][2], const Unit& u, int wr, int wc, int fr, int fq) const {
        const int pn = u.pn, cw = wc * 32 + 8 * fq; bf16_t* O = (pn < 2) ? KN + pn * 256 : V + (pn - 2) * 256;
        EPI_ROWS( const float rs = __builtin_amdgcn_rsqf(ssq_get(SSQKV + r) * (1.0f / 128.0f) + RMS_EPS);
            _Pragma("unroll") for (int bj = 0; bj < 2; ++bj) *(u32x4*)(O + r * 512 + bj * HALF + cw) = pack8(acc[ai][bj][m][0] * rs, acc[ai][bj][m][1] * rs); )
    }
};
template <bool SECOND> struct EpiMix { static constexpr bool PERM = true;
    bf16_t* MIX; const bf16_t* G;
    __device__ __forceinline__ void operator()(const f32x4 (&acc)[2][2][4][2], const Unit& u, int wr, int wc, int fr, int fq) const {
        const int cw = u.pn * 256 + wc * 32 + 8 * fq;
        EPI_ROWS( _Pragma("unroll") for (int bj = 0; bj < 2; ++bj) { f32x4 g0, g1; unpack8(*(const u32x4*)(G + r * 2048 + (SECOND ? 1024 : 0) + bj * HALF + cw), g0, g1);
                f32x4 o0 = g0 * acc[ai][bj][m][0], o1 = g1 * acc[ai][bj][m][1];
                if (SECOND) { f32x4 p0, p1; unpack8(*(const u32x4*)(MIX + r * 1024 + bj * HALF + cw), p0, p1); o0 += p0; o1 += p1; }
                *(u32x4*)(MIX + r * 1024 + bj * HALF + cw) = pack8(o0, o1); } )
    }
};
template <typename TR> struct EpiResid { static constexpr bool PERM = false;
    const TR* RES; bf16_t* OB; ssq_t* SSQ; bool do_ssq;
    __device__ __forceinline__ void operator()(const f32x4 (&acc)[2][2][4][2], const Unit& u, int wr, int wc, int fr, int fq) const {
        const int c0 = u.pn * 256 + wc * 32 + 4 * fq;
        EPI_ROWS( float ss = 0.f;
            _Pragma("unroll") for (int bj = 0; bj < 2; ++bj) _Pragma("unroll") for (int n = 0; n < 2; ++n) { const size_t o = r * 1024 + c0 + bj * HALF + n * 16;
                f32x4 x;
                if constexpr (sizeof(TR) == 4) x = *(const f32x4*)(RES + o); else { const u32x2 w = *(const u32x2*)(RES + o); x = (f32x4){bf_lo(w.x), bf_hi(w.x), bf_lo(w.y), bf_hi(w.y)}; }
                x += acc[ai][bj][m][n]; ss += dot4(x);
                u32x2 w2; w2.x = cvt_pk_bf16(x[0], x[1]); w2.y = cvt_pk_bf16(x[2], x[3]); *(u32x2*)(OB + o) = w2; }
            ss = quad_sum(ss); if (fq == 0 && do_ssq) ssq_add(SSQ + r, ss); )
    }
};
struct EpiScaleRows { static constexpr bool PERM = true;
    bf16_t* O; int ldo; const ssq_t* SSQ;
    __device__ __forceinline__ void operator()(const f32x4 (&acc)[2][2][4][2], const Unit& u, int wr, int wc, int fr, int fq) const {
        const int cw = u.pn * 256 + wc * 32 + 8 * fq;
        EPI_ROWS( const float rs = __builtin_amdgcn_rsqf(ssq_get(SSQ + r) * (1.0f / 1024.0f) + RMS_EPS);
            _Pragma("unroll") for (int bj = 0; bj < 2; ++bj) *(u32x4*)(O + r * ldo + bj * HALF + cw) = pack8(acc[ai][bj][m][0] * rs, acc[ai][bj][m][1] * rs); )
    }
};
struct EpiKVM { static constexpr bool PERM = true;
    bf16_t *KM, *VM;
    __device__ __forceinline__ void operator()(const f32x4 (&acc)[2][2][4][2], const Unit& u, int wr, int wc, int fr, int fq) const {
        const int pn = u.pn, cw = wc * 32 + 8 * fq; bf16_t* O = (pn < 2) ? KM + pn * 256 : VM + (pn - 2) * 256;
        EPI_ROWS( _Pragma("unroll") for (int bj = 0; bj < 2; ++bj) *(u32x4*)(O + r * 512 + bj * HALF + cw) = pack8(acc[ai][bj][m][0], acc[ai][bj][m][1]); )
    }
};
struct EpiRouter { static constexpr bool PERM = false;
    float* LOG;
    __device__ __forceinline__ void operator()(const f32x4 (&acc)[2][2][4][2], const Unit& u, int wr, int wc, int fr, int fq) const {
        const int c0 = wc * 32 + 4 * fq;
        EPI_ROWS( _Pragma("unroll") for (int n = 0; n < 2; ++n) *(f32x4*)(LOG + r * 128 + c0 + n * 16) = acc[ai][0][m][n]; )
    }
};
struct EpiGateUp { static constexpr bool PERM = true;
    bf16_t* HH; const float* RSP;
    __device__ __forceinline__ void operator()(const f32x4 (&acc)[2][2][4][2], const Unit& u, int wr, int wc, int fr, int fq) const {
        const int cw = (u.pn & 1) * 128 + wc * 32 + 8 * fq;
        EPI_ROWS( const float rs = RSP[r];
            f32x4 h[2];
            _Pragma("unroll") for (int n = 0; n < 2; ++n) { const f32x4 g = acc[ai][0][m][n] * rs, up = acc[ai][1][m][n] * rs; h[n] = g * sig4(g) * up; }
            store16_wt(HH + r * 256 + cw, pack8(h[0], h[1])); )
    }
};
struct EpiDown { static constexpr bool PERM = true;
    bf16_t* YD;
    __device__ __forceinline__ void operator()(const f32x4 (&acc)[2][2][4][2], const Unit& u, int wr, int wc, int fr, int fq) const {
        const int cw = (u.pn & 3) * 256 + wc * 32 + 8 * fq;
        EPI_ROWS( _Pragma("unroll") for (int bj = 0; bj < 2; ++bj) *(u32x4*)(YD + r * 1024 + bj * HALF + cw) = pack8(acc[ai][bj][m][0], acc[ai][bj][m][1]); )
    }
};
#undef EPI_ROWS
}
namespace att {
typedef unsigned short bf16;
using bf16x8 = __attribute__((ext_vector_type(8))) short;
using s16x4  = __attribute__((ext_vector_type(4))) short;
using f32x16 = __attribute__((ext_vector_type(16))) float;
using u32x4  = __attribute__((ext_vector_type(4))) unsigned;
constexpr int NW = 8, QBLK = 32, KVBLK = 64;
constexpr float THR = 8.f;
#define SBAR() __builtin_amdgcn_sched_barrier(0)
__device__ __forceinline__ int crow(int r, int hi) { return (r & 3) + 8 * (r >> 2) + 4 * hi; }
__device__ __forceinline__ unsigned cvtpk(float lo, float hi) { return pg8::cvt_pk_bf16(lo, hi); }

struct MlaCfg { static constexpr int DQ = 96, D1 = 64, DV = 64, LDQ = 768, LDK1 = 512, LDK2 = 32, LDV = 512, LDO = 512, KP = 208; static constexpr bool CAUSAL = true;
                static constexpr float SCALE = 0.10206207261596575f; };
struct XatCfg { static constexpr int DQ = 128, D1 = 128, DV = 128, LDQ = 512, LDK1 = 512, LDK2 = 0, LDV = 512, LDO = 512, KP = 256; static constexpr bool CAUSAL = false;
                static constexpr float SCALE = 0.08838834764831845f; };
template <class C> constexpr int lds_bytes() { return 2 * 64 * C::DV * 2 + 2 * 64 * C::KP + NW * 64 * 4; }

template <class C> __device__ __forceinline__ int kaddr(int row, int colB) { if constexpr (C::DQ == 128) return row * 256 + (colB ^ ((row & 7) << 4)); else return row * C::KP + colB; }

template <class C> __device__ __forceinline__ void partialSM(f32x16& p0, f32x16& p1, float& m_reg, float& mn, float& alpha) {
  constexpr float Cc = C::SCALE * 1.4426950408889634f;
  float pmax = p0[0];
#pragma unroll
  for (int r = 1; r < 16; ++r) pmax = fmaxf(pmax, p0[r]);
#pragma unroll
  for (int r = 0; r < 16; ++r) pmax = fmaxf(pmax, p1[r]);
  { auto rr = __builtin_amdgcn_permlane32_swap(__float_as_uint(pmax), __float_as_uint(pmax), false, false);
    pmax = fmaxf(__uint_as_float(rr[0]), __uint_as_float(rr[1])); }
  if (__builtin_expect(__all(pmax - m_reg <= THR / C::SCALE), 1)) { mn = m_reg; alpha = 1.f; }
  else { mn = fmaxf(m_reg, pmax); alpha = __builtin_amdgcn_exp2f((m_reg - mn) * Cc); m_reg = mn; }
  const float mnC = -mn * Cc;
#pragma unroll
  for (int r = 0; r < 16; ++r) p0[r] = fmaf(p0[r], Cc, mnC);
#pragma unroll
  for (int r = 0; r < 16; ++r) p1[r] = fmaf(p1[r], Cc, mnC);
#pragma unroll
  for (int r = 0; r < 16; ++r) p0[r] = __builtin_amdgcn_exp2f(p0[r]);
}
__device__ __forceinline__ void finishSM(f32x16& p0, f32x16& p1, float alpha, float& l_reg, bf16x8& pa0, bf16x8& pa1, bf16x8& pa2, bf16x8& pa3) {
#pragma unroll
  for (int r = 0; r < 16; ++r) p1[r] = __builtin_amdgcn_exp2f(p1[r]);
  float ps = 0;
#pragma unroll
  for (int r = 0; r < 16; ++r) ps += p0[r];
#pragma unroll
  for (int r = 0; r < 16; ++r) ps += p1[r];
  { auto rr = __builtin_amdgcn_permlane32_swap(__float_as_uint(ps), __float_as_uint(ps), false, false);
    ps = __uint_as_float(rr[0]) + __uint_as_float(rr[1]); }
  l_reg = l_reg * alpha + ps;
#define PK4(P, BASE, OUT) do { unsigned a0 = cvtpk(P[BASE + 0], P[BASE + 1]), a1 = cvtpk(P[BASE + 2], P[BASE + 3]);   \
    unsigned b0 = cvtpk(P[BASE + 4], P[BASE + 5]), b1 = cvtpk(P[BASE + 6], P[BASE + 7]);                              \
    auto r0 = __builtin_amdgcn_permlane32_swap(a0, b0, false, false); auto r1 = __builtin_amdgcn_permlane32_swap(a1, b1, false, false); \
    u32x4 w = {r0[0], r1[0], r0[1], r1[1]}; OUT = *reinterpret_cast<bf16x8*>(&w); } while (0)
  PK4(p0, 0, pa0); PK4(p0, 8, pa1); PK4(p1, 0, pa2); PK4(p1, 8, pa3);
#undef PK4
}
template <class C> __device__ __forceinline__ void qkt(f32x16& p0, f32x16& p1, const char* Ks, const bf16x8* qr, int r32, int hi) {
  p0 = f32x16{}; p1 = f32x16{};
#pragma unroll
  for (int d0 = 0; d0 < C::DQ / 16; ++d0) { const int cb = (d0 * 16 + hi * 8) * 2;
    const bf16x8 b0 = *reinterpret_cast<const bf16x8*>(Ks + kaddr<C>(r32, cb));
    const bf16x8 b1 = *reinterpret_cast<const bf16x8*>(Ks + kaddr<C>(32 + r32, cb));
    p0 = __builtin_amdgcn_mfma_f32_32x32x16_bf16(b0, qr[d0], p0, 0, 0, 0);
    p1 = __builtin_amdgcn_mfma_f32_32x32x16_bf16(b1, qr[d0], p1, 0, 0, 0); }
}
template <int NCB> __device__ __forceinline__ int v_st(int k, int c) { const int kk = (k & ~0xC) | ((k & 4) << 1) | ((k & 8) >> 1); return ((kk >> 3) * NCB + (c >> 5)) * 512 + ((kk & 7) * 32 + (c & 31)) * 2; }
__device__ __forceinline__ int v_rd_base(int lane) { return ((lane & 3) << 3) | (((lane >> 2) & 3) << 6) | (((lane >> 4) & 1) << 5) | (((lane >> 5) & 1) << 8); }
template <int NCB> constexpr int v_rd_off(int d0, int ks, int half) { return d0 * 512 + ks * (2 * NCB * 512) + half * (NCB * 512); }
template <int OFF> __device__ __forceinline__ s16x4 tr_read(int vb) {
  s16x4 r; asm volatile("ds_read_b64_tr_b16 %0, %1 offset:%2" : "=&v"(r) : "v"(vb), "i"(OFF) : "memory"); return r;
}
template <int NCB, int D0> __device__ __forceinline__ void pv_one(f32x16& od, int vb, bf16x8 pa0, bf16x8 pa1, bf16x8 pa2, bf16x8 pa3) {
  const s16x4 l0 = tr_read<v_rd_off<NCB>(D0, 0, 0)>(vb), h0 = tr_read<v_rd_off<NCB>(D0, 0, 1)>(vb), l1 = tr_read<v_rd_off<NCB>(D0, 1, 0)>(vb), h1 = tr_read<v_rd_off<NCB>(D0, 1, 1)>(vb);
  const s16x4 l2 = tr_read<v_rd_off<NCB>(D0, 2, 0)>(vb), h2 = tr_read<v_rd_off<NCB>(D0, 2, 1)>(vb), l3 = tr_read<v_rd_off<NCB>(D0, 3, 0)>(vb), h3 = tr_read<v_rd_off<NCB>(D0, 3, 1)>(vb);
  asm volatile("s_waitcnt lgkmcnt(0)" ::: "memory"); SBAR();
#define PK(L, H) (bf16x8){L[0], L[1], L[2], L[3], H[0], H[1], H[2], H[3]}
  od = __builtin_amdgcn_mfma_f32_32x32x16_bf16(pa0, PK(l0, h0), od, 0, 0, 0);
  od = __builtin_amdgcn_mfma_f32_32x32x16_bf16(pa1, PK(l1, h1), od, 0, 0, 0);
  od = __builtin_amdgcn_mfma_f32_32x32x16_bf16(pa2, PK(l2, h2), od, 0, 0, 0);
  od = __builtin_amdgcn_mfma_f32_32x32x16_bf16(pa3, PK(l3, h3), od, 0, 0, 0);
#undef PK
}
template <int NCB> __device__ __forceinline__ void pv_all(f32x16* o, int vb, bf16x8 pa0, bf16x8 pa1, bf16x8 pa2, bf16x8 pa3) {
  pv_one<NCB, 0>(o[0], vb, pa0, pa1, pa2, pa3); pv_one<NCB, 1>(o[1], vb, pa0, pa1, pa2, pa3);
  if constexpr (NCB == 4) { pv_one<NCB, 2>(o[2], vb, pa0, pa1, pa2, pa3); pv_one<NCB, 3>(o[3], vb, pa0, pa1, pa2, pa3); }
}
__device__ __forceinline__ void cmask(f32x16& p0, f32x16& p1, int kbase, int qpos, int hi) {
#pragma unroll
  for (int r = 0; r < 16; ++r) { const int kv = kbase + crow(r, hi); if (kv > qpos) p0[r] = -INFINITY; if (kv + 32 > qpos) p1[r] = -INFINITY; }
}
template <class C>
__device__ __forceinline__ void attn_unit(const bf16* __restrict__ Q1, const bf16* __restrict__ Q2, const bf16* __restrict__ K1, const bf16* __restrict__ K2,
                                          const bf16* __restrict__ Vp, bf16* __restrict__ Op, int qrow0, int NT, char* lds) {
  constexpr int DQ = C::DQ, DV = C::DV, NQF = DQ / 16, NCB = DV / 32, NKC = DQ / 8;
  constexpr int SHM_V = 64 * DV * 2, SHM_K = 64 * C::KP;
  const int tid = threadIdx.x, wid = tid >> 6, lane = tid & 63, r32 = lane & 31, hi = lane >> 5;
  char* V_lds = lds; char* K_lds = lds + 2 * SHM_V;
  float* ws = (float*)(lds + 2 * SHM_V + 2 * SHM_K) + wid * 64; float* li_l = ws; float* al_l = ws + 32;
  float m_reg = -1e30f, l_reg = 0; f32x16 o[NCB]; bf16x8 qr[NQF];
#pragma unroll
  for (int d = 0; d < NCB; ++d) o[d] = f32x16{};
  __syncthreads();
  { const long qrow = wid * QBLK + r32;
#pragma unroll
    for (int d0 = 0; d0 < NQF; ++d0) { const int d = d0 * 16 + hi * 8;
      qr[d0] = (d0 * 16 < C::D1) ? *reinterpret_cast<const bf16x8*>(Q1 + qrow * C::LDQ + d) : *reinterpret_cast<const bf16x8*>(Q2 + qrow * C::LDQ + (d - C::D1)); } }
  const bool kact = tid < 32 * NKC; const int ksr = tid / NKC, kcc = tid % NKC;
  const bf16* kbase = (kcc * 8 < C::D1) ? K1 + kcc * 8 : K2 + (kcc * 8 - C::D1); const int kld = (kcc * 8 < C::D1) ? C::LDK1 : C::LDK2;
  const int kst0 = kaddr<C>(ksr, kcc * 16), kst1 = kaddr<C>(32 + ksr, kcc * 16);
  const int vsr = (DV == 128) ? (tid >> 4) : (tid >> 3), vsc = (DV == 128) ? (tid & 15) * 8 : (tid & 7) * 8;
  const int vst0 = v_st<NCB>(vsr, vsc), vst1 = v_st<NCB>(32 + vsr, vsc);
  const int vb0 = (int)(uintptr_t)V_lds + v_rd_base(lane);
  struct { bf16x8 vs0, vs1, ks0, ks1; } sr_[2];
#define SLOAD(i, k0) do { sr_[i].vs0 = *reinterpret_cast<const bf16x8*>(&Vp[(long)((k0) + vsr) * C::LDV + vsc]); \
    if constexpr (DV == 128) sr_[i].vs1 = *reinterpret_cast<const bf16x8*>(&Vp[(long)((k0) + 32 + vsr) * C::LDV + vsc]); \
    if (kact) { sr_[i].ks0 = *reinterpret_cast<const bf16x8*>(&kbase[(long)((k0) + ksr) * kld]); sr_[i].ks1 = *reinterpret_cast<const bf16x8*>(&kbase[(long)((k0) + 32 + ksr) * kld]); } } while (0)
#define SWRITE(b, i) do { *(bf16x8*)(V_lds + (b) * SHM_V + vst0) = sr_[i].vs0; if constexpr (DV == 128) *(bf16x8*)(V_lds + (b) * SHM_V + vst1) = sr_[i].vs1; \
    if (kact) { *(bf16x8*)(K_lds + (b) * SHM_K + kst0) = sr_[i].ks0; *(bf16x8*)(K_lds + (b) * SHM_K + kst1) = sr_[i].ks1; } } while (0)
#define SWAIT() do { if constexpr (DV == 128) asm volatile("s_waitcnt vmcnt(4)" ::: "memory"); else asm volatile("s_waitcnt vmcnt(3)" ::: "memory"); } while (0)
#define RESC(a) do { if (__any((a) < 1.f)) { if (hi == 0) al_l[r32] = (a); asm volatile("s_waitcnt lgkmcnt(0)" ::: "memory"); \
    _Pragma("unroll") for (int d = 0; d < NCB; ++d) _Pragma("unroll") for (int r = 0; r < 16; ++r) o[d][r] *= al_l[crow(r, hi)]; } } while (0)
#define CMASK(P0, P1, t) do { if constexpr (C::CAUSAL) { if ((t) >= NT - 4) cmask(P0, P1, (t) * KVBLK, qrow0 + wid * QBLK + r32, hi); } } while (0)
  f32x16 pA0, pA1, pB0, pB1; float mnA, mnB, alA, alB; bf16x8 pa0, pa1, pa2, pa3;
  constexpr int SE = 0, SO = 1;
  SLOAD(SE, 0); asm volatile("s_waitcnt vmcnt(0)" ::: "memory"); SWRITE(0, SE); __syncthreads();
  qkt<C>(pA0, pA1, K_lds, qr, r32, hi); CMASK(pA0, pA1, 0); partialSM<C>(pA0, pA1, m_reg, mnA, alA);
  SLOAD(SO, KVBLK); if (2 < NT) SLOAD(SE, 2 * KVBLK);
  SWAIT(); SWRITE(1, SO); __syncthreads();
  for (int j = 1; j + 1 < NT; j += 2) {
    SBAR(); qkt<C>(pB0, pB1, K_lds + SHM_K, qr, r32, hi);
    finishSM(pA0, pA1, alA, l_reg, pa0, pa1, pa2, pa3); SBAR();
    SLOAD(SO, (j + 2) * KVBLK); SBAR();
    pv_all<NCB>(o, vb0, pa0, pa1, pa2, pa3); CMASK(pB0, pB1, j); partialSM<C>(pB0, pB1, m_reg, mnB, alB);
    __syncthreads(); SWAIT(); SWRITE(0, SE);
    RESC(alB); __syncthreads();
    SBAR(); qkt<C>(pA0, pA1, K_lds, qr, r32, hi);
    finishSM(pB0, pB1, alB, l_reg, pa0, pa1, pa2, pa3); SBAR();
    if (j + 3 < NT) SLOAD(SE, (j + 3) * KVBLK); SBAR();
    pv_all<NCB>(o, vb0 + SHM_V, pa0, pa1, pa2, pa3); CMASK(pA0, pA1, j + 1); partialSM<C>(pA0, pA1, m_reg, mnA, alA);
    __syncthreads(); SWAIT(); SWRITE(1, SO);
    RESC(alA); __syncthreads();
  }
  SBAR(); qkt<C>(pB0, pB1, K_lds + SHM_K, qr, r32, hi);
  finishSM(pA0, pA1, alA, l_reg, pa0, pa1, pa2, pa3); SBAR();
  pv_all<NCB>(o, vb0, pa0, pa1, pa2, pa3); CMASK(pB0, pB1, NT - 1); partialSM<C>(pB0, pB1, m_reg, mnB, alB);
  __syncthreads(); RESC(alB);
  finishSM(pB0, pB1, alB, l_reg, pa0, pa1, pa2, pa3); SBAR();
  pv_all<NCB>(o, vb0 + SHM_V, pa0, pa1, pa2, pa3);
  if (hi == 0) li_l[r32] = l_reg; asm volatile("s_waitcnt lgkmcnt(0)" ::: "memory");
  float rli[16];
#pragma unroll
  for (int r = 0; r < 16; ++r) rli[r] = __builtin_amdgcn_rcpf(li_l[crow(r, hi)]);
  bf16* Ow = Op + (long)(wid * QBLK) * C::LDO;
#pragma unroll
  for (int r = 0; r < 16; ++r) { const int orow = crow(r, hi);
#pragma unroll
    for (int d0 = 0; d0 < NCB; ++d0) Ow[(long)orow * C::LDO + d0 * 32 + r32] = (bf16)(cvtpk(o[d0][r] * rli[r], 0.f) & 0xffffu); }
#undef SLOAD
#undef SWRITE
#undef SWAIT
#undef RESC
#undef CMASK
}
#undef SBAR
}
#define GAS __attribute__((address_space(1)))
#define LAS __attribute__((address_space(3)))
typedef unsigned short bf16;
typedef unsigned v4u __attribute__((ext_vector_type(4)));
typedef float f32x4 __attribute__((ext_vector_type(4)));
typedef short bf16x8 __attribute__((ext_vector_type(8)));
typedef GAS unsigned gu32;
typedef GAS unsigned long long gu64;
#define RLX_AGENT __ATOMIC_RELAXED, __HIP_MEMORY_SCOPE_AGENT
#define LDS_WAIT() asm volatile("s_waitcnt lgkmcnt(0)" ::: "memory")
#define VM_WAIT() asm volatile("s_waitcnt vmcnt(0)" ::: "memory")
__device__ __forceinline__ unsigned long long rt() { return __builtin_amdgcn_s_memrealtime(); }
__device__ __forceinline__ unsigned f2bf(float f) { unsigned u = __builtin_bit_cast(unsigned, f); return (u + 0x7fffu + ((u >> 16) & 1u)) >> 16; }
__device__ __forceinline__ unsigned pk2(float lo, float hi) { return f2bf(lo) | (f2bf(hi) << 16); }

#define XB_TMO      128
#define XB_XCNT(j)  (256  + 64 * (j))
#define XB_XSUB(j)  (1280 + 64 * (j))
#define XB_XGEN(j)  (2304 + 64 * (j))
#define XB_TOP      3328
#define XB_TOPGEN   3392
#define XCD_BAR_WORDS 3456
#define XB_SPIN_CAP (1u << 18)

__device__ __forceinline__ unsigned xb_ld(unsigned* p)              { return __hip_atomic_load(p, __ATOMIC_RELAXED, __HIP_MEMORY_SCOPE_AGENT); }
__device__ __forceinline__ unsigned xb_add(unsigned* p, unsigned v) { return __hip_atomic_fetch_add(p, v, __ATOMIC_RELAXED, __HIP_MEMORY_SCOPE_AGENT); }
__device__ __forceinline__ unsigned xb_xcc_id() { return (unsigned)__builtin_amdgcn_s_getreg((3 << 11) | 20) & 0xFu; }
#define XB_SPIN(cond, bar) do { unsigned _sp = 0; while (cond) { __builtin_amdgcn_s_sleep(1); \
    if ((++_sp & 255u) == 0u) { if (xb_ld(&(bar)[XB_TMO])) break; if (_sp > XB_SPIN_CAP) { atomicAdd(&(bar)[XB_TMO], 1u); break; } } } } while (0)

struct XcdBarrier {
    unsigned* bar; unsigned x;
    volatile LAS unsigned* st;
};

__device__ __forceinline__ XcdBarrier xcd_barrier_post(unsigned* bar, volatile LAS unsigned* st) {
    XcdBarrier b; b.bar = bar; b.x = xb_xcc_id(); b.st = st;
    if (threadIdx.x == 0) (void)xb_add(&bar[XB_XCNT(b.x)], 1u);
    return b;
}
__device__ __forceinline__ void xcd_barrier_complete(unsigned* bar, unsigned x, unsigned& nloc, unsigned& nx) {
    const unsigned G = gridDim.x * gridDim.y * gridDim.z;
    unsigned sum, cnt, mine, sp = 0u;
    for (;;) {
        sum = 0u; cnt = 0u; mine = 0u;
#pragma unroll
        for (unsigned j = 0; j < 16; ++j) { const unsigned c = xb_ld(&bar[XB_XCNT(j)]); sum += c; cnt += (c > 0u) ? 1u : 0u; mine = (j == x) ? c : mine; }
        if (sum == G) break;
        __builtin_amdgcn_s_sleep(1);
        if ((++sp & 255u) == 0u) { if (xb_ld(&bar[XB_TMO])) break; if (sp > XB_SPIN_CAP) { atomicAdd(&bar[XB_TMO], 1u); break; } }
    }
    nloc = mine > 0u ? mine : 1u; nx = cnt > 0u ? cnt : 1u;
}

__device__ __forceinline__ void xcd_barrier(const XcdBarrier& b) {
    asm volatile("s_waitcnt vmcnt(0)" ::: "memory");
    __syncthreads();
    if (threadIdx.x == 0) {
        unsigned* bar = b.bar;
        __builtin_amdgcn_s_waitcnt(0);
        unsigned nloc = b.st[0], nx = b.st[1];
        if (nloc == 0u) { xcd_barrier_complete(bar, b.x, nloc, nx); b.st[0] = nloc; b.st[1] = nx; }
        const unsigned old = xb_add(&bar[XB_XSUB(b.x)], 1u);
        const unsigned gen = old / nloc;
        if (old + 1u == (gen + 1u) * nloc) {
            __builtin_amdgcn_fence(__ATOMIC_RELEASE, "agent");
            asm volatile("s_waitcnt vmcnt(0)" ::: "memory");
            const unsigned og = xb_add(&bar[XB_TOP], 1u);
            const unsigned tg = og / nx;
            if (og + 1u == (tg + 1u) * nx) xb_add(&bar[XB_TOPGEN], 1u);
            else XB_SPIN(xb_ld(&bar[XB_TOPGEN]) == tg, bar);
            __builtin_amdgcn_fence(__ATOMIC_ACQUIRE, "agent");
            xb_add(&bar[XB_XGEN(b.x)], 1u);
            asm volatile("s_waitcnt vmcnt(0)" ::: "memory");
        } else {
            XB_SPIN(xb_ld(&bar[XB_XGEN(b.x)]) == gen, bar);
            __builtin_amdgcn_fence(__ATOMIC_ACQUIRE, "agent");
            asm volatile("s_waitcnt vmcnt(0)" ::: "memory");
        }
    }
    __syncthreads();
}
constexpr int NWAVES = 8;
constexpr int D = 1024, BATCH = 8, SEQ = 2048, M = BATCH * SEQ, MEM = 256, MM = BATCH * MEM;
constexpr int NH = 8, DN = 64, DR = 32, DV = 64, QL = 256, KVL = 128, DQK = DN + DR;
constexpr int CW = 512, XH = 4, XD = 128, NG = 8, EPG = 8, NE = 64, FF = 256;
constexpr int COL_CQ = 256, COL_CKV = 384, COL_KR = 416, COL_CONV = 1952, IN_COLS = 4000, INP = 4096;
constexpr int PMAX = 2 * M + NE * 256, NTILE_MAX = PMAX / 256;
constexpr float EPS = 1e-6f;
constexpr int RCAP = M;

constexpr size_t MiB = 1u << 20;
constexpr size_t WS_CTL = 0, CTL_ZERO_BYTES = 1 * MiB;
constexpr size_t WS_COS = 1 * MiB, WS_SIN = 2 * MiB, WS_RIDX = 3 * MiB, WS_SLOT = WS_RIDX + 256 * 1024, WS_EID = WS_RIDX + 512 * 1024, WS_EW = WS_RIDX + 768 * 1024;
constexpr size_t WS_WIN = 4 * MiB, WS_WUQ = 12 * MiB, WS_WUKV = 12 * MiB + 512 * 1024, WS_WA = 13 * MiB, WS_WB = 14 * MiB, WS_WOUT = 15 * MiB, WS_WQM = 17 * MiB, WS_WKVM = 18 * MiB,
                 WS_WOM = 20 * MiB, WS_WR = 21 * MiB, WS_WGU = 22 * MiB, WS_WDN = 86 * MiB;
constexpr size_t WS_XN = 118 * MiB, WS_MIX = 118 * MiB, WS_G = 150 * MiB, WS_CQ = 214 * MiB, WS_CKV = 222 * MiB, WS_KR = 226 * MiB, WS_BG = 227 * MiB, WS_U = 243 * MiB,
                 WS_Q = 259 * MiB, WS_KN = 283 * MiB, WS_V = 299 * MiB, WS_ATT = 315 * MiB, WS_CONV = 331 * MiB, WS_X1B = 347 * MiB, WS_QM = 379 * MiB, WS_MEMN = 395 * MiB,
                 WS_KM = 399 * MiB, WS_VM = 401 * MiB, WS_OM = 403 * MiB, WS_X2B = 214 * MiB, WS_LOG = 246 * MiB, WS_HH = 259 * MiB, WS_YD = 118 * MiB, WS_RIDX2 = 420 * MiB, WS_XN8 = 424 * MiB, WS_WIN8 = 440 * MiB, WS_X1 = 448 * MiB, WS_END = 512 * MiB;
constexpr int CW_BAR = 4096, CW_SSQQ = 16384, CW_SSQKV = 49152, CW_SSQ1 = 81920, CW_SSQ2 = 114688, CW_INPROJ = 147648, CW_GRP = 147712, CW_TREADY = 151808, CW_COUNTS = 164096;
static_assert((CW_COUNTS + 64 * NE) * 4 <= (int)CTL_ZERO_BYTES && CW_TREADY + 64 * NTILE_MAX <= CW_COUNTS, "CTL words inside the memset region");
constexpr int RING_OFF = 0, RING_BYTES = 131072;
constexpr int LDSCTL_OFF = RING_BYTES, MISC_OFF = LDSCTL_OFF + 320, TEXP_OFF = RING_BYTES + 1024, GTAB_OFF = RING_BYTES + 2048, OFFS_OFF = GTAB_OFF + 4096, TORD_OFF = OFFS_OFF + 1024;
constexpr int LDS_BYTES = 147456;
static_assert(TORD_OFF + 1024 <= LDS_BYTES, "LDS map");

struct Args { const float* in[27]; float* out; unsigned char* ws; int ph_lo, ph_hi, sub, pad; };
constexpr int NPHASE = 15;
#ifndef GROUPBAR
#define GROUPBAR 1
#endif
#ifndef MOEALIGN
#define MOEALIGN true
#endif
#ifndef SUALIGN
#define SUALIGN true
#endif
#ifndef P1ALIGN
#define P1ALIGN false
#endif
#ifndef INROT
#define INROT 0
#endif

__device__ __forceinline__ float wave_sum(float v) {
#pragma unroll
    for (int o = 1; o < 64; o <<= 1) v += __shfl_xor(v, o);
    return v;
}
__device__ __forceinline__ int rope_pos(int j) { const int x = j & 15, second = j >> 4; return 8 * (x >> 2) + 4 * second + (x & 3); }
struct MapId  { __device__ __forceinline__ int operator()(int n) const { return n; } };
struct MapWin { __device__ __forceinline__ int operator()(int n) const {
    if (n < COL_CKV) return n;
    if (n < COL_KR) return 384 + rope_pos(n - COL_CKV);
    if (n < COL_KR + CW) return 512 + (n - COL_KR);
    if (n < COL_KR + 2 * CW) { const int c = n - COL_KR - CW; return 1024 + (c >> 7) * 256 + (c & 127); }
    if (n < COL_CONV) { const int c = n - COL_KR - 2 * CW; return 1024 + (c >> 7) * 256 + 128 + (c & 127); }
    return 2048 + (n - COL_CONV); } };
struct MapUq  { __device__ __forceinline__ int operator()(int n) const { const int h = n / DQK, d = n % DQK; return d < DN ? h * DN + d : 512 + h * DR + rope_pos(d - DN); } };
struct MapUkv { __device__ __forceinline__ int operator()(int n) const { const int h = n >> 7, d = n & 127; return d < 64 ? h * 64 + d : 512 + h * 64 + (d - 64); } };
struct MapGu  { __device__ __forceinline__ int operator()(int n) const { const int c = n & 255; return (c >> 7) * 256 + (n >> 8) * 128 + (c & 127); } };
struct TItem { const float* W; bf16* WT; const float* gain; int K, N, k0, n0, map; };
__device__ __forceinline__ void titem_load(const TItem& t, f32x4 (&v)[8], int lane) {
    const int sub = lane >> 3, c4 = (lane & 7) * 4;
#pragma unroll
    for (int j = 0; j < 8; ++j) v[j] = __builtin_nontemporal_load((const GAS f32x4*)(t.W + (size_t)(t.k0 + 8 * j + sub) * t.N + t.n0 + c4));
}
__device__ __forceinline__ int titem_row(int map, int n) {
    switch (map) { case 1: return MapWin()(n); case 2: return MapUq()(n); case 3: return MapUkv()(n); case 4: return MapGu()(n); default: return n; }
}
__device__ __forceinline__ void titem_finish(const TItem& t, const f32x4 (&v)[8], LAS float* scr, int lane) {
    const int sub = lane >> 3, c4 = (lane & 7) * 4;
#pragma unroll
    for (int j = 0; j < 8; ++j) { const int kk = 8 * j + sub; const float g = t.gain ? t.gain[t.k0 + kk] : 1.0f; LAS float* s = scr + kk * 33 + c4;
        s[0] = v[j].x * g; s[1] = v[j].y * g; s[2] = v[j].z * g; s[3] = v[j].w * g; }
    LDS_WAIT(); asm volatile("" ::: "memory");
    const int c = lane & 7;
#pragma unroll
    for (int j = 0; j < 4; ++j) { const int n = (lane >> 3) + 8 * j; const LAS float* s = scr + (8 * c) * 33 + n;
        if (t.map == 5) { unsigned w0 = 0, w1 = 0;
            w0 = __builtin_amdgcn_cvt_pk_fp8_f32(s[0 * 33] * 32.f, s[1 * 33] * 32.f, w0, false); w0 = __builtin_amdgcn_cvt_pk_fp8_f32(s[2 * 33] * 32.f, s[3 * 33] * 32.f, w0, true);
            w1 = __builtin_amdgcn_cvt_pk_fp8_f32(s[4 * 33] * 32.f, s[5 * 33] * 32.f, w1, false); w1 = __builtin_amdgcn_cvt_pk_fp8_f32(s[6 * 33] * 32.f, s[7 * 33] * 32.f, w1, true);
            *(GAS unsigned long long*)((GAS unsigned char*)t.WT + (size_t)(t.n0 + n - COL_CONV) * t.K + t.k0 + 8 * c) = (unsigned long long)w0 | ((unsigned long long)w1 << 32); continue; }
        v4u o; o.x = pk2(s[0 * 33], s[1 * 33]); o.y = pk2(s[2 * 33], s[3 * 33]); o.z = pk2(s[4 * 33], s[5 * 33]); o.w = pk2(s[6 * 33], s[7 * 33]);
        GAS v4u* dst = (GAS v4u*)(t.WT + (size_t)titem_row(t.map, t.n0 + n) * t.K + t.k0 + 8 * c);
        if (t.map == 4 || t.map == 6) __builtin_nontemporal_store(o, dst); else *dst = o; }
    LDS_WAIT(); asm volatile("" ::: "memory");
}
__device__ __forceinline__ void rms_row_to_bf16(const float* xrow, const float* g, bf16* orow, int lane) {
    const GAS f32x4* xr = (const GAS f32x4*)xrow + lane; const GAS f32x4* gr = (const GAS f32x4*)g + lane;
    f32x4 v[4]; float s = 0.f;
#pragma unroll
    for (int j = 0; j < 4; ++j) { v[j] = xr[64 * j]; s += (v[j].x * v[j].x + v[j].y * v[j].y) + (v[j].z * v[j].z + v[j].w * v[j].w); }
    const float rstd = 1.f / sqrtf(wave_sum(s) * (1.f / D) + EPS);
    GAS unsigned long long* o8 = (GAS unsigned long long*)orow + lane;
#pragma unroll
    for (int j = 0; j < 4; ++j) { const f32x4 gg = gr[64 * j]; o8[64 * j] = (unsigned long long)pk2(v[j].x * rstd * gg.x, v[j].y * rstd * gg.y) | ((unsigned long long)pk2(v[j].z * rstd * gg.z, v[j].w * rstd * gg.w) << 32); }
}

template <class MK>
__device__ __forceinline__ void run_titems(const MK& mk, int it_lo, int it_hi, int wv, int nwv, LAS float* scr, int lane) {
    f32x4 va[8], vb[8], vc[8]; TItem ta, tb, tc; int it = it_lo + wv;
    if (it < it_hi) { ta = mk(it); titem_load(ta, va, lane); }
    if (it + nwv < it_hi) { tb = mk(it + nwv); titem_load(tb, vb, lane); }
    while (it < it_hi) {
        if (it + 2 * nwv < it_hi) { tc = mk(it + 2 * nwv); titem_load(tc, vc, lane); }
        titem_finish(ta, va, scr, lane); it += nwv; if (it >= it_hi) break;
        if (it + 2 * nwv < it_hi) { ta = mk(it + 2 * nwv); titem_load(ta, va, lane); }
        titem_finish(tb, vb, scr, lane); it += nwv; if (it >= it_hi) break;
        if (it + 2 * nwv < it_hi) { tb = mk(it + 2 * nwv); titem_load(tb, vb, lane); }
        titem_finish(tc, vc, scr, lane); it += nwv;
    }
}
constexpr int I_GU = 16 * 8, I_DN = 4 * 16, MOE_ITEMS = NE * (I_GU + I_DN);
struct WItem { const float* W; bf16* WT; const float* gain; int K, N, k0, n0, gu; };
__device__ __forceinline__ void witem_load(const WItem& t, f32x4 (&v)[16], int lane) {
    const int sub = lane >> 4, c4 = (lane & 15) * 4;
#pragma unroll
    for (int j = 0; j < 16; ++j) v[j] = __builtin_nontemporal_load((const GAS f32x4*)(t.W + (size_t)(t.k0 + 4 * j + sub) * t.N + t.n0 + c4));
}
__device__ __forceinline__ void witem_write(const WItem& t, const f32x4 (&v)[16], LAS float* scr, int lane) {
    const int sub = lane >> 4, c4 = (lane & 15) * 4;
#pragma unroll
    for (int j = 0; j < 16; ++j) { const int kk = 4 * j + sub; const float g = t.gain ? t.gain[t.k0 + kk] : 1.0f; LAS float* s = scr + kk * 64;
        s[(c4 + 0 + kk) & 63] = v[j].x * g; s[(c4 + 1 + kk) & 63] = v[j].y * g; s[(c4 + 2 + kk) & 63] = v[j].z * g; s[(c4 + 3 + kk) & 63] = v[j].w * g; }
    LDS_WAIT(); asm volatile("" ::: "memory");
}
__device__ __forceinline__ void witem_out(const WItem& t, LAS float* scr, int lane) {
    const int c = lane & 7;
#pragma unroll 2
    for (int j = 0; j < 8; ++j) { const int n = (lane >> 3) + 8 * j; const LAS float* s = scr + (8 * c) * 64;
        float e[8];
#pragma unroll
        for (int q = 0; q < 8; ++q) e[q] = s[q * 64 + ((n + 8 * c + q) & 63)];
        v4u o; o.x = pk2(e[0], e[1]); o.y = pk2(e[2], e[3]); o.z = pk2(e[4], e[5]); o.w = pk2(e[6], e[7]);
        const int nn = t.n0 + n, row = t.gu ? MapGu()(nn) : nn;
        *(GAS v4u*)(t.WT + (size_t)row * t.K + t.k0 + 8 * c) = o; }
    LDS_WAIT(); asm volatile("" ::: "memory");
}
__device__ __forceinline__ void moe_prep(unsigned char* ws, const float* w_gu, const float* w_dn, const float* g_moe, int it_lo, int it_hi, int wv, int nwv, LAS float* scr, int lane) {
    auto mk = [&](int it) -> WItem { WItem t; int r = it;
        if (r < NE * I_GU) { const int e = r / I_GU, item = r % I_GU; t.W = w_gu + (size_t)e * D * 512; t.WT = (bf16*)(ws + WS_WGU) + (size_t)e * 512 * D; t.gain = g_moe; t.K = D; t.N = 512; t.k0 = 64 * (item / 8); t.n0 = 64 * (item % 8); t.gu = 1; return t; }
        r -= NE * I_GU; { const int e = r / I_DN, item = r % I_DN; t.W = w_dn + (size_t)e * FF * D; t.WT = (bf16*)(ws + WS_WDN) + (size_t)e * D * FF; t.gain = nullptr; t.K = FF; t.N = D; t.k0 = 64 * (item / 16); t.n0 = 64 * (item % 16); t.gu = 0; return t; } };
    f32x4 v[16]; WItem tc, tn; int it = it_lo + wv;
    if (it < it_hi) { tc = mk(it); witem_load(tc, v, lane); }
    while (it < it_hi) {
        witem_write(tc, v, scr, lane);
        const int it2 = it + nwv; if (it2 < it_hi) { tn = mk(it2); witem_load(tn, v, lane); }
        witem_out(tc, scr, lane);
        tc = tn; it = it2;
    }
}
#ifdef PREP_IN_P0
#define PREP_A MOE_ITEMS
#define PREP_B MOE_ITEMS
#endif
#ifndef PREP_A
#define PREP_A 750
#endif
#ifndef PREP_B
#define PREP_B 5500
#endif
__device__ __forceinline__ void group_barrier(unsigned* cnt, unsigned target, unsigned* tmo, volatile LAS unsigned* st) {
    asm volatile("s_waitcnt vmcnt(0)" ::: "memory");
    __syncthreads();
    if (threadIdx.x == 0) {
        const unsigned mode = st[0];
        if (mode != 1u) __builtin_amdgcn_fence(__ATOMIC_RELEASE, "agent");
        asm volatile("s_waitcnt vmcnt(0)" ::: "memory");
        (void)xb_add(cnt, 1u);
        unsigned sp = 0;
        while (xb_ld(cnt) < target) { __builtin_amdgcn_s_sleep(1); if ((++sp & 255u) == 0u) { if (xb_ld(tmo)) break; if (sp > XB_SPIN_CAP) { atomicAdd(tmo, 1u); break; } } }
        __builtin_amdgcn_fence(__ATOMIC_ACQUIRE, "agent");
        asm volatile("s_waitcnt vmcnt(0)" ::: "memory");
        if (mode == 0u) { const unsigned m = xb_ld(cnt + 1); st[0] = (__builtin_popcount(m) == 1) ? 1u : 2u; }
    }
    __syncthreads();
}
__device__ __forceinline__ void conv_item(unsigned char* ws, const float* conv_w, int m, int c) {
    const int s = m % SEQ; const bf16* Ub = (const bf16*)(ws + WS_U) + (size_t)m * CW + c;
    f32x4 u0a, u0b, u1a, u1b, u2a, u2b, ba, bb;
    pg8::unpack8(*(const v4u*)Ub, u2a, u2b); pg8::unpack8(*(const v4u*)((const bf16*)(ws + WS_BG) + (size_t)m * CW + c), ba, bb);
    if (s >= 1) pg8::unpack8(*(const v4u*)(Ub - CW), u1a, u1b); else { u1a = (f32x4){0.f, 0.f, 0.f, 0.f}; u1b = u1a; }
    if (s >= 2) pg8::unpack8(*(const v4u*)(Ub - 2 * CW), u0a, u0b); else { u0a = (f32x4){0.f, 0.f, 0.f, 0.f}; u0b = u0a; }
    const f32x4 w0a = *(const f32x4*)(conv_w + c), w0b = *(const f32x4*)(conv_w + c + 4), w1a = *(const f32x4*)(conv_w + CW + c), w1b = *(const f32x4*)(conv_w + CW + c + 4),
                w2a = *(const f32x4*)(conv_w + 2 * CW + c), w2b = *(const f32x4*)(conv_w + 2 * CW + c + 4);
    *(v4u*)((bf16*)(ws + WS_CONV) + (size_t)m * CW + c) = pg8::pack8(ba * (w0a * u0a + w1a * u1a + w2a * u2a), bb * (w0b * u0b + w1b * u1b + w2b * u2b));
}
__device__ __forceinline__ const void* kernarg_ptr(int i) {
    const void* const* p = (const void* const*)__builtin_amdgcn_kernarg_segment_ptr(); asm volatile("" : "+s"(p)); return p[i];
}
__global__ void __launch_bounds__(NWAVES * 64, 2) mega_fwd(Args args) {
    extern __shared__ __attribute__((aligned(16))) unsigned char lds[];
    LAS unsigned char* const ldsl = (LAS unsigned char*)lds;
    volatile LAS unsigned* const MISC = (volatile LAS unsigned*)(ldsl + MISC_OFF);
    const int tid = threadIdx.x, lane = tid & 63, wave = __builtin_amdgcn_readfirstlane(tid >> 6);
    const int G = gridDim.x, bx = blockIdx.x, vcu = (G % 8 == 0) ? (bx % 8) * (G / 8) + bx / 8 : bx;
    unsigned char* const ws = args.ws;
    gu32* const ctl = (gu32*)(ws + WS_CTL);
#define ARGF(i) ((const float*)kernarg_ptr(i))
#define WSB(off) ((bf16*)(ws + (off)))
    float* const COS = (float*)(ws + WS_COS); float* const SIN = (float*)(ws + WS_SIN);
    int* const RIDX = (int*)(ws + WS_RIDX); int* const SLOT = (int*)(ws + WS_SLOT); int* const EID = (int*)(ws + WS_EID); int* const RIDX2 = (int*)(ws + WS_RIDX2); float* const EW = (float*)(ws + WS_EW);
    pg8::ssq_t* const SSQQ = (pg8::ssq_t*)(ctl + CW_SSQQ); pg8::ssq_t* const SSQKV = (pg8::ssq_t*)(ctl + CW_SSQKV); pg8::ssq_t* const SSQ1 = (pg8::ssq_t*)(ctl + CW_SSQ1); pg8::ssq_t* const SSQ2 = (pg8::ssq_t*)(ctl + CW_SSQ2);
    unsigned* const COUNTS = (unsigned*)(ctl + CW_COUNTS);
    float* const LOG = (float*)(ws + WS_LOG);

    for (int u = tid; u < (LDS_BYTES - LDSCTL_OFF) / 4; u += NWAVES * 64) ((LAS unsigned*)(ldsl + LDSCTL_OFF))[u] = 0u;
    __syncthreads();
    const int lo = args.ph_lo, hi = args.ph_hi;
    XcdBarrier bar; bar.bar = (unsigned*)(ctl + CW_BAR); bar.x = 0; bar.st = nullptr;
    if (hi - lo > 1) { bar = xcd_barrier_post((unsigned*)(ctl + CW_BAR), MISC + 8); if (GROUPBAR && tid == 0) atomicOr((unsigned*)(ctl + CW_GRP) + 64 * (bx % 64) + 1, 1u << bar.x); }
#ifndef PHMASK
#define PHMASK 0x7fff
#endif
#ifndef REPMASK
#define REPMASK 0
#endif
#ifndef REPBAR
#define REPBAR 0
#endif
#define REP(k) for (int rep_ = 0; rep_ < ((((REPMASK) >> (k)) & 1) ? 2 : 1); ++rep_, (REPBAR ? xcd_barrier(bar) : (void)0))
#define IN(k) ((((PHMASK) >> (k)) & 1) && lo <= (k) && (k) < hi)
#ifndef NBAR
#define NBAR 1
#endif
#ifdef TSPROBE
#define TSTAMP(i) do { if (bx == 0 && tid == 0) ((unsigned long long*)(ctl + 512))[i] = __builtin_amdgcn_s_memrealtime(); } while (0)
#else
#define TSTAMP(i) do {} while (0)
#endif
#define SEAM(k) do { if (IN(k) && IN((k) + 1)) { for (int nb_ = 0; nb_ < NBAR; ++nb_) xcd_barrier(bar); } TSTAMP((k) + 1); } while (0)
    unsigned* const grp_cnt = (unsigned*)(ctl + CW_GRP) + 64 * (bx % 64); unsigned* const grp_tmo = (unsigned*)(ctl + CW_BAR) + XB_TMO;
#define GSEAM(k, s) do { if (IN(k) && IN((k) + 1)) { if (GROUPBAR && G == 256) group_barrier(grp_cnt, 4u * ((s) + 1u), grp_tmo, MISC + 12); else xcd_barrier(bar); } TSTAMP((k) + 1); } while (0)
    TSTAMP(0);
#ifndef NPASS
#define NPASS 1
#endif
    const int gw = vcu * NWAVES + wave, NGW = G * NWAVES, gt = vcu * (NWAVES * 64) + tid, NGT = G * NWAVES * 64;

    if (IN(0)) REP(0) {
        const float* x = ARGF(0); const float* mem = ARGF(1); const int* pos = (const int*)ARGF(2); const float* g_mix = ARGF(3); const float* w_in = ARGF(4);
        const float* g_cq = ARGF(6); const float* w_uq = ARGF(7); const float* g_ckv = ARGF(8); const float* w_ukv = ARGF(9); const float* w_a = ARGF(11); const float* w_b = ARGF(12); const float* w_out = ARGF(13);
        const float* g_xattn = ARGF(14); const float* g_mem = ARGF(15); const float* w_q_mem = ARGF(16); const float* w_kv_mem = ARGF(17); const float* w_o_mem = ARGF(18); const float* g_moe = ARGF(19);
        const float* w_rg = ARGF(20); const float* w_re = ARGF(22);
        LAS float* scr = (LAS float*)(ldsl + RING_OFF + wave * 16384);
        constexpr int I_IN = 16 * 125, I_UQ = 4 * 24, I_UKV = 2 * 32, I_A = 8 * 32, I_OUT = 16 * 32, I_QM = 16 * 16, I_KVM = 16 * 32, I_OM = 8 * 32;
        constexpr int NITEMS = I_IN + I_UQ + I_UKV + 2 * I_A + I_OUT + I_QM + I_KVM + I_OM;
        auto mk_item = [&](int it) -> TItem {
            TItem t; int r = it;
            auto set = [&](const float* W, int K, int N, bf16* WT, const float* gain, int map, int item) { const int nblk = N / 32; t.W = W; t.WT = WT; t.gain = gain; t.K = K; t.N = N; t.k0 = 64 * (item / nblk); t.n0 = 32 * (item % nblk); t.map = map; };
            if (r < I_IN) { set(w_in, D, IN_COLS, WSB(WS_WIN), nullptr, 1, r); return t; } r -= I_IN;
            if (r < I_UQ) { set(w_uq, QL, NH * DQK, WSB(WS_WUQ), g_cq, 2, r); return t; } r -= I_UQ;
            if (r < I_UKV) { set(w_ukv, KVL, NH * 128, WSB(WS_WUKV), g_ckv, 3, r); return t; } r -= I_UKV;
            if (r < I_A) { set(w_a, 512, D, WSB(WS_WA), nullptr, 0, r); return t; } r -= I_A;
            if (r < I_A) { set(w_b, 512, D, WSB(WS_WB), nullptr, 0, r); return t; } r -= I_A;
            if (r < I_OUT) { set(w_out, D, D, WSB(WS_WOUT), nullptr, 0, r); return t; } r -= I_OUT;
            if (r < I_QM) { set(w_q_mem, D, 512, WSB(WS_WQM), g_xattn, 0, r); return t; } r -= I_QM;
            if (r < I_KVM) { set(w_kv_mem, D, D, WSB(WS_WKVM), nullptr, 0, r); return t; } r -= I_KVM;
            set(w_o_mem, 512, D, WSB(WS_WOM), nullptr, 0, r); return t;
        };
        run_titems(mk_item, 0, NITEMS, gw, NGW, scr, lane);
#ifdef PREP_IN_P0
        moe_prep(ws, ARGF(24), ARGF(25), ARGF(19), 0, MOE_ITEMS, gw, NGW, scr, lane);
#endif
        {
            auto ldrow = [&](const float* xrow, f32x4 (&v)[4]) { const GAS f32x4* xr = (const GAS f32x4*)xrow + lane; _Pragma("unroll") for (int j = 0; j < 4; ++j) v[j] = xr[64 * j]; };
            auto finrow = [&](const f32x4 (&v)[4], const float* g, bf16* orow, unsigned char* orow8) { float s = 0.f;
                _Pragma("unroll") for (int j = 0; j < 4; ++j) s += (v[j].x * v[j].x + v[j].y * v[j].y) + (v[j].z * v[j].z + v[j].w * v[j].w);
                const float rstd = 1.f / sqrtf(wave_sum(s) * (1.f / D) + EPS); const GAS f32x4* gr = (const GAS f32x4*)g + lane; GAS unsigned long long* o8 = (GAS unsigned long long*)orow + lane;
                _Pragma("unroll") for (int j = 0; j < 4; ++j) { const f32x4 gg = gr[64 * j]; const float a0 = v[j].x * rstd * gg.x, a1 = v[j].y * rstd * gg.y, a2 = v[j].z * rstd * gg.z, a3 = v[j].w * rstd * gg.w;
                    o8[64 * j] = (unsigned long long)pk2(a0, a1) | ((unsigned long long)pk2(a2, a3) << 32);
                    if (orow8) { unsigned w = 0; w = __builtin_amdgcn_cvt_pk_fp8_f32(a0, a1, w, false); w = __builtin_amdgcn_cvt_pk_fp8_f32(a2, a3, w, true); ((GAS unsigned*)orow8)[lane + 64 * j] = w; } } };
            f32x4 r0[4], r1[4];
            for (int m = gw; m < M; m += 2 * NGW) { const int m1 = m + NGW; ldrow(x + (size_t)m * D, r0); if (m1 < M) ldrow(x + (size_t)m1 * D, r1);
                finrow(r0, g_mix, WSB(WS_XN) + (size_t)m * D, nullptr); if (m1 < M) finrow(r1, g_mix, WSB(WS_XN) + (size_t)m1 * D, nullptr); }
            for (int m = gw; m < MM; m += NGW) { ldrow(mem + (size_t)m * D, r0); finrow(r0, g_mem, WSB(WS_MEMN) + (size_t)m * D, nullptr); }
        }
        for (int i = gt; i < M * 16; i += NGT) { const int m = i >> 4, j = i & 15; const float inv = powf(10000.0f, -(float)(2 * j) / 32.0f); const float ang = (float)pos[m] * inv; COS[i] = cosf(ang); SIN[i] = sinf(ang); }
        for (int i = gt; i < PMAX; i += NGT) RIDX[i] = 0;
        for (int i = gt; i < 96 * D; i += NGT) WSB(WS_WIN)[(size_t)416 * D + i] = 0;
        for (int i = gt; i < 256 * D; i += NGT) { const int n = i >> 10, k = i & 1023;
            float v = 0.f; if (n < NG) v = w_rg[k * NG + n] * g_moe[k]; else if (n < NG + NE) v = w_re[k * NE + (n - NG)] * g_moe[k];
            WSB(WS_WR)[i] = (bf16)f2bf(v); }
    }
    SEAM(0);
    if (GROUPBAR && IN(0) && IN(1)) {
        if (tid == 0) { const unsigned m = xb_ld(grp_cnt + 1); MISC[12] = (__builtin_popcount(m) == 1) ? 1u : 2u; }
        __syncthreads();
    }
    if (IN(1)) REP(1) {
        const float* b_gate = ARGF(5);
        pg8::Gemm g{WSB(WS_XN), WSB(WS_WIN), M, INP, D}; pg8::StaticOrder S;
#ifdef P1SPLIT
        S.init(M, INP, 1024, bx + args.sub * 256, INROT);
#else
        S.init(M, INP, G, bx, INROT);
#endif
        pg8::EpiInProj E{WSB(WS_CQ), WSB(WS_CKV), WSB(WS_KR), WSB(WS_BG), WSB(WS_U), WSB(WS_G), SSQQ, SSQKV, COS, SIN, b_gate, rep_ == 0, 0, 1.0f};
        pg8::gemm_phase<pg8::EpiInProj, pg8::StaticOrder, P1ALIGN>(ldsl + RING_OFF, g, S, E);
        if (rep_ == 0 && G == 256) {
            group_barrier(grp_cnt + 4, 4u, grp_tmo, MISC + 12);
            const int pm1 = 8 * (bx % 8) + (bx / 8) % 8, j1 = bx / 64;
            if (j1 == 0 || j1 == 2) { pg8::Gemm g2{WSB(WS_CQ), WSB(WS_WUQ), M, 768, QL}; pg8::PanelOrder S2{pm1, j1 == 0 ? 2 : 1, j1 == 0 ? 0 : 2};
                pg8::EpiQUp E2{WSB(WS_Q), SSQQ, COS, SIN}; pg8::gemm_phase<pg8::EpiQUp, pg8::PanelOrder, true>(ldsl + RING_OFF, g2, S2, E2); }
            if (j1 == 1 || j1 == 2) { pg8::Gemm g2{WSB(WS_CKV), WSB(WS_WUKV), M, 1024, KVL}; pg8::PanelOrder S2{pm1, j1 == 1 ? 3 : 1, j1 == 1 ? 0 : 3};
                pg8::EpiKVUp E2{WSB(WS_KN), WSB(WS_V), SSQKV}; pg8::gemm_phase<pg8::EpiKVUp, pg8::PanelOrder, true>(ldsl + RING_OFF, g2, S2, E2); }
            if (j1 == 3) {
                if (bx < 224) { pg8::Gemm g{WSB(WS_MEMN), WSB(WS_WKVM), MM, 1024, D}; pg8::StaticOrder S; S.init(MM, 1024, G, bx - 192);
                    pg8::EpiKVM E{WSB(WS_KM), WSB(WS_VM)}; pg8::gemm_phase<pg8::EpiKVM, pg8::StaticOrder, true>(ldsl + RING_OFF, g, S, E); }
                else if (PREP_A > 0 && PREP_A < MOE_ITEMS) moe_prep(ws, ARGF(24), ARGF(25), ARGF(19), 0, PREP_A, (bx - 224) * NWAVES + wave, 32 * NWAVES, (LAS float*)(ldsl + RING_OFF + wave * 16384), lane);
            }
        }
    }
    SEAM(1);
    if (IN(3)) REP(3) {
        const float* conv_w = ARGF(10);
        for (int i = gt; i < M * (CW / 8); i += NGT) conv_item(ws, conv_w, i >> 6, (i & 63) * 8);
        for (int v = vcu; v < 256; v += G) {
            const int bh = v >> 2, b = bh >> 3, h = bh & 7, s4 = v & 3;
            for (int k = 0; k < 2; ++k) { const int qb = k ? 7 - s4 : s4; const size_t row0 = (size_t)b * SEQ + qb * 256, key0 = (size_t)b * SEQ;
                att::attn_unit<att::MlaCfg>(WSB(WS_Q) + row0 * 768 + h * 64, WSB(WS_Q) + row0 * 768 + 512 + h * 32, WSB(WS_KN) + key0 * 512 + h * 64, WSB(WS_KR) + key0 * 32,
                                             WSB(WS_V) + key0 * 512 + h * 64, WSB(WS_ATT) + row0 * 512 + h * 64, qb * 256, 4 * (qb + 1), (char*)lds + RING_OFF); }
        }
        __syncthreads();
    }
    SEAM(3);
    if (IN(4)) REP(4) {
        { pg8::Gemm g{WSB(WS_ATT), WSB(WS_WA), M, D, 512}; pg8::StaticOrder S; S.init(M, D, G, bx);
          pg8::EpiMix<false> E{WSB(WS_MIX), WSB(WS_G)}; pg8::gemm_phase<pg8::EpiMix<false>, pg8::StaticOrder, SUALIGN>(ldsl + RING_OFF, g, S, E); }
        { pg8::Gemm g{WSB(WS_CONV), WSB(WS_WB), M, D, 512}; pg8::StaticOrder S; S.init(M, D, G, bx);
          pg8::EpiMix<true> E{WSB(WS_MIX), WSB(WS_G)}; pg8::gemm_phase<pg8::EpiMix<true>, pg8::StaticOrder, SUALIGN>(ldsl + RING_OFF, g, S, E); }
    }
    GSEAM(4, 0);
    if (IN(5)) REP(5) {
        const float* x = ARGF(0);
        pg8::Gemm g{WSB(WS_MIX), WSB(WS_WOUT), M, D, D}; pg8::StaticOrder S; S.init(M, D, G, bx);
        pg8::EpiResid<float> E{x, WSB(WS_X1B), SSQ1, rep_ == 0}; pg8::gemm_phase<pg8::EpiResid<float>, pg8::StaticOrder, SUALIGN>(ldsl + RING_OFF, g, S, E);
    }
    GSEAM(5, 1);
    if (IN(6)) REP(6) {
        pg8::Gemm g{WSB(WS_X1B), WSB(WS_WQM), M, 512, D}; pg8::StaticOrder S; S.init(M, 512, G, bx);
        pg8::EpiScaleRows E{WSB(WS_QM), 512, SSQ1}; pg8::gemm_phase<pg8::EpiScaleRows, pg8::StaticOrder, SUALIGN>(ldsl + RING_OFF, g, S, E);
        if (rep_ == 0 && bx >= 128) moe_prep(ws, ARGF(24), ARGF(25), ARGF(19), PREP_A, PREP_B, (bx - 128) * NWAVES + wave, 128 * NWAVES, (LAS float*)(ldsl + RING_OFF + wave * 16384), lane);
    }
    GSEAM(6, 2);
    if (IN(7)) REP(7) {
        for (int v = bx; v < 256; v += G) {
            const int pmv = 8 * (v % 8) + (v / 8) % 8, b = pmv >> 3, qb = pmv & 7, h = v / 64; const size_t row0 = (size_t)b * SEQ + qb * 256, key0 = (size_t)b * MEM;
            att::attn_unit<att::XatCfg>(WSB(WS_QM) + row0 * 512 + h * 128, nullptr, WSB(WS_KM) + key0 * 512 + h * 128, nullptr, WSB(WS_VM) + key0 * 512 + h * 128,
                                         WSB(WS_OM) + row0 * 512 + h * 128, 0, MEM / 64, (char*)lds + RING_OFF);
        }
        __syncthreads();
    }
    GSEAM(7, 3);
    if (IN(8)) REP(8) {
        pg8::Gemm g{WSB(WS_OM), WSB(WS_WOM), M, D, 512}; pg8::StaticOrder S; S.init(M, D, G, bx);
        pg8::EpiResid<bf16> E{WSB(WS_X1B), WSB(WS_X2B), SSQ2, rep_ == 0}; pg8::gemm_phase<pg8::EpiResid<bf16>, pg8::StaticOrder, SUALIGN>(ldsl + RING_OFF, g, S, E);
    }
    GSEAM(8, 4);
    if (IN(9)) REP(9) {
        const float* b_rg = ARGF(21); const float* b_re = ARGF(23);
        pg8::Gemm g{WSB(WS_X2B), WSB(WS_WR), M, 256, D}; pg8::StaticOrder S; S.init(M, 256, G, bx);
        pg8::EpiRouter E{LOG}; pg8::gemm_phase<pg8::EpiRouter, pg8::StaticOrder, SUALIGN>(ldsl + RING_OFF, g, S, E);
        if (rep_ == 0 && bx >= 64) moe_prep(ws, ARGF(24), ARGF(25), ARGF(19), PREP_B, MOE_ITEMS, (bx - 64) * NWAVES + wave, 192 * NWAVES, (LAS float*)(ldsl + RING_OFF + wave * 16384), lane);
        VM_WAIT(); __syncthreads();
        if (rep_ == 0)
        { pg8::Unit ur; if (S.next(0, ur) && tid < 256) { const int n = ur.pm * 256 + tid;
            const float rs = 1.0f / sqrtf(pg8::ssq_get(SSQ2 + n) * (1.0f / D) + EPS); const float* L = LOG + (size_t)n * 128;
            float gl[NG]; float gm = -3.0e38f; int gi = 0;
#pragma unroll
            for (int g = 0; g < NG; ++g) { gl[g] = L[g] * rs + b_rg[g]; if (gl[g] > gm) { gm = gl[g]; gi = g; } }
            float se = 0.f;
#pragma unroll
            for (int g = 0; g < NG; ++g) se += __expf(gl[g] - gm);
            const float pg = 1.0f / se;
            float v0 = -3.0e38f, v1 = -3.0e38f; int i0 = 0, i1 = 0;
            for (int e = 0; e < EPG; ++e) { const float v = L[NG + gi * EPG + e] * rs + b_re[gi * EPG + e];
                if (v > v0) { v1 = v0; i1 = i0; v0 = v; i0 = e; } else if (v > v1) { v1 = v; i1 = e; } }
            const float e1 = __expf(v1 - v0);
            EID[2 * n] = gi * EPG + i0; EID[2 * n + 1] = gi * EPG + i1; EW[2 * n] = pg / (1.0f + e1); EW[2 * n + 1] = pg * e1 / (1.0f + e1);
            { const int ea = gi * EPG + i0, eb = gi * EPG + i1;
              const int sa = (int)atomicAdd(&COUNTS[64 * ea], 1u), sb = (int)atomicAdd(&COUNTS[64 * eb], 1u);
              RIDX2[ea * RCAP + sa] = n; RIDX2[eb * RCAP + sb] = n; SLOT[2 * n] = sa; SLOT[2 * n + 1] = sb; }
        } }
    }
    SEAM(10);
    if (IN(12) || IN(13)) {
        LAS int* texp = (LAS int*)(ldsl + TEXP_OFF); LAS int* gtab = (LAS int*)(ldsl + GTAB_OFF); LAS int* offs = (LAS int*)(ldsl + OFFS_OFF);
        LAS int* cnts = offs + 128;
        if (tid < NE) cnts[tid] = (int)__hip_atomic_load(&COUNTS[64 * tid], RLX_AGENT);
        __syncthreads();
        LAS int* tord = (LAS int*)(ldsl + TORD_OFF);
        if (tid == 0) { int t = 0; for (int e = 0; e < NE; ++e) { offs[e] = t * 256; t += (cnts[e] + 255) / 256; } offs[64] = t; }
        __syncthreads();
        if (tid < NTILE_MAX) { int lo_ = 0, hi_ = NE - 1;
            const int r0 = tid * 256;
            while (lo_ < hi_) { const int mid = (lo_ + hi_ + 1) >> 1; if (offs[mid] <= r0) lo_ = mid; else hi_ = mid - 1; }
            while (lo_ > 0 && cnts[lo_] == 0) --lo_;
            texp[tid] = lo_; tord[tid] = tid; }
        __syncthreads();
        const int ntiles = __builtin_amdgcn_readfirstlane(offs[64]);
        if (IN(12)) {
            unsigned* tready = (unsigned*)(ctl + CW_TREADY);
            for (int i = 0; i < 4; ++i) { const int L = i * G + vcu; if (L < ntiles * 2 && tid < 256) { const int tile = tord[L >> 1] & 0xffff, e = texp[tile], s = tile * 256 - offs[e] + tid;
                const int tok = (s < cnts[e]) ? RIDX2[e * RCAP + s] : 0; gtab[i * 256 + tid] = tok; ((float*)RIDX)[tile * 256 + tid] = __builtin_amdgcn_rsqf(pg8::ssq_get(SSQ2 + tok) * (1.0f / D) + EPS); } }
            VM_WAIT(); __syncthreads();
            { pg8::Gemm g{WSB(WS_X2B), WSB(WS_WGU), PMAX, NE * 512, D}; pg8::MoeUpOrder S{ntiles, G, vcu, texp, tord, tready};
              pg8::EpiGateUp E{WSB(WS_HH), (const float*)RIDX}; pg8::gemm_phase<pg8::EpiGateUp, pg8::MoeUpOrder, MOEALIGN, true>(ldsl + RING_OFF, g, S, E, gtab); }
            { pg8::Gemm g{WSB(WS_HH), WSB(WS_WDN), PMAX, NE * D, FF}; pg8::MoeDownOrder S{ntiles, G, vcu, texp, tord, tready, (unsigned*)(ctl + CW_BAR) + XB_TMO};
              pg8::EpiDown E{WSB(WS_YD)}; pg8::gemm_phase<pg8::EpiDown, pg8::MoeDownOrder, MOEALIGN>(ldsl + RING_OFF, g, S, E); }
        }
    }
    SEAM(13);
    if (IN(14)) REP(14) {
        const float* g_final = ARGF(26);
        LAS int* offs = (LAS int*)(ldsl + OFFS_OFF);
        __syncthreads();
        if (tid < NE) offs[128 + tid] = (int)__hip_atomic_load(&COUNTS[64 * tid], RLX_AGENT);
        __syncthreads();
        if (tid == 0) { int t = 0; for (int e = 0; e < NE; ++e) { offs[e] = t * 256; t += (offs[128 + e] + 255) / 256; } }
        __syncthreads();
        {
            typedef unsigned long long u64;
            const GAS f32x4* gr = (const GAS f32x4*)g_final + lane; f32x4 gg[4];
#pragma unroll
            for (int j = 0; j < 4; ++j) gg[j] = gr[64 * j];
            u64 ra[2][4], rb[2][4], rx[2][4]; float w0[2], w1[2];
            auto ld = [&](int m, int b) { const size_t s0 = (size_t)(offs[EID[2 * m]] + SLOT[2 * m]), s1 = (size_t)(offs[EID[2 * m + 1]] + SLOT[2 * m + 1]); w0[b] = EW[2 * m]; w1[b] = EW[2 * m + 1];
                const GAS u64* xr = (const GAS u64*)(WSB(WS_X2B) + (size_t)m * D) + lane; const GAS u64* y0 = (const GAS u64*)(WSB(WS_YD) + s0 * D) + lane; const GAS u64* y1 = (const GAS u64*)(WSB(WS_YD) + s1 * D) + lane;
                _Pragma("unroll") for (int j = 0; j < 4; ++j) { ra[b][j] = y0[64 * j]; rb[b][j] = y1[64 * j]; rx[b][j] = xr[64 * j]; } };
            auto fin = [&](int m, int b) { f32x4 v[4]; float ss = 0.f;
                _Pragma("unroll") for (int j = 0; j < 4; ++j) { const u64 a = ra[b][j], bq = rb[b][j], xw = rx[b][j];
                    const unsigned al = (unsigned)a, ah = (unsigned)(a >> 32), bl = (unsigned)bq, bh = (unsigned)(bq >> 32), xl = (unsigned)xw, xh = (unsigned)(xw >> 32);
                    const f32x4 ya = (f32x4){pg8::bf_lo(al), pg8::bf_hi(al), pg8::bf_lo(ah), pg8::bf_hi(ah)}, yb = (f32x4){pg8::bf_lo(bl), pg8::bf_hi(bl), pg8::bf_lo(bh), pg8::bf_hi(bh)};
                    v[j] = (f32x4){pg8::bf_lo(xl), pg8::bf_hi(xl), pg8::bf_lo(xh), pg8::bf_hi(xh)} + (ya * w0[b] + yb * w1[b]); ss += (v[j].x * v[j].x + v[j].y * v[j].y) + (v[j].z * v[j].z + v[j].w * v[j].w); }
                const float rstd = 1.f / sqrtf(wave_sum(ss) * (1.f / D) + EPS);
                GAS f32x4* o = (GAS f32x4*)(args.out + (size_t)m * D) + lane;
                _Pragma("unroll") for (int j = 0; j < 4; ++j) o[64 * j] = v[j] * rstd * gg[j]; };
            int m = gw; if (m < M) ld(m, 0);
            while (m < M) {
                const int m1 = m + NGW; if (m1 < M) ld(m1, 1);
                fin(m, 0); if (m1 >= M) break;
                const int m2 = m1 + NGW; if (m2 < M) ld(m2, 0);
                fin(m1, 1); m = m2;
            }
        }
    }
#ifdef TSPROBE
    TSTAMP(15); __syncthreads();
    if (bx == 0 && tid == 0) { asm volatile("s_waitcnt vmcnt(0)" ::: "memory"); const unsigned long long* T = (const unsigned long long*)(ctl + 512);
        unsigned long long a = T[TSPROBE], b = 0; for (int i = TSPROBE + 1; i <= 15; ++i) { b = __hip_atomic_load(&T[i], RLX_AGENT); if (b > a) break; }
        args.out[0] = (float)(b - __hip_atomic_load(&T[TSPROBE], RLX_AGENT)) * 0.01f; }
#endif
#undef IN
#undef SEAM
#undef WSB
}
#if MODE >= 1 && MODE <= 5
constexpr int NV_PMAX = M * 2 + NE * 64, NV_NTILES = NV_PMAX / 64;
template <typename TA> __device__ __forceinline__ float4 ld4(const TA* p);
template <> __device__ __forceinline__ float4 ld4<float>(const float* p) { return *(const float4*)p; }
template <> __device__ __forceinline__ float4 ld4<bf16>(const bf16* p) { const uint2 w = *(const uint2*)p; return make_float4(pg8::bf_lo(w.x), pg8::bf_hi(w.x), pg8::bf_lo(w.y), pg8::bf_hi(w.y)); }
template <typename TA> __global__ __launch_bounds__(256) void k_gemm(const TA* __restrict__ A, int lda, const float* __restrict__ B, int ldb, float* __restrict__ C, int ldc,
                                              int Mr, int N, int K, const int* __restrict__ rowidx, const int* __restrict__ tile_group, long b_group_stride) {
    __shared__ float As[16][65];
    __shared__ float Bs[16][64];
    const int tx = threadIdx.x & 15, ty = threadIdx.x >> 4;
    const int m0 = blockIdx.y * 64, n0 = blockIdx.x * 64;
    const float* Bg = B;
    if (tile_group) { const int g = tile_group[blockIdx.y]; if (g < 0) return; Bg = B + (long)g * b_group_stride; }
    float acc[4][4];
#pragma unroll
    for (int i = 0; i < 4; ++i)
#pragma unroll
        for (int j = 0; j < 4; ++j) acc[i][j] = 0.f;
    const int ar = threadIdx.x >> 2, ak = (threadIdx.x & 3) * 4;
    const int arow = m0 + ar; long asrc = -1;
    if (arow < Mr) asrc = rowidx ? (long)rowidx[arow] : (long)arow;
    const int bk = threadIdx.x >> 4, bn = (threadIdx.x & 15) * 4;
    for (int k0 = 0; k0 < K; k0 += 16) {
        float4 av = make_float4(0.f, 0.f, 0.f, 0.f);
        if (asrc >= 0) av = ld4<TA>(A + asrc * lda + k0 + ak);
        As[ak + 0][ar] = av.x; As[ak + 1][ar] = av.y; As[ak + 2][ar] = av.z; As[ak + 3][ar] = av.w;
#pragma unroll
        for (int j = 0; j < 4; ++j) { const int n = n0 + bn + j; Bs[bk][bn + j] = (n < N) ? Bg[(long)(k0 + bk) * ldb + n] : 0.f; }
        __syncthreads();
#pragma unroll
        for (int kk = 0; kk < 16; ++kk) {
            float a0 = As[kk][ty * 4 + 0], a1 = As[kk][ty * 4 + 1], a2 = As[kk][ty * 4 + 2], a3 = As[kk][ty * 4 + 3];
            float b0 = Bs[kk][tx * 4 + 0], b1 = Bs[kk][tx * 4 + 1], b2 = Bs[kk][tx * 4 + 2], b3 = Bs[kk][tx * 4 + 3];
            acc[0][0] += a0 * b0; acc[0][1] += a0 * b1; acc[0][2] += a0 * b2; acc[0][3] += a0 * b3;
            acc[1][0] += a1 * b0; acc[1][1] += a1 * b1; acc[1][2] += a1 * b2; acc[1][3] += a1 * b3;
            acc[2][0] += a2 * b0; acc[2][1] += a2 * b1; acc[2][2] += a2 * b2; acc[2][3] += a2 * b3;
            acc[3][0] += a3 * b0; acc[3][1] += a3 * b1; acc[3][2] += a3 * b2; acc[3][3] += a3 * b3;
        }
        __syncthreads();
    }
#pragma unroll
    for (int i = 0; i < 4; ++i) { const int r = m0 + ty * 4 + i; if (r >= Mr) continue;
#pragma unroll
        for (int j = 0; j < 4; ++j) { const int c = n0 + tx * 4 + j; if (c < N) C[(long)r * ldc + c] = acc[i][j]; } }
}
__global__ __launch_bounds__(64) void k_rmsnorm(const float* __restrict__ in, int ldi, const float* __restrict__ g, float* __restrict__ out, int ldo, int cols) {
    const long r = blockIdx.x; const int lane = threadIdx.x;
    float s = 0.f;
    for (int c = lane; c < cols; c += 64) { const float v = in[r * ldi + c]; s += v * v; }
    s = wave_sum(s);
    const float rs = 1.0f / sqrtf(s / (float)cols + EPS);
    for (int c = lane; c < cols; c += 64) out[r * ldo + c] = in[r * ldi + c] * rs * g[c];
}
__global__ void k_add(const float* __restrict__ a, const float* __restrict__ b, float* __restrict__ o) {
    const long i = (long)blockIdx.x * blockDim.x + threadIdx.x; o[i] = a[i] + b[i];
}
__global__ __launch_bounds__(64) void k_xattn(const float* __restrict__ QM, const float* __restrict__ KVM, float* __restrict__ OM) {
    const int h = blockIdx.y, half = blockIdx.z; const long m = (long)blockIdx.x * 64 + threadIdx.x; const int b = (int)(m / SEQ);
    float q[XD], o[64];
#pragma unroll
    for (int d = 0; d < XD; ++d) q[d] = QM[m * (XH * XD) + h * XD + d];
#pragma unroll
    for (int d = 0; d < 64; ++d) o[d] = 0.f;
    float mr = -1e30f, l = 0.f; const float scale = 1.0f / sqrtf((float)XD);
    for (int j = 0; j < MEM; ++j) {
        const float* k = KVM + ((long)b * MEM + j) * (2 * XH * XD) + h * XD; const float* v = k + XH * XD + half * 64;
        float sc = 0.f;
#pragma unroll
        for (int d = 0; d < XD; ++d) sc += q[d] * k[d];
        sc *= scale;
        const float mn = fmaxf(mr, sc), al = expf(mr - mn), p = expf(sc - mn);
        l = l * al + p;
#pragma unroll
        for (int d = 0; d < 64; ++d) o[d] = o[d] * al + p * v[d];
        mr = mn;
    }
    const float il = 1.0f / l;
#pragma unroll
    for (int d = 0; d < 64; ++d) OM[m * (XH * XD) + h * XD + half * 64 + d] = o[d] * il;
}
__global__ void k_route(const float* __restrict__ GL, const float* __restrict__ EL, const float* __restrict__ brg, const float* __restrict__ bre,
                        int* __restrict__ eid, float* __restrict__ ew, int* __restrict__ counts) {
    const int n = blockIdx.x * blockDim.x + threadIdx.x; if (n >= M) return;
    float gl[NG]; float gm = -1e30f; int gi = 0;
#pragma unroll
    for (int g = 0; g < NG; ++g) { gl[g] = GL[(long)n * NG + g] + brg[g]; if (gl[g] > gm) { gm = gl[g]; gi = g; } }
    float se = 0.f;
#pragma unroll
    for (int g = 0; g < NG; ++g) se += expf(gl[g] - gm);
    const float pg = 1.0f / se;
    float v0 = -1e30f, v1 = -1e30f; int i0 = 0, i1 = 0;
    for (int e = 0; e < EPG; ++e) { const float v = EL[(long)n * NE + gi * EPG + e] + bre[gi * EPG + e];
        if (v > v0) { v1 = v0; i1 = i0; v0 = v; i0 = e; } else if (v > v1) { v1 = v; i1 = e; } }
    const float e1 = expf(v1 - v0), w0 = pg / (1.0f + e1), w1 = pg * e1 / (1.0f + e1);
    eid[2 * n] = gi * EPG + i0; eid[2 * n + 1] = gi * EPG + i1; ew[2 * n] = w0; ew[2 * n + 1] = w1;
    atomicAdd(&counts[gi * EPG + i0], 1); atomicAdd(&counts[gi * EPG + i1], 1);
}
__global__ void k_scan(const int* __restrict__ counts, int* __restrict__ offs, int* __restrict__ cursor, int* __restrict__ tile_group, int* __restrict__ rowidx) {
    __shared__ int so[NE + 1];
    if (threadIdx.x == 0) { int a = 0; for (int e = 0; e < NE; ++e) { so[e] = a; a += (counts[e] + 63) / 64 * 64; } so[NE] = a; }
    __syncthreads();
    if (threadIdx.x < NE) { offs[threadIdx.x] = so[threadIdx.x]; cursor[threadIdx.x] = 0; }
    for (int t = threadIdx.x; t < NV_NTILES; t += blockDim.x) { int g = -1; const int r = t * 64; if (r < so[NE]) { for (int e = 0; e < NE; ++e) if (r >= so[e] && r < so[e + 1]) g = e; } tile_group[t] = g; }
    for (int r = threadIdx.x; r < NV_PMAX; r += blockDim.x) rowidx[r] = -1;
}
__global__ void k_scatter(const int* __restrict__ eid, const int* __restrict__ offs, int* __restrict__ cursor, int* __restrict__ rowidx, int* __restrict__ slot) {
    const int i = blockIdx.x * blockDim.x + threadIdx.x; if (i >= 2 * M) return;
    const int e = eid[i]; const int p = offs[e] + atomicAdd(&cursor[e], 1);
    rowidx[p] = i >> 1; slot[i] = p;
}
__global__ void k_silu(const float* __restrict__ GU, float* __restrict__ HH) {
    const long i = (long)blockIdx.x * blockDim.x + threadIdx.x; const long r = i >> 8; const int c = (int)(i & 255);
    const float g = GU[r * 512 + c], u = GU[r * 512 + 256 + c];
    HH[i] = g / (1.0f + expf(-g)) * u;
}
__global__ __launch_bounds__(64) void k_final(const float* __restrict__ X2, const float* __restrict__ YD, const int* __restrict__ slot, const float* __restrict__ ew,
                                              const float* __restrict__ g, float* __restrict__ out) {
    const long m = blockIdx.x; const int lane = threadIdx.x;
    const long s0 = slot[2 * m], s1 = slot[2 * m + 1]; const float w0 = ew[2 * m], w1 = ew[2 * m + 1];
    float v[16]; float ss = 0.f;
#pragma unroll
    for (int j = 0; j < 16; ++j) { const int c = lane + 64 * j; v[j] = X2[m * D + c] + (w0 * YD[s0 * D + c] + w1 * YD[s1 * D + c]); ss += v[j] * v[j]; }
    ss = wave_sum(ss); const float rs = 1.0f / sqrtf(ss / (float)D + EPS);
#pragma unroll
    for (int j = 0; j < 16; ++j) { const int c = lane + 64 * j; out[m * D + c] = v[j] * rs * g[c]; }
}

__global__ __launch_bounds__(64) void k_mla_attn_b(const bf16* __restrict__ Q, const bf16* __restrict__ KN, const bf16* __restrict__ KR, const bf16* __restrict__ V, float* __restrict__ O) {
    const int h = blockIdx.y; const long m = (long)blockIdx.x * 64 + threadIdx.x; const int b = (int)(m / SEQ), s = (int)(m % SEQ);
    const int smax = (int)(((long)blockIdx.x * 64) % SEQ) + 63;
    float q[DQK], o[DV];
#pragma unroll
    for (int d = 0; d < DN; ++d) q[d] = pg8::bf_lo(Q[m * 768 + h * 64 + d]);
#pragma unroll
    for (int d = 0; d < DR; ++d) q[DN + d] = pg8::bf_lo(Q[m * 768 + 512 + h * 32 + d]);
#pragma unroll
    for (int d = 0; d < DV; ++d) o[d] = 0.f;
    float mr = -1e30f, l = 0.f; const float scale = 1.0f / sqrtf((float)DQK);
    for (int j = 0; j <= smax; ++j) {
        const long mk = (long)b * SEQ + j;
        const bf16* kn = KN + mk * 512 + h * 64; const bf16* kr = KR + mk * 32; const bf16* vv = V + mk * 512 + h * 64;
        float sc = 0.f;
#pragma unroll
        for (int d = 0; d < DN; ++d) sc += q[d] * pg8::bf_lo(kn[d]);
#pragma unroll
        for (int d = 0; d < DR; ++d) sc += q[DN + d] * pg8::bf_lo(kr[d]);
        sc *= scale;
        if (j <= s) {
            const float mn = fmaxf(mr, sc), al = expf(mr - mn), p = expf(sc - mn);
            l = l * al + p;
#pragma unroll
            for (int d = 0; d < DV; ++d) o[d] = o[d] * al + p * pg8::bf_lo(vv[d]);
            mr = mn;
        }
    }
    const float il = 1.0f / l;
#pragma unroll
    for (int d = 0; d < DV; ++d) O[m * (NH * DV) + h * DV + d] = o[d] * il;
}
__global__ void k_mix_b(const bf16* __restrict__ G, float* __restrict__ BA, const float* __restrict__ BB) {
    const long i = (long)blockIdx.x * blockDim.x + threadIdx.x; const long m = i >> 10; const int c = (int)(i & 1023);
    BA[i] = pg8::bf_lo(G[m * 2048 + c]) * BA[i] + pg8::bf_lo(G[m * 2048 + 1024 + c]) * BB[i];
}
__global__ void k_cvt_b(const bf16* __restrict__ a, float* __restrict__ o) { const long i = (long)blockIdx.x * blockDim.x + threadIdx.x; o[i] = pg8::bf_lo(a[i]); }

__global__ void k_ovr_g(const float* __restrict__ GLOG, const float* __restrict__ bg, bf16* __restrict__ G, int half) {
    const long i = (long)blockIdx.x * blockDim.x + threadIdx.x; const long m = i >> 10; const int c = (int)(i & 1023);
    G[m * 2048 + half * 1024 + c] = (bf16)f2bf(1.0f / (1.0f + expf(-(GLOG[i] + bg[half * 1024 + c]))));
}
__global__ void k_ovr_conv(const float* __restrict__ BCX, const float* __restrict__ cw, bf16* __restrict__ CONV) {
    const long m = blockIdx.x; const int c = threadIdx.x; const int s = (int)(m % SEQ);
    const float* p = BCX + m * 1536;
    float y = cw[2 * CW + c] * (p[CW + c] * p[2 * CW + c]);
    if (s >= 1) y += cw[1 * CW + c] * (p[-1536 + CW + c] * p[-1536 + 2 * CW + c]);
    if (s >= 2) y += cw[0 * CW + c] * (p[-3072 + CW + c] * p[-3072 + 2 * CW + c]);
    CONV[m * CW + c] = (bf16)f2bf(p[c] * y);
}
__global__ void k_ovr_qkv(const float* __restrict__ Qf, const float* __restrict__ KVf, const float* __restrict__ P416, const int* __restrict__ pos,
                          bf16* __restrict__ Q, bf16* __restrict__ KN, bf16* __restrict__ V, bf16* __restrict__ KR) {
    const long m = blockIdx.x; const int t = threadIdx.x;
    { const int h = t >> 7, d = t & 127; const float v = KVf[m * 1024 + t]; if (d < 64) KN[m * 512 + h * 64 + d] = (bf16)f2bf(v); else V[m * 512 + h * 64 + (d - 64)] = (bf16)f2bf(v); }
    if (t < 768) { const int h = t / 96, d = t % 96; if (d < 64) Q[m * 768 + h * 64 + d] = (bf16)f2bf(Qf[m * 768 + t]); }
    if (t < 128) { const int h = t >> 4, j = t & 15; const float inv = powf(10000.0f, -(float)(2 * j) / 32.0f); const float ang = (float)pos[m] * inv; const float c = cosf(ang), s = sinf(ang);
        const float x1 = Qf[m * 768 + h * 96 + 64 + j], x2 = Qf[m * 768 + h * 96 + 80 + j];
        Q[m * 768 + 512 + h * 32 + rope_pos(j)] = (bf16)f2bf(x1 * c - x2 * s); Q[m * 768 + 512 + h * 32 + rope_pos(16 + j)] = (bf16)f2bf(x1 * s + x2 * c);
        if (h == 0) { const float k1 = P416[m * 416 + 384 + j], k2 = P416[m * 416 + 400 + j]; KR[m * 32 + rope_pos(j)] = (bf16)f2bf(k1 * c - k2 * s); KR[m * 32 + rope_pos(16 + j)] = (bf16)f2bf(k1 * s + k2 * c); } }
}

#ifdef DIAG
__global__ void k_diag_cmp(const bf16* __restrict__ G, const bf16* __restrict__ G2, unsigned* __restrict__ cnt) {
    const long i = (long)blockIdx.x * blockDim.x + threadIdx.x; const long m = i >> 11; const int c = (int)(i & 2047);
    const float d = fabsf(pg8::bf_lo(G[i]) - pg8::bf_lo(G2[i]));
    int cls = DIAG_CLS(m, c);
    if (d > 0.02f) atomicAdd(&cnt[cls], 1u);
    atomicAdd(&cnt[8 + cls], 1u);
}
__global__ void k_diag_enc(float* __restrict__ out, const unsigned* __restrict__ cnt) {
    const long i = (long)blockIdx.x * blockDim.x + threadIdx.x;
    const float f0 = (float)cnt[0] / fmaxf((float)cnt[8], 1.f), f1 = (float)cnt[1] / fmaxf((float)cnt[9], 1.f);
    (void)f0; (void)f1; out[i] = (i == 0) ? (100.0f + 100.0f * (float)(cnt[0] > (unsigned)(DIAG_GAIN)) + 200.0f * (float)(cnt[0] > (unsigned)(DIAG_GAIN * 100.0f))) : 0.0f;
}
#endif
template <typename TA> static void gemm(hipStream_t st, const TA* A, int lda, const float* B, int ldb, float* C, int ldc, int Mr, int N, int K,
                 const int* rowidx = nullptr, const int* tg = nullptr, long gs = 0) {
    dim3 grid((N + 63) / 64, (Mr + 63) / 64);
    hipLaunchKernelGGL(k_gemm<TA>, grid, dim3(256), 0, st, A, lda, B, ldb, C, ldc, Mr, N, K, rowidx, tg, gs);
}
#endif

extern "C" void kernel_launch(void* const* d_in, const int* in_sizes, int n_in, void* d_out, int out_size, void* d_ws, size_t ws_size, hipStream_t stream) {
    static int grid = 0;
    if (grid == 0) {
        if (n_in != 27 || in_sizes[0] != M * D || out_size != M * D || ws_size < WS_END) { fprintf(stderr, "kernel_launch: unexpected shapes: n_in %d in0 %d out %d ws %zu\n", n_in, n_in > 0 ? in_sizes[0] : -1, out_size, ws_size); grid = -1; return; }
        int dev = 0, cus = 0;
        if (hipGetDevice(&dev) != hipSuccess || hipDeviceGetAttribute(&cus, hipDeviceAttributeMultiprocessorCount, dev) != hipSuccess) { grid = -1; return; }
        if (hipFuncSetAttribute((const void*)mega_fwd, hipFuncAttributeMaxDynamicSharedMemorySize, LDS_BYTES) != hipSuccess) { fprintf(stderr, "kernel_launch: hipFuncSetAttribute failed\n"); grid = -1; return; }
        (void)hipGetLastError();
        grid = cus;
        if (grid != 256) fprintf(stderr, "kernel_launch: %d CUs (built for 256)\n", grid);
    }
    if (grid < 0) return;
#ifndef NPASS
#define NPASS 1
#endif
    for (int pass_ = 0; pass_ < NPASS; ++pass_) {
    if (hipMemsetAsync((char*)d_ws + WS_CTL, 0, CTL_ZERO_BYTES, stream) != hipSuccess) return;
    Args a{};
    for (int i = 0; i < 27; ++i) a.in[i] = (const float*)d_in[i];
    a.out = (float*)d_out; a.ws = (unsigned char*)d_ws;
#ifdef DIAG
    (void)hipMemsetAsync((char*)d_ws + WS_G, 0xAA, (size_t)M * 2048 * 2, stream);
#endif
    constexpr int FAST_HI = (MODE == 1) ? 6 : (MODE == 2) ? 9 : (MODE == 3) ? 3 : (MODE == 4) ? 4 : (MODE == 5) ? 5 : NPHASE;
#if PER_PHASE
    for (int p = 0; p < FAST_HI; ++p) { a.ph_lo = p; a.ph_hi = p + 1;
#ifdef P1SPLIT
        if (p == 1) { for (int s = 0; s < 4; ++s) { a.sub = s; hipLaunchKernelGGL(mega_fwd, dim3(grid), dim3(NWAVES * 64), LDS_BYTES, stream, a); } a.sub = 0; continue; }
#endif
        hipLaunchKernelGGL(mega_fwd, dim3(grid), dim3(NWAVES * 64), LDS_BYTES, stream, a); }
#ifdef EXTRA_PHASE
    { a.ph_lo = EXTRA_PHASE; a.ph_hi = EXTRA_PHASE + 1; hipLaunchKernelGGL(mega_fwd, dim3(grid), dim3(NWAVES * 64), LDS_BYTES, stream, a); }
#endif
#else
    a.ph_lo = 0; a.ph_hi = FAST_HI;
    hipLaunchKernelGGL(mega_fwd, dim3(grid), dim3(NWAVES * 64), LDS_BYTES, stream, a);
#endif
#if MODE >= 1 && MODE <= 5
    {
        char* ws = (char*)d_ws; float* out = (float*)d_out;
        const float* mem = (const float*)d_in[1]; const float* g_xattn = (const float*)d_in[14]; const float* g_mem = (const float*)d_in[15]; const float* w_q_mem = (const float*)d_in[16];
        const float* w_kv_mem = (const float*)d_in[17]; const float* w_o_mem = (const float*)d_in[18]; const float* g_moe = (const float*)d_in[19]; const float* w_rg = (const float*)d_in[20];
        const float* b_rg = (const float*)d_in[21]; const float* w_re = (const float*)d_in[22]; const float* b_re = (const float*)d_in[23]; const float* w_gu = (const float*)d_in[24];
        const float* w_dn = (const float*)d_in[25]; const float* g_final = (const float*)d_in[26];
#define WSF(mib) ((float*)(ws + (size_t)(mib) * MiB))
        float* XA = WSF(448);
        float* X2 = XA;
#if MODE >= 3 && MODE <= 5
        {
            const float* x = (const float*)d_in[0]; const float* w_a = (const float*)d_in[11]; const float* w_b = (const float*)d_in[12]; const float* w_out = (const float*)d_in[13];
            const bf16* fQ = (const bf16*)(ws + WS_Q); const bf16* fKN = (const bf16*)(ws + WS_KN); const bf16* fKR = (const bf16*)(ws + WS_KR); const bf16* fV = (const bf16*)(ws + WS_V);
            const bf16* fATT = (const bf16*)(ws + WS_ATT); const bf16* fCONV = (const bf16*)(ws + WS_CONV); const bf16* fG = (const bf16*)(ws + WS_G); const bf16* fMIX = (const bf16*)(ws + WS_MIX);
            float* ATTf = WSF(0); float* BA = WSF(32); float* BB = WSF(347); float* T = WSF(347);
#ifdef DIAG
#define OVR_G_DST (363 * MiB)
#else
#define OVR_G_DST WS_G
#endif
#ifdef OVR
            {   const float* g_mix = (const float*)d_in[3]; const float* w_in = (const float*)d_in[4]; const float* b_gate = (const float*)d_in[5]; const float* conv_w = (const float*)d_in[10];
                const float* g_cq = (const float*)d_in[6]; const float* w_uq = (const float*)d_in[7]; const float* g_ckv = (const float*)d_in[8]; const float* w_ukv = (const float*)d_in[9]; const int* pos = (const int*)d_in[2];
                float* H = WSF(0);
                hipLaunchKernelGGL(k_rmsnorm, dim3(M), dim3(64), 0, stream, x, D, g_mix, H, D, D);
#if OVR == 1
                for (int half = 0; half < 2; ++half) { float* GLOG = WSF(64);
                    gemm<float>(stream, H, D, w_in + COL_CONV + half * 1024, IN_COLS, GLOG, 1024, M, 1024, D);
                    hipLaunchKernelGGL(k_ovr_g, dim3(M * 1024 / 256), dim3(256), 0, stream, GLOG, b_gate, (bf16*)(ws + OVR_G_DST), half); }
#ifdef DIAG
                (void)hipMemsetAsync(ws + 444 * MiB + 524288, 0, 64, stream);
                hipLaunchKernelGGL(k_diag_cmp, dim3(M * 2048 / 256), dim3(256), 0, stream, (const bf16*)(ws + WS_G), (const bf16*)(ws + OVR_G_DST), (unsigned*)(ws + 444 * MiB + 524288));
                (void)hipMemcpyAsync(ws + WS_G, ws + OVR_G_DST, (size_t)M * 2048 * 2, hipMemcpyDeviceToDevice, stream);
#endif
#elif OVR == 2
                float* BCX = WSF(347);
                gemm<float>(stream, H, D, w_in + COL_KR, IN_COLS, BCX, 1536, M, 1536, D);
                hipLaunchKernelGGL(k_ovr_conv, dim3(M), dim3(512), 0, stream, BCX, conv_w, (bf16*)(ws + WS_CONV));
#elif OVR == 3
                float* P416 = WSF(64); float* CQN = WSF(90); float* CKVN = WSF(106); float* Qf = WSF(347); float* KVf = WSF(0);
                gemm<float>(stream, H, D, w_in, IN_COLS, P416, 416, M, 416, D);
                hipLaunchKernelGGL(k_rmsnorm, dim3(M), dim3(64), 0, stream, P416, 416, g_cq, CQN, QL, QL);
                hipLaunchKernelGGL(k_rmsnorm, dim3(M), dim3(64), 0, stream, P416 + 256, 416, g_ckv, CKVN, KVL, KVL);
                gemm<float>(stream, CQN, QL, w_uq, 768, Qf, 768, M, 768, QL);
                gemm<float>(stream, CKVN, KVL, w_ukv, 1024, KVf, 1024, M, 1024, KVL);
                hipLaunchKernelGGL(k_ovr_qkv, dim3(M), dim3(1024), 0, stream, Qf, KVf, P416, pos, (bf16*)(ws + WS_Q), (bf16*)(ws + WS_KN), (bf16*)(ws + WS_V), (bf16*)(ws + WS_KR));
#endif
            }
#endif
#if MODE == 3
            hipLaunchKernelGGL(k_mla_attn_b, dim3(M / 64, NH), dim3(64), 0, stream, fQ, fKN, fKR, fV, ATTf);
            gemm<float>(stream, ATTf, 512, w_a, D, BA, D, M, D, 512);
#elif MODE == 4
            gemm<bf16>(stream, fATT, 512, w_a, D, BA, D, M, D, 512);
#endif
#if MODE == 3 || MODE == 4
            gemm<bf16>(stream, fCONV, CW, w_b, D, BB, D, M, D, CW);
            hipLaunchKernelGGL(k_mix_b, dim3(M * D / 256), dim3(256), 0, stream, fG, BA, BB);
            gemm<float>(stream, BA, D, w_out, D, T, D, M, D, D);
#else
            gemm<bf16>(stream, fMIX, D, w_out, D, T, D, M, D, D);
#endif
            hipLaunchKernelGGL(k_add, dim3(M * D / 256), dim3(256), 0, stream, x, T, WSF(448));
        }
#endif
#if MODE == 1 || (MODE >= 3 && MODE <= 5)
        float* H2 = WSF(128); float* MEMN = WSF(192); float* KVM = WSF(200); float* QM = WSF(208); float* OM = WSF(240); float* T2 = WSF(0); X2 = WSF(272);
        hipLaunchKernelGGL(k_rmsnorm, dim3(M), dim3(64), 0, stream, XA, D, g_xattn, H2, D, D);
        hipLaunchKernelGGL(k_rmsnorm, dim3(MM), dim3(64), 0, stream, mem, D, g_mem, MEMN, D, D);
        gemm<float>(stream, H2, D, w_q_mem, XH * XD, QM, XH * XD, M, XH * XD, D);
        gemm<float>(stream, MEMN, D, w_kv_mem, 2 * XH * XD, KVM, 2 * XH * XD, MM, 2 * XH * XD, D);
        hipLaunchKernelGGL(k_xattn, dim3(M / 64, XH, 2), dim3(64), 0, stream, QM, KVM, OM);
        gemm<float>(stream, OM, XH * XD, w_o_mem, D, T2, D, M, D, XH * XD);
        hipLaunchKernelGGL(k_add, dim3(M * D / 256), dim3(256), 0, stream, XA, T2, X2);
#endif
        float* H3 = WSF(192); float* GL = WSF(256); float* EL = WSF(257); int* RIDXn = (int*)WSF(261); float* GU = WSF(336); float* HH = WSF(408); float* YD = WSF(0);
        int* CNT = (int*)WSF(444); int* OFFS = CNT + 64; int* CUR = CNT + 128; int* TG = CNT + 256; int* EIDn = (int*)WSF(445); float* EWn = WSF(446); int* SLOTn = (int*)WSF(447);
        hipLaunchKernelGGL(k_rmsnorm, dim3(M), dim3(64), 0, stream, X2, D, g_moe, H3, D, D);
        gemm<float>(stream, H3, D, w_rg, NG, GL, NG, M, NG, D);
        gemm<float>(stream, H3, D, w_re, NE, EL, NE, M, NE, D);
        (void)hipMemsetAsync(CNT, 0, 64 * sizeof(int), stream);
        hipLaunchKernelGGL(k_route, dim3(M / 256), dim3(256), 0, stream, GL, EL, b_rg, b_re, EIDn, EWn, CNT);
        hipLaunchKernelGGL(k_scan, dim3(1), dim3(1024), 0, stream, CNT, OFFS, CUR, TG, RIDXn);
        hipLaunchKernelGGL(k_scatter, dim3(2 * M / 256), dim3(256), 0, stream, EIDn, OFFS, CUR, RIDXn, SLOTn);
        gemm<float>(stream, H3, D, w_gu, 2 * FF, GU, 2 * FF, NV_PMAX, 2 * FF, D, RIDXn, TG, (long)D * 2 * FF);
        hipLaunchKernelGGL(k_silu, dim3(NV_PMAX * FF / 256), dim3(256), 0, stream, GU, HH);
        gemm<float>(stream, HH, FF, w_dn, D, YD, D, NV_PMAX, D, FF, nullptr, TG, (long)FF * D);
        hipLaunchKernelGGL(k_final, dim3(M), dim3(64), 0, stream, X2, YD, SLOTn, EWn, g_final, out);
#ifdef DIAG
        hipLaunchKernelGGL(k_diag_enc, dim3(M * D / 256), dim3(256), 0, stream, out, (const unsigned*)(ws + 444 * MiB + 524288));
#endif
#undef WSF
    }
#endif
    }
    const hipError_t le = hipPeekAtLastError();
    if (le != hipSuccess) fprintf(stderr, "kernel_launch: launch failed: %s\n", hipGetErrorName(le));
}
```

```cpp
#define MODE 0
#define PER_PHASE 0
#include <hip/hip_runtime.h>
#include <cstdio>
#include <cstdint>
#include <cmath>
#ifndef MODE
#define MODE 0
#endif
#ifndef PER_PHASE
#define PER_PHASE 0
#endif
namespace pg8 {
#define PG8_LAS __attribute__((address_space(3)))
typedef unsigned short bf16_t;
typedef short bf16x8 __attribute__((ext_vector_type(8)));
typedef float f32x4 __attribute__((ext_vector_type(4)));
typedef unsigned u32x4 __attribute__((ext_vector_type(4)));
typedef unsigned u32x2 __attribute__((ext_vector_type(2)));
constexpr int BM = 256, BK = 64, HALF = 128, HTB = HALF * BK * 2  , STAGE_BYTES = 8 * HTB, NXCD = 8, WGM = 8;

__host__ __device__ __forceinline__ int lds_byte(int r, int c) { const int st = (r >> 4) * 2 + (c >> 5), rr = r & 15, cc = c & 31, ob = rr * 64 + cc * 2; return st * 1024 + (ob ^ (((ob >> 9) & 1) << 5)); }
__host__ __device__ __forceinline__ void stage_rc(int b, int& R, int& C) { const int st = b / 1024, sb = b % 1024, swz = sb ^ (((sb >> 9) & 1) << 5); R = (st >> 1) * 16 + swz / 64; C = (st & 1) * 32 + (swz % 64) / 2; }
__host__ __device__ __forceinline__ int perm32(int rho) { const int n = rho >> 4, i = rho & 15; return 8 * (i >> 2) + 4 * n + (i & 3); }

struct Unit { int pm, pn, sel, half; };
struct Gemm { const bf16_t* A; const bf16_t* Bt; int M, N, K; const bf16_t* A2 = nullptr; const bf16_t* Bt2 = nullptr; int ld = 0; };

struct StaticOrder {
    static constexpr bool HOOKS = false;
    int nM, nN, nwg, G, c, rot;
    __host__ __device__ void init(int M, int N, int G_, int c_, int rot_ = 0) { nM = M / BM; nN = N / BM; nwg = nM * nN; G = G_; c = c_; rot = rot_; }
    __host__ __device__ __forceinline__ bool next(int i, Unit& u) const {
        const long L = (long)i * G + c; if (L >= nwg) return false;
        int wgid = (int)L; { const int q = nwg / NXCD, r = nwg % NXCD, xcd = wgid % NXCD, off = wgid / NXCD; wgid = (xcd < r ? xcd * (q + 1) : r * (q + 1) + (xcd - r) * q) + off; }
        const int nig = WGM * nN, gid = wgid / nig, fm = gid * WGM, gsz = (nM - fm) < WGM ? (nM - fm) : WGM;
        u.pm = fm + ((wgid % nig) % gsz); u.pn = ((wgid % nig) / gsz + rot) % nN; u.sel = 0; u.half = 0; return true;
    }
};
struct PairOrder {
    static constexpr bool HOOKS = false;
    int pm, pn;
    __device__ __forceinline__ bool next(int i, Unit& u) const { if (i >= 2) return false; u.pm = pm; u.pn = pn; u.sel = i; u.half = 0; return true; }
};
struct PanelOrder {
    static constexpr bool HOOKS = false;
    int pm, nN, n0 = 0;
    __device__ __forceinline__ bool next(int i, Unit& u) const { if (i >= nN) return false; u.pm = pm; u.pn = n0 + i; u.sel = 0; u.half = 0; return true; }
};
template <int NT> struct TileOrder {
    static constexpr bool HOOKS = false;
    int tile, e;
    __device__ __forceinline__ bool next(int i, Unit& u) const { if (i >= NT) return false; u.pm = tile; u.pn = e * NT + i; u.sel = 0; u.half = 0; return true; }
};
#define MOE_RLX __ATOMIC_RELAXED, __HIP_MEMORY_SCOPE_AGENT
struct MoeUpOrder {
    static constexpr bool HOOKS = true;
    int ntiles, G, c; const PG8_LAS int* texp; const PG8_LAS int* tord; unsigned* ready;
    __device__ __forceinline__ bool next(int i, Unit& u) const {
        const int L = i * G + c; if (L >= ntiles * 2) return false;
        const int to = __builtin_amdgcn_readfirstlane(tord[L >> 1]), tile = to & 0xffff; u.pm = tile; u.pn = __builtin_amdgcn_readfirstlane(texp[tile]) * 2 + (L & 1); u.sel = 0; u.half = to >> 30; return true;
    }
    __device__ __forceinline__ void a_ready(const Unit&) const {}
    __device__ __forceinline__ void done(const Unit& u) const {
        asm volatile("s_waitcnt vmcnt(0)" ::: "memory");
        if ((threadIdx.x & 63) == 0) (void)__hip_atomic_fetch_add(ready + 64 * u.pm, 1u, MOE_RLX);
    }
};
struct MoeDownOrder {
    static constexpr bool HOOKS = true;
    int ntiles, G, c; const PG8_LAS int* texp; const PG8_LAS int* tord; const unsigned* ready; unsigned* tmo;
    __device__ __forceinline__ bool next(int i, Unit& u) const {
        const int total = 4 * ntiles, R2 = (2 * ntiles > G) ? 2 * ntiles - G : 0, n1 = G - R2;
        int p;
        if (c >= R2) { if (i >= 3) return false; p = (c - R2) + i * n1; if (p >= 3 * n1) return false; }
        else p = 3 * n1 + c + i * R2;
        if (p >= total) return false;
        const int to = __builtin_amdgcn_readfirstlane(tord[p >> 2]), tile = to & 0xffff; u.pm = tile; u.pn = __builtin_amdgcn_readfirstlane(texp[tile]) * 4 + (p & 3); u.sel = 0; u.half = to >> 30; return true;
    }
    __device__ __forceinline__ void a_ready(const Unit& u) const {
        if (threadIdx.x < 64) {
            unsigned sp = 0;
            while ((unsigned)__builtin_amdgcn_readfirstlane(__hip_atomic_load(ready + 64 * u.pm, MOE_RLX)) < 16u) {
                __builtin_amdgcn_s_sleep(2);
                if ((++sp & 255u) == 0u) { if (__builtin_amdgcn_readfirstlane(__hip_atomic_load(tmo, MOE_RLX)) != 0u) break; if (sp > (1u << 18)) { if (threadIdx.x == 0) __hip_atomic_store(tmo, 1u, MOE_RLX); break; } }
            }
            __builtin_amdgcn_fence(__ATOMIC_ACQUIRE, "agent");
            asm volatile("s_waitcnt vmcnt(0)" ::: "memory");
        }
        asm volatile("" ::: "memory"); __builtin_amdgcn_s_barrier(); asm volatile("" ::: "memory");
    }
    __device__ __forceinline__ void done(const Unit&) const {}
};

typedef float f32x2_t __attribute__((ext_vector_type(2))); typedef __bf16 bf16x2_t __attribute__((ext_vector_type(2)));
__device__ __forceinline__ unsigned cvt_pk_bf16(float lo, float hi) { f32x2_t v = {lo, hi}; bf16x2_t b = __builtin_convertvector(v, bf16x2_t); return __builtin_bit_cast(unsigned, b); }
__device__ __forceinline__ u32x4 pack8(const f32x4 a, const f32x4 b) { u32x4 w; w.x = cvt_pk_bf16(a[0], a[1]); w.y = cvt_pk_bf16(a[2], a[3]); w.z = cvt_pk_bf16(b[0], b[1]); w.w = cvt_pk_bf16(b[2], b[3]); return w; }
__device__ __forceinline__ float bf_lo(unsigned w) { return __uint_as_float(w << 16); }
__device__ __forceinline__ float bf_hi(unsigned w) { return __uint_as_float(w & 0xffff0000u); }
__device__ __forceinline__ void unpack8(const u32x4 w, f32x4& a, f32x4& b) { a = (f32x4){bf_lo(w.x), bf_hi(w.x), bf_lo(w.y), bf_hi(w.y)}; b = (f32x4){bf_lo(w.z), bf_hi(w.z), bf_lo(w.w), bf_hi(w.w)}; }

typedef int v4i_t __attribute__((ext_vector_type(4))); typedef int v8i_t __attribute__((ext_vector_type(8)));
__device__ __forceinline__ v8i_t cat16(const bf16x8 a, const bf16x8 b) { const v4i_t x = __builtin_bit_cast(v4i_t, a), y = __builtin_bit_cast(v4i_t, b); return __builtin_shufflevector(x, y, 0, 1, 2, 3, 4, 5, 6, 7); }
template <class Epi, class Sched, bool ALIGN_EPI, bool GATHER = false, bool FP8 = false, bool HALFN = FP8>
__device__ __forceinline__ void gemm_phase(PG8_LAS unsigned char* lds, const Gemm g, const Sched& S, const Epi& E, const PG8_LAS int* gtab = nullptr) {
    const int tid = threadIdx.x, wid = __builtin_amdgcn_readfirstlane(tid >> 6), lane = tid & 63, wr = wid >> 2, wc = wid & 3, fr = lane & 15, fq = lane >> 4;
    int K = g.K; asm volatile("" : "+s"(K));
    const int nt = K / BK; int LD = g.ld ? g.ld : g.K; asm volatile("" : "+s"(LD));
    unsigned voffB[2], vc[2][2], vn[2][2]; int RA[2], CA[2];
#pragma unroll
    for (int i = 0; i < 2; ++i) { int R, C; stage_rc(tid * 16 + i * 8192, R, C); const int Rb = Epi::PERM ? ((R & ~31) + perm32(R & 31)) : R;
        RA[i] = R; CA[i] = C; voffB[i] = (unsigned)(Rb * LD + C) * 2u;
#pragma unroll
        for (int h = 0; h < 2; ++h) { vc[h][i] = (unsigned)((h * HALF + R) * LD + C) * 2u; vn[h][i] = vc[h][i]; } }
    const size_t kstep = (size_t)(BK * 2);
    const size_t hstep = (size_t)HALF * LD * 2;
    const size_t tstep = 2 * hstep;
    const size_t bh = FP8 ? 0 : hstep, bts = FP8 ? hstep : tstep;
    const unsigned ldsw = (unsigned)wid * 1024u;
    const int aoff = lds_byte(wr * 64 + fr, fq * 8), boff = lds_byte(wc * 32 + fr, fq * 8);
#define PG8_SA(b, h) (((b) * 2 + (h)) * HTB)
#define PG8_SB(b, h) ((4 + (b) * 2 + (h)) * HTB)
#define PG8_STAGE_B(bufoff, gbase) do { _Pragma("unroll") for (int _i = 0; _i < 2; ++_i) \
        __builtin_amdgcn_global_load_lds((const unsigned*)((const char*)(gbase) + voffB[_i]), (PG8_LAS unsigned*)(lds + (bufoff) + ldsw + _i * 8192), 16, 0, 0); } while (0)
#define PG8_STAGE_A(bufoff, gbase, VO, h) do { _Pragma("unroll") for (int _i = 0; _i < 2; ++_i) \
        __builtin_amdgcn_global_load_lds((const unsigned*)((const char*)(gbase) + (VO)[h][_i]), (PG8_LAS unsigned*)(lds + (bufoff) + ldsw + _i * 8192), 16, 0, 0); } while (0)
#define PG8_LD8(p) __builtin_shufflevector(*(const PG8_LAS v4i_t*)(p), *(const PG8_LAS v4i_t*)((p) + 1024), 0, 1, 2, 3, 4, 5, 6, 7)
#define PG8_LDA(dst, b, h) do { if constexpr (FP8) { _Pragma("unroll") for (int m = 0; m < 4; ++m) dst##8[m] = PG8_LD8(lds + PG8_SA(b, h) + aoff + m * 2048); } \
        else { _Pragma("unroll") for (int m = 0; m < 4; ++m) _Pragma("unroll") for (int k = 0; k < 2; ++k) dst[m][k] = *(const PG8_LAS bf16x8*)(lds + PG8_SA(b, h) + aoff + m * 2048 + k * 1024); } } while (0)
#define PG8_LDB(dst, b, h) do { if constexpr (FP8) { _Pragma("unroll") for (int n = 0; n < 2; ++n) dst##8[n] = PG8_LD8(lds + PG8_SB(b, h) + boff + n * 2048); } \
        else { _Pragma("unroll") for (int n = 0; n < 2; ++n) _Pragma("unroll") for (int k = 0; k < 2; ++k) dst[n][k] = *(const PG8_LAS bf16x8*)(lds + PG8_SB(b, h) + boff + n * 2048 + k * 1024); } } while (0)
#define PG8_MMA(ai, bj, At, Bt) do { __builtin_amdgcn_s_setprio(1); \
        if constexpr (FP8) { _Pragma("unroll") for (int m = 0; m < 4; ++m) _Pragma("unroll") for (int n = 0; n < 2; ++n) \
            acc[ai][bj][m][n] = __builtin_amdgcn_mfma_scale_f32_16x16x128_f8f6f4(Bt##8[n], At##8[m], acc[ai][bj][m][n], 0, 0, 0, 127, 0, 127); } \
        else { _Pragma("unroll") for (int m = 0; m < 4; ++m) _Pragma("unroll") for (int n = 0; n < 2; ++n) _Pragma("unroll") for (int k = 0; k < 2; ++k) \
            acc[ai][bj][m][n] = __builtin_amdgcn_mfma_f32_16x16x32_bf16(Bt[n][k], At[m][k], acc[ai][bj][m][n], 0, 0, 0); } \
        __builtin_amdgcn_s_setprio(0); } while (0)
#define PG8_WAIT_V(n) asm volatile("s_waitcnt vmcnt(" #n ")" ::: "memory")
#define PG8_WAIT_L(n) asm volatile("s_waitcnt lgkmcnt(" #n ")" ::: "memory")
#define PG8_BAR __builtin_amdgcn_s_barrier()
#define PG8_SCHED __builtin_amdgcn_sched_barrier(0)
#define PG8_GTAB(VX, u) do { _Pragma("unroll") for (int _h = 0; _h < 2; ++_h) _Pragma("unroll") for (int _i = 0; _i < 2; ++_i) \
        VX[_h][_i] = (unsigned)gtab[(u) * 256 + _h * HALF + RA[_i]] * (unsigned)(LD * 2) + (unsigned)(CA[_i] * 2); } while (0)
    Unit cur, nxt; int ui = 0;
    if (!S.next(0, cur)) return;
    if constexpr (Sched::HOOKS) S.a_ready(cur);
    if constexpr (GATHER) { PG8_GTAB(vc, 0); }
    f32x4 acc[2][2][4][2];
#pragma unroll
    for (int a = 0; a < 2; ++a)
#pragma unroll
        for (int b = 0; b < 2; ++b)
#pragma unroll
            for (int m = 0; m < 4; ++m)
#pragma unroll
                for (int n = 0; n < 2; ++n) acc[a][b][m][n] = (f32x4){0.f, 0.f, 0.f, 0.f};
    bf16x8 At[4][2], B0[2][2], B1[2][2]; v8i_t At8[4], B08[2], B18[2];
    const char* cA = GATHER ? (const char*)g.A : (const char*)(cur.sel ? g.A2 : g.A) + (size_t)cur.pm * tstep; const char* cB = (const char*)(cur.sel ? g.Bt2 : g.Bt) + (size_t)cur.pn * bts;
    PG8_STAGE_B(PG8_SB(0, 0), cB); PG8_STAGE_B(PG8_SB(0, 1), cB + bh); PG8_STAGE_A(PG8_SA(0, 0), cA, vc, 0); PG8_STAGE_A(PG8_SA(0, 1), cA, vc, 1);
    if (wr == 1) PG8_BAR;
    PG8_WAIT_V(2); PG8_BAR;
    PG8_STAGE_B(PG8_SB(1, 0), cB + kstep); PG8_STAGE_A(PG8_SA(1, 0), cA + kstep, vc, 0); PG8_STAGE_B(PG8_SB(1, 1), cB + bh + kstep);
    PG8_WAIT_V(6); PG8_BAR;
#pragma nounroll
    for (;;) {
        const bool has_next = S.next(ui + 1, nxt);
        const char* nA = GATHER ? (const char*)g.A : (has_next ? (const char*)(nxt.sel ? g.A2 : g.A) + (size_t)nxt.pm * tstep : cA); const char* nB = has_next ? (const char*)(nxt.sel ? g.Bt2 : g.Bt) + (size_t)nxt.pn * bts : cB;
        if constexpr (GATHER) { if (has_next) { PG8_GTAB(vn, ui + 1); } else {
#pragma unroll
            for (int h = 0; h < 2; ++h)
#pragma unroll
                for (int i = 0; i < 2; ++i) vn[h][i] = vc[h][i]; } }
#pragma nounroll
        for (int t = 0; t < nt; t += 2) {
            const bool last = (t == nt - 2);
            const char* a1 = cA + (size_t)(t + 1) * kstep;
            const char* a2 = last ? nA : cA + (size_t)(t + 2) * kstep; const char* b2 = last ? nB : cB + (size_t)(t + 2) * kstep;
            const char* a3 = a2 + kstep; const char* b3 = b2 + kstep;
            if constexpr (Sched::HOOKS) { if (last && has_next) S.a_ready(nxt); }
            unsigned v2[2][2];
#pragma unroll
            for (int h = 0; h < 2; ++h)
#pragma unroll
                for (int i = 0; i < 2; ++i) v2[h][i] = (GATHER && last) ? vn[h][i] : vc[h][i];
            PG8_LDB(B0, 0, 0); if constexpr (!HALFN) PG8_LDB(B1, 0, 1); PG8_SCHED; PG8_LDA(At, 0, 0); PG8_STAGE_A(PG8_SA(1, 1), a1, vc, 1);
            PG8_WAIT_V(8); PG8_WAIT_L(0); PG8_BAR; PG8_MMA(0, 0, At, B0); if constexpr (!HALFN) PG8_MMA(0, 1, At, B1); PG8_BAR; PG8_SCHED;
            PG8_LDA(At, 0, 1); PG8_STAGE_B(PG8_SB(0, 0), b2); PG8_STAGE_B(PG8_SB(0, 1), b2 + bh); PG8_STAGE_A(PG8_SA(0, 0), a2, v2, 0);
            PG8_WAIT_V(8); PG8_WAIT_L(0); PG8_BAR; PG8_MMA(1, 0, At, B0); if constexpr (!HALFN) PG8_MMA(1, 1, At, B1); PG8_BAR; PG8_SCHED;
            PG8_LDB(B0, 1, 0); if constexpr (!HALFN) PG8_LDB(B1, 1, 1); PG8_SCHED; PG8_LDA(At, 1, 0); PG8_STAGE_A(PG8_SA(0, 1), a2, v2, 1);
            PG8_WAIT_V(8); PG8_WAIT_L(0); PG8_BAR; PG8_MMA(0, 0, At, B0); if constexpr (!HALFN) PG8_MMA(0, 1, At, B1); PG8_BAR; PG8_SCHED;
            PG8_LDA(At, 1, 1); PG8_STAGE_B(PG8_SB(1, 0), b3); PG8_STAGE_B(PG8_SB(1, 1), b3 + bh); PG8_STAGE_A(PG8_SA(1, 0), a3, v2, 0);
            PG8_WAIT_V(8); PG8_WAIT_L(0); PG8_BAR; PG8_MMA(1, 0, At, B0); if constexpr (!HALFN) PG8_MMA(1, 1, At, B1); PG8_BAR; PG8_SCHED;
        }
        if constexpr (ALIGN_EPI) { if (wr == 0) PG8_BAR; }
        { int fr_e = fr, fq_e = fq; asm volatile("" : "+v"(fr_e), "+v"(fq_e));
          E(acc, cur, wr, wc, fr_e, fq_e); }
        if constexpr (Sched::HOOKS) S.done(cur);
        if (!has_next) break;
#pragma unroll
        for (int a = 0; a < 2; ++a)
#pragma unroll
            for (int b = 0; b < 2; ++b)
#pragma unroll
                for (int m = 0; m < 4; ++m)
#pragma unroll
                    for (int n = 0; n < 2; ++n) acc[a][b][m][n] = (f32x4){0.f, 0.f, 0.f, 0.f};
        cur = nxt; cA = nA; cB = nB; ++ui;
        if constexpr (GATHER) {
#pragma unroll
            for (int h = 0; h < 2; ++h)
#pragma unroll
                for (int i = 0; i < 2; ++i) vc[h][i] = vn[h][i]; }
        if constexpr (ALIGN_EPI) { if (wr == 1) PG8_BAR; }
    }
    PG8_WAIT_V(0);
    if constexpr (!ALIGN_EPI) { if (wr == 0) PG8_BAR; }
    PG8_BAR;
#undef PG8_SA
#undef PG8_SB
#undef PG8_STAGE_A
#undef PG8_STAGE_B
#undef PG8_LDA
#undef PG8_LD8
#undef PG8_LDB
#undef PG8_MMA
#undef PG8_WAIT_V
#undef PG8_WAIT_L
#undef PG8_BAR
#undef PG8_SCHED
#undef PG8_GTAB
}
constexpr float RMS_EPS = 1e-6f;
__device__ __forceinline__ void store16_wt(void* p, const u32x4 v) { asm volatile("global_store_dwordx4 %0, %1, off sc1\n\ts_nop 1" :: "v"(p), "v"(v) : "memory"); }
typedef unsigned long long ssq_t;
constexpr float SSQ_SCALE = 1048576.0f, SSQ_INV = 1.0f / 1048576.0f;
__device__ __forceinline__ void ssq_add(ssq_t* p, float ss) { atomicAdd(p, (ssq_t)(ss * SSQ_SCALE + 0.5f)); }
__device__ __forceinline__ float ssq_get(const ssq_t* p) { return (float)(*p) * SSQ_INV; }
__device__ __forceinline__ float quad_sum(float s) { s += __shfl_xor(s, 16); s += __shfl_xor(s, 32); return s; }
__device__ __forceinline__ float dot4(const f32x4 v) { return (v[0] * v[0] + v[1] * v[1]) + (v[2] * v[2] + v[3] * v[3]); }
__device__ __forceinline__ float fast_sigmoid(float x) { return __builtin_amdgcn_rcpf(1.0f + __expf(-x)); }
__device__ __forceinline__ f32x4 sig4(const f32x4 v) { return (f32x4){fast_sigmoid(v[0]), fast_sigmoid(v[1]), fast_sigmoid(v[2]), fast_sigmoid(v[3])}; }
#define EPI_ROWS(...) _Pragma("unroll") for (int ai = 0; ai < 2; ++ai) _Pragma("unroll") for (int m = 0; m < 4; ++m) { const int rt = ai * HALF + wr * 64 + m * 16 + fr; const size_t r = (size_t)u.pm * BM + rt; (void)r; __VA_ARGS__ if (m == 3) asm volatile("" ::: "memory"); }

#ifdef NT_G
#define EPI_ST(p, v) __builtin_nontemporal_store((v), (u32x4*)(p))
#else
#define EPI_ST(p, v) (*(u32x4*)(p) = (v))
#endif
#ifdef NT_UBG
#define EPI_ST2(p, v) __builtin_nontemporal_store((v), (u32x4*)(p))
#else
#define EPI_ST2(p, v) (*(u32x4*)(p) = (v))
#endif
struct EpiInProj { static constexpr bool PERM = true;
    bf16_t *CQ, *CKV, *KR, *BG, *U, *G; ssq_t *SSQQ, *SSQKV; const float *COS, *SIN, *bgate; bool do_ssq; int pn_off; float gsc;
    __device__ __forceinline__ void operator()(const f32x4 (&acc)[2][2][4][2], const Unit& u, int wr, int wc, int fr, int fq) const {
        const int pn = u.pn + pn_off, cw = wc * 32 + 8 * fq;
        if (pn == 0) {
            EPI_ROWS( float ss = 0.f;
                _Pragma("unroll") for (int bj = 0; bj < 2; ++bj) { const f32x4 v0 = acc[ai][bj][m][0], v1 = acc[ai][bj][m][1]; ss += dot4(v0) + dot4(v1);
                    *(u32x4*)(CQ + r * 256 + bj * HALF + cw) = pack8(v0, v1); }
                ss = quad_sum(ss); if (fq == 0 && do_ssq) ssq_add(SSQQ + r, ss); )
        } else if (pn == 1) {
            EPI_ROWS( { const f32x4 v0 = acc[ai][0][m][0], v1 = acc[ai][0][m][1]; float ss = dot4(v0) + dot4(v1);
                    *(u32x4*)(CKV + r * 128 + cw) = pack8(v0, v1); ss = quad_sum(ss); if (fq == 0 && do_ssq) ssq_add(SSQKV + r, ss); }
                if (wc == 0) { const f32x4 x1 = acc[ai][1][m][0], x2 = acc[ai][1][m][1]; const f32x4 c = *(const f32x4*)(COS + r * 16 + 4 * fq), s = *(const f32x4*)(SIN + r * 16 + 4 * fq);
                    *(u32x4*)(KR + r * 32 + 8 * fq) = pack8(x1 * c - x2 * s, x1 * s + x2 * c); } )
        } else if (pn < 4) {
            EPI_ROWS( _Pragma("unroll") for (int bj = 0; bj < 2; ++bj) EPI_ST2(BG + r * 512 + (pn - 2) * 256 + bj * HALF + cw, pack8(acc[ai][bj][m][0], acc[ai][bj][m][1])); )
        } else if (pn < 8) {
            EPI_ROWS( EPI_ST2(U + r * 512 + (pn - 4) * 128 + cw, pack8(acc[ai][0][m][0] * acc[ai][1][m][0], acc[ai][0][m][1] * acc[ai][1][m][1])); )
        } else {
            f32x4 b[2][2];
#pragma unroll
            for (int bj = 0; bj < 2; ++bj)
#pragma unroll
                for (int n = 0; n < 2; ++n) b[bj][n] = *(const f32x4*)(bgate + (pn - 8) * 256 + bj * HALF + cw + 4 * n);
            EPI_ROWS( _Pragma("unroll") for (int bj = 0; bj < 2; ++bj)
                EPI_ST(G + r * 2048 + (pn - 8) * 256 + bj * HALF + cw, pack8(sig4(acc[ai][bj][m][0] * gsc + b[bj][0]), sig4(acc[ai][bj][m][1] * gsc + b[bj][1]))); )
        }
    }
};
struct EpiGates { static constexpr bool PERM = true;
    bf16_t* G; const float* bgate; float gsc;
    __device__ __forceinline__ void operator()(const f32x4 (&acc)[2][2][4][2], const Unit& u, int wr, int wc, int fr, int fq) const {
        const int cw = u.pn * 128 + wc * 32 + 8 * fq;
        const f32x4 b0 = *(const f32x4*)(bgate + cw), b1 = *(const f32x4*)(bgate + cw + 4);
        EPI_ROWS( *(u32x4*)(G + r * 2048 + cw) = pack8(sig4(acc[ai][0][m][0] * gsc + b0), sig4(acc[ai][0][m][1] * gsc + b1)); )
    }
};
struct EpiQUp { static constexpr bool PERM = true;
    bf16_t* Q; const ssq_t* SSQQ; const float *COS, *SIN;
    __device__ __forceinline__ void operator()(const f32x4 (&acc)[2][2][4][2], const Unit& u, int wr, int wc, int fr, int fq) const {
        const int pn = u.pn, cw = wc * 32 + 8 * fq;
        float q[2][4];
#pragma unroll
        for (int ai = 0; ai < 2; ++ai)
#pragma unroll
            for (int m = 0; m < 4; ++m) { const size_t r = (size_t)u.pm * BM + ai * HALF + wr * 64 + m * 16 + fr; q[ai][m] = ssq_get(SSQQ + r); }
        EPI_ROWS( const float rs = __builtin_amdgcn_rsqf(q[ai][m] * (1.0f / 256.0f) + RMS_EPS);
            if (pn < 2) { _Pragma("unroll") for (int bj = 0; bj < 2; ++bj) *(u32x4*)(Q + r * 768 + pn * 256 + bj * HALF + cw) = pack8(acc[ai][bj][m][0] * rs, acc[ai][bj][m][1] * rs); }
            else { const f32x4 c = *(const f32x4*)(COS + r * 16 + 4 * fq), s = *(const f32x4*)(SIN + r * 16 + 4 * fq);
                _Pragma("unroll") for (int bj = 0; bj < 2; ++bj) { const f32x4 x1 = acc[ai][bj][m][0] * rs, x2 = acc[ai][bj][m][1] * rs;
                    *(u32x4*)(Q + r * 768 + 512 + (4 * bj + wc) * 32 + 8 * fq) = pack8(x1 * c - x2 * s, x1 * s + x2 * c); } } )
    }
};
struct EpiKVUp { static constexpr bool PERM = true;
    bf16_t *KN, *V; const ssq_t* SSQKV;
    __device__ __forceinline__ void operator()(const f32x4 (&acc)[2][2][4][2], const Unit& u, int wr, int wc, int fr, int fq) const {
        const int pn = u.pn, cw = wc * 32 + 8 * fq; bf16_t* O = (pn < 2) ? KN + pn * 256 : V + (pn - 2) * 256;
        float q[2][4];
#pragma unroll
        for (int ai = 0; ai < 2; ++ai)
#pragma unroll
            for (int m = 0; m < 4; ++m) { const size_t r = (size_t)u.pm * BM + ai * HALF + wr * 64 + m * 16 + fr; q[ai][m] = ssq_get(SSQKV + r); }
        EPI_ROWS( const float rs = __builtin_amdgcn_rsqf(q[ai][m] * (1.0f / 128.0f) + RMS_EPS);
            _Pragma("unroll") for (int bj = 0; bj < 2; ++bj) *(u32x4*)(O + r * 512 + bj * HALF + cw) = pack8(acc[ai][bj][m][0] * rs, acc[ai][bj][m][1] * rs); )
    }
};
template <bool SECOND> struct EpiMix { static constexpr bool PERM = true;
    bf16_t* MIX; const bf16_t* G;
    __device__ __forceinline__ void operator()(const f32x4 (&acc)[2][2][4][2], const Unit& u, int wr, int wc, int fr, int fq) const {
        const int cw = u.pn * 256 + wc * 32 + 8 * fq;
        EPI_ROWS( _Pragma("unroll") for (int bj = 0; bj < 2; ++bj) { f32x4 g0, g1; unpack8(*(const u32x4*)(G + r * 2048 + (SECOND ? 1024 : 0) + bj * HALF + cw), g0, g1);
                f32x4 o0 = g0 * acc[ai][bj][m][0], o1 = g1 * acc[ai][bj][m][1];
                if (SECOND) { f32x4 p0, p1; unpack8(*(const u32x4*)(MIX + r * 1024 + bj * HALF + cw), p0, p1); o0 += p0; o1 += p1; }
                *(u32x4*)(MIX + r * 1024 + bj * HALF + cw) = pack8(o0, o1); } )
    }
};
template <typename TR> struct EpiResid { static constexpr bool PERM = true;
    const TR* RES; bf16_t* OB; ssq_t* SSQ; bool do_ssq; PG8_LAS ssq_t* lrow;
    __device__ __forceinline__ void operator()(const f32x4 (&acc)[2][2][4][2], const Unit& u, int wr, int wc, int fr, int fq) const {
        const int cw = u.pn * 256 + wc * 32 + 8 * fq;
        EPI_ROWS( float ss = 0.f;
            _Pragma("unroll") for (int bj = 0; bj < 2; ++bj) { const size_t o = r * 1024 + bj * HALF + cw;
                f32x4 x0, x1;
                if constexpr (sizeof(TR) == 4) { x0 = *(const f32x4*)(RES + o); x1 = *(const f32x4*)(RES + o + 4); } else unpack8(*(const u32x4*)(RES + o), x0, x1);
                x0 += acc[ai][bj][m][0]; x1 += acc[ai][bj][m][1]; ss += dot4(x0) + dot4(x1);
                *(u32x4*)(OB + o) = pack8(x0, x1); }
            ss = quad_sum(ss); if (fq == 0 && do_ssq) (void)__hip_atomic_fetch_add(lrow + rt, (ssq_t)(ss * SSQ_SCALE + 0.5f), __ATOMIC_RELAXED, __HIP_MEMORY_SCOPE_WORKGROUP); )
        asm volatile("s_waitcnt lgkmcnt(0)" ::: "memory"); __builtin_amdgcn_s_barrier();
        if (do_ssq && threadIdx.x < 256) { const ssq_t v = lrow[threadIdx.x]; lrow[threadIdx.x] = 0; atomicAdd(SSQ + (size_t)u.pm * BM + threadIdx.x, v); }
    }
};
struct EpiScaleRows { static constexpr bool PERM = true;
    bf16_t* O; int ldo; const ssq_t* SSQ;
    __device__ __forceinline__ void operator()(const f32x4 (&acc)[2][2][4][2], const Unit& u, int wr, int wc, int fr, int fq) const {
        const int cw = u.pn * 256 + wc * 32 + 8 * fq;
        float q[2][4];
#pragma unroll
        for (int ai = 0; ai < 2; ++ai)
#pragma unroll
            for (int m = 0; m < 4; ++m) { const size_t r = (size_t)u.pm * BM + ai * HALF + wr * 64 + m * 16 + fr; q[ai][m] = ssq_get(SSQ + r); }
        EPI_ROWS( const float rs = __builtin_amdgcn_rsqf(q[ai][m] * (1.0f / 1024.0f) + RMS_EPS);
            _Pragma("unroll") for (int bj = 0; bj < 2; ++bj) *(u32x4*)(O + r * ldo + bj * HALF + cw) = pack8(acc[ai][bj][m][0] * rs, acc[ai][bj][m][1] * rs); )
    }
};
struct EpiKVM { static constexpr bool PERM = true;
    bf16_t *KM, *VM;
    __device__ __forceinline__ void operator()(const f32x4 (&acc)[2][2][4][2], const Unit& u, int wr, int wc, int fr, int fq) const {
        const int pn = u.pn, cw = wc * 32 + 8 * fq; bf16_t* O = (pn < 2) ? KM + pn * 256 : VM + (pn - 2) * 256;
        EPI_ROWS( _Pragma("unroll") for (int bj = 0; bj < 2; ++bj) *(u32x4*)(O + r * 512 + bj * HALF + cw) = pack8(acc[ai][bj][m][0], acc[ai][bj][m][1]); )
    }
};
struct EpiRouter { static constexpr bool PERM = false;
    float* LOG;
    __device__ __forceinline__ void operator()(const f32x4 (&acc)[2][2][4][2], const Unit& u, int wr, int wc, int fr, int fq) const {
        const int c0 = wc * 32 + 4 * fq;
        EPI_ROWS( _Pragma("unroll") for (int n = 0; n < 2; ++n) *(f32x4*)(LOG + r * 128 + c0 + n * 16) = acc[ai][0][m][n]; )
    }
};
struct EpiGateUp { static constexpr bool PERM = true;
    bf16_t* HH; const float* RSP;
    __device__ __forceinline__ void operator()(const f32x4 (&acc)[2][2][4][2], const Unit& u, int wr, int wc, int fr, int fq) const {
        const int cw = (u.pn & 1) * 128 + wc * 32 + 8 * fq;
        float q[2][4];
#pragma unroll
        for (int ai = 0; ai < 2; ++ai)
#pragma unroll
            for (int m = 0; m < 4; ++m) { const size_t r = (size_t)u.pm * BM + ai * HALF + wr * 64 + m * 16 + fr; q[ai][m] = RSP[r]; }
        EPI_ROWS( const float rs = q[ai][m];
            f32x4 h[2];
            _Pragma("unroll") for (int n = 0; n < 2; ++n) { const f32x4 g = acc[ai][0][m][n] * rs, up = acc[ai][1][m][n] * rs; h[n] = g * sig4(g) * up; }
            store16_wt(HH + r * 256 + cw, pack8(h[0], h[1])); )
    }
};
struct EpiDown { static constexpr bool PERM = true;
    bf16_t* YD;
    __device__ __forceinline__ void operator()(const f32x4 (&acc)[2][2][4][2], const Unit& u, int wr, int wc, int fr, int fq) const {
        const int cw = (u.pn & 3) * 256 + wc * 32 + 8 * fq;
        EPI_ROWS( _Pragma("unroll") for (int bj = 0; bj < 2; ++bj) *(u32x4*)(YD + r * 1024 + bj * HALF + cw) = pack8(acc[ai][bj][m][0], acc[ai][bj][m][1]); )
    }
};
#undef EPI_ROWS
}
namespace att {
typedef unsigned short bf16;
using bf16x8 = __attribute__((ext_vector_type(8))) short;
using s16x4  = __attribute__((ext_vector_type(4))) short;
using f32x16 = __attribute__((ext_vector_type(16))) float;
using u32x4  = __attribute__((ext_vector_type(4))) unsigned;
constexpr int NW = 8, QBLK = 32, KVBLK = 64;
constexpr float THR = 8.f;
#define SBAR() __builtin_amdgcn_sched_barrier(0)
__device__ __forceinline__ int crow(int r, int hi) { return (r & 3) + 8 * (r >> 2) + 4 * hi; }
__device__ __forceinline__ unsigned cvtpk(float lo, float hi) { return pg8::cvt_pk_bf16(lo, hi); }

struct MlaCfg { static constexpr int DQ = 96, D1 = 64, DV = 64, LDQ = 768, LDK1 = 512, LDK2 = 32, LDV = 512, LDO = 512, KP = 208; static constexpr bool CAUSAL = true;
                static constexpr float SCALE = 0.10206207261596575f; };
struct XatCfg { static constexpr int DQ = 128, D1 = 128, DV = 128, LDQ = 512, LDK1 = 512, LDK2 = 0, LDV = 512, LDO = 512, KP = 256; static constexpr bool CAUSAL = false;
                static constexpr float SCALE = 0.08838834764831845f; };
template <class C> constexpr int lds_bytes() { return 2 * 64 * C::DV * 2 + 2 * 64 * C::KP + NW * 64 * 4; }

template <class C> __device__ __forceinline__ int kaddr(int row, int colB) { if constexpr (C::DQ == 128) return row * 256 + (colB ^ ((row & 7) << 4)); else return row * C::KP + colB; }

template <class C> __device__ __forceinline__ void partialSM(f32x16& p0, f32x16& p1, float& m_reg, float& mn, float& alpha) {
  constexpr float Cc = C::SCALE * 1.4426950408889634f;
  float pmax = p0[0];
#pragma unroll
  for (int r = 1; r < 16; ++r) pmax = fmaxf(pmax, p0[r]);
#pragma unroll
  for (int r = 0; r < 16; ++r) pmax = fmaxf(pmax, p1[r]);
  { auto rr = __builtin_amdgcn_permlane32_swap(__float_as_uint(pmax), __float_as_uint(pmax), false, false);
    pmax = fmaxf(__uint_as_float(rr[0]), __uint_as_float(rr[1])); }
  if (__builtin_expect(__all(pmax - m_reg <= THR / C::SCALE), 1)) { mn = m_reg; alpha = 1.f; }
  else { mn = fmaxf(m_reg, pmax); alpha = __builtin_amdgcn_exp2f((m_reg - mn) * Cc); m_reg = mn; }
  const float mnC = -mn * Cc;
#pragma unroll
  for (int r = 0; r < 16; ++r) p0[r] = fmaf(p0[r], Cc, mnC);
#pragma unroll
  for (int r = 0; r < 16; ++r) p1[r] = fmaf(p1[r], Cc, mnC);
#pragma unroll
  for (int r = 0; r < 16; ++r) p0[r] = __builtin_amdgcn_exp2f(p0[r]);
}
__device__ __forceinline__ void finishSM(f32x16& p0, f32x16& p1, float alpha, float& l_reg, bf16x8& pa0, bf16x8& pa1, bf16x8& pa2, bf16x8& pa3) {
#pragma unroll
  for (int r = 0; r < 16; ++r) p1[r] = __builtin_amdgcn_exp2f(p1[r]);
  float ps = 0;
#pragma unroll
  for (int r = 0; r < 16; ++r) ps += p0[r];
#pragma unroll
  for (int r = 0; r < 16; ++r) ps += p1[r];
  { auto rr = __builtin_amdgcn_permlane32_swap(__float_as_uint(ps), __float_as_uint(ps), false, false);
    ps = __uint_as_float(rr[0]) + __uint_as_float(rr[1]); }
  l_reg = l_reg * alpha + ps;
#define PK4(P, BASE, OUT) do { unsigned a0 = cvtpk(P[BASE + 0], P[BASE + 1]), a1 = cvtpk(P[BASE + 2], P[BASE + 3]);   \
    unsigned b0 = cvtpk(P[BASE + 4], P[BASE + 5]), b1 = cvtpk(P[BASE + 6], P[BASE + 7]);                              \
    auto r0 = __builtin_amdgcn_permlane32_swap(a0, b0, false, false); auto r1 = __builtin_amdgcn_permlane32_swap(a1, b1, false, false); \
    u32x4 w = {r0[0], r1[0], r0[1], r1[1]}; OUT = *reinterpret_cast<bf16x8*>(&w); } while (0)
  PK4(p0, 0, pa0); PK4(p0, 8, pa1); PK4(p1, 0, pa2); PK4(p1, 8, pa3);
#undef PK4
}
template <class C> __device__ __forceinline__ void qkt(f32x16& p0, f32x16& p1, const char* Ks, const bf16x8* qr, int r32, int hi) {
  p0 = f32x16{}; p1 = f32x16{};
#pragma unroll
  for (int d0 = 0; d0 < C::DQ / 16; ++d0) { const int cb = (d0 * 16 + hi * 8) * 2;
    const bf16x8 b0 = *reinterpret_cast<const bf16x8*>(Ks + kaddr<C>(r32, cb));
    const bf16x8 b1 = *reinterpret_cast<const bf16x8*>(Ks + kaddr<C>(32 + r32, cb));
    p0 = __builtin_amdgcn_mfma_f32_32x32x16_bf16(b0, qr[d0], p0, 0, 0, 0);
    p1 = __builtin_amdgcn_mfma_f32_32x32x16_bf16(b1, qr[d0], p1, 0, 0, 0); }
}
template <int NCB> __device__ __forceinline__ int v_st(int k, int c) { const int kk = (k & ~0xC) | ((k & 4) << 1) | ((k & 8) >> 1); return ((kk >> 3) * NCB + (c >> 5)) * 512 + ((kk & 7) * 32 + (c & 31)) * 2; }
__device__ __forceinline__ int v_rd_base(int lane) { return ((lane & 3) << 3) | (((lane >> 2) & 3) << 6) | (((lane >> 4) & 1) << 5) | (((lane >> 5) & 1) << 8); }
template <int NCB> constexpr int v_rd_off(int d0, int ks, int half) { return d0 * 512 + ks * (2 * NCB * 512) + half * (NCB * 512); }
template <int OFF> __device__ __forceinline__ s16x4 tr_read(int vb) {
  s16x4 r; asm volatile("ds_read_b64_tr_b16 %0, %1 offset:%2" : "=&v"(r) : "v"(vb), "i"(OFF) : "memory"); return r;
}
template <int NCB, int D0> __device__ __forceinline__ void pv_one(f32x16& od, int vb, bf16x8 pa0, bf16x8 pa1, bf16x8 pa2, bf16x8 pa3) {
  const s16x4 l0 = tr_read<v_rd_off<NCB>(D0, 0, 0)>(vb), h0 = tr_read<v_rd_off<NCB>(D0, 0, 1)>(vb), l1 = tr_read<v_rd_off<NCB>(D0, 1, 0)>(vb), h1 = tr_read<v_rd_off<NCB>(D0, 1, 1)>(vb);
  const s16x4 l2 = tr_read<v_rd_off<NCB>(D0, 2, 0)>(vb), h2 = tr_read<v_rd_off<NCB>(D0, 2, 1)>(vb), l3 = tr_read<v_rd_off<NCB>(D0, 3, 0)>(vb), h3 = tr_read<v_rd_off<NCB>(D0, 3, 1)>(vb);
  asm volatile("s_waitcnt lgkmcnt(0)" ::: "memory"); SBAR();
#define PK(L, H) (bf16x8){L[0], L[1], L[2], L[3], H[0], H[1], H[2], H[3]}
  od = __builtin_amdgcn_mfma_f32_32x32x16_bf16(pa0, PK(l0, h0), od, 0, 0, 0);
  od = __builtin_amdgcn_mfma_f32_32x32x16_bf16(pa1, PK(l1, h1), od, 0, 0, 0);
  od = __builtin_amdgcn_mfma_f32_32x32x16_bf16(pa2, PK(l2, h2), od, 0, 0, 0);
  od = __builtin_amdgcn_mfma_f32_32x32x16_bf16(pa3, PK(l3, h3), od, 0, 0, 0);
#undef PK
}
template <int NCB> __device__ __forceinline__ void pv_all(f32x16* o, int vb, bf16x8 pa0, bf16x8 pa1, bf16x8 pa2, bf16x8 pa3) {
  pv_one<NCB, 0>(o[0], vb, pa0, pa1, pa2, pa3); pv_one<NCB, 1>(o[1], vb, pa0, pa1, pa2, pa3);
  if constexpr (NCB == 4) { pv_one<NCB, 2>(o[2], vb, pa0, pa1, pa2, pa3); pv_one<NCB, 3>(o[3], vb, pa0, pa1, pa2, pa3); }
}
__device__ __forceinline__ void cmask(f32x16& p0, f32x16& p1, int kbase, int qpos, int hi) {
#pragma unroll
  for (int r = 0; r < 16; ++r) { const int kv = kbase + crow(r, hi); if (kv > qpos) p0[r] = -INFINITY; if (kv + 32 > qpos) p1[r] = -INFINITY; }
}
template <class C>
__device__ __forceinline__ void attn_unit(const bf16* __restrict__ Q1, const bf16* __restrict__ Q2, const bf16* __restrict__ K1, const bf16* __restrict__ K2,
                                          const bf16* __restrict__ Vp, bf16* __restrict__ Op, int qrow0, int NT, char* lds) {
  constexpr int DQ = C::DQ, DV = C::DV, NQF = DQ / 16, NCB = DV / 32, NKC = DQ / 8;
  constexpr int SHM_V = 64 * DV * 2, SHM_K = 64 * C::KP;
  const int tid = threadIdx.x, wid = tid >> 6, lane = tid & 63, r32 = lane & 31, hi = lane >> 5;
  char* V_lds = lds; char* K_lds = lds + 2 * SHM_V;
  float* ws = (float*)(lds + 2 * SHM_V + 2 * SHM_K) + wid * 64; float* li_l = ws; float* al_l = ws + 32;
  float m_reg = -1e30f, l_reg = 0; f32x16 o[NCB]; bf16x8 qr[NQF];
#pragma unroll
  for (int d = 0; d < NCB; ++d) o[d] = f32x16{};
  __syncthreads();
  { const long qrow = wid * QBLK + r32;
#pragma unroll
    for (int d0 = 0; d0 < NQF; ++d0) { const int d = d0 * 16 + hi * 8;
      qr[d0] = (d0 * 16 < C::D1) ? *reinterpret_cast<const bf16x8*>(Q1 + qrow * C::LDQ + d) : *reinterpret_cast<const bf16x8*>(Q2 + qrow * C::LDQ + (d - C::D1)); } }
  const bool kact = tid < 32 * NKC; const int ksr = tid / NKC, kcc = tid % NKC;
  const bf16* kbase = (kcc * 8 < C::D1) ? K1 + kcc * 8 : K2 + (kcc * 8 - C::D1); const int kld = (kcc * 8 < C::D1) ? C::LDK1 : C::LDK2;
  const int kst0 = kaddr<C>(ksr, kcc * 16), kst1 = kaddr<C>(32 + ksr, kcc * 16);
  const int vsr = (DV == 128) ? (tid >> 4) : (tid >> 3), vsc = (DV == 128) ? (tid & 15) * 8 : (tid & 7) * 8;
  const int vst0 = v_st<NCB>(vsr, vsc), vst1 = v_st<NCB>(32 + vsr, vsc);
  const int vb0 = (int)(uintptr_t)V_lds + v_rd_base(lane);
  struct { bf16x8 vs0, vs1, ks0, ks1; } sr_[2];
#define SLOAD(i, k0) do { sr_[i].vs0 = *reinterpret_cast<const bf16x8*>(&Vp[(long)((k0) + vsr) * C::LDV + vsc]); \
    if constexpr (DV == 128) sr_[i].vs1 = *reinterpret_cast<const bf16x8*>(&Vp[(long)((k0) + 32 + vsr) * C::LDV + vsc]); \
    if (kact) { sr_[i].ks0 = *reinterpret_cast<const bf16x8*>(&kbase[(long)((k0) + ksr) * kld]); sr_[i].ks1 = *reinterpret_cast<const bf16x8*>(&kbase[(long)((k0) + 32 + ksr) * kld]); } } while (0)
#define SWRITE(b, i) do { *(bf16x8*)(V_lds + (b) * SHM_V + vst0) = sr_[i].vs0; if constexpr (DV == 128) *(bf16x8*)(V_lds + (b) * SHM_V + vst1) = sr_[i].vs1; \
    if (kact) { *(bf16x8*)(K_lds + (b) * SHM_K + kst0) = sr_[i].ks0; *(bf16x8*)(K_lds + (b) * SHM_K + kst1) = sr_[i].ks1; } } while (0)
#define SWAIT() do { if constexpr (DV == 128) asm volatile("s_waitcnt vmcnt(4)" ::: "memory"); else asm volatile("s_waitcnt vmcnt(3)" ::: "memory"); } while (0)
#define RESC(a) do { if (__any((a) < 1.f)) { if (hi == 0) al_l[r32] = (a); asm volatile("s_waitcnt lgkmcnt(0)" ::: "memory"); \
    _Pragma("unroll") for (int d = 0; d < NCB; ++d) _Pragma("unroll") for (int r = 0; r < 16; ++r) o[d][r] *= al_l[crow(r, hi)]; } } while (0)
#define CMASK(P0, P1, t) do { if constexpr (C::CAUSAL) { if ((t) >= NT - 4) cmask(P0, P1, (t) * KVBLK, qrow0 + wid * QBLK + r32, hi); } } while (0)
  f32x16 pA0, pA1, pB0, pB1; float mnA, mnB, alA, alB; bf16x8 pa0, pa1, pa2, pa3;
  constexpr int SE = 0, SO = 1;
  SLOAD(SE, 0); asm volatile("s_waitcnt vmcnt(0)" ::: "memory"); SWRITE(0, SE); __syncthreads();
  qkt<C>(pA0, pA1, K_lds, qr, r32, hi); CMASK(pA0, pA1, 0); partialSM<C>(pA0, pA1, m_reg, mnA, alA);
  SLOAD(SO, KVBLK); if (2 < NT) SLOAD(SE, 2 * KVBLK);
  SWAIT(); SWRITE(1, SO); __syncthreads();
  for (int j = 1; j + 1 < NT; j += 2) {
    SBAR(); qkt<C>(pB0, pB1, K_lds + SHM_K, qr, r32, hi);
    finishSM(pA0, pA1, alA, l_reg, pa0, pa1, pa2, pa3); SBAR();
    SLOAD(SO, (j + 2) * KVBLK); SBAR();
    pv_all<NCB>(o, vb0, pa0, pa1, pa2, pa3); CMASK(pB0, pB1, j); partialSM<C>(pB0, pB1, m_reg, mnB, alB);
    __syncthreads(); SWAIT(); SWRITE(0, SE);
    RESC(alB); __syncthreads();
    SBAR(); qkt<C>(pA0, pA1, K_lds, qr, r32, hi);
    finishSM(pB0, pB1, alB, l_reg, pa0, pa1, pa2, pa3); SBAR();
    if (j + 3 < NT) SLOAD(SE, (j + 3) * KVBLK); SBAR();
    pv_all<NCB>(o, vb0 + SHM_V, pa0, pa1, pa2, pa3); CMASK(pA0, pA1, j + 1); partialSM<C>(pA0, pA1, m_reg, mnA, alA);
    __syncthreads(); SWAIT(); SWRITE(1, SO);
    RESC(alA); __syncthreads();
  }
  SBAR(); qkt<C>(pB0, pB1, K_lds + SHM_K, qr, r32, hi);
  finishSM(pA0, pA1, alA, l_reg, pa0, pa1, pa2, pa3); SBAR();
  pv_all<NCB>(o, vb0, pa0, pa1, pa2, pa3); CMASK(pB0, pB1, NT - 1); partialSM<C>(pB0, pB1, m_reg, mnB, alB);
  __syncthreads(); RESC(alB);
  finishSM(pB0, pB1, alB, l_reg, pa0, pa1, pa2, pa3); SBAR();
  pv_all<NCB>(o, vb0 + SHM_V, pa0, pa1, pa2, pa3);
  if (hi == 0) li_l[r32] = l_reg; asm volatile("s_waitcnt lgkmcnt(0)" ::: "memory");
  float rli[16];
#pragma unroll
  for (int r = 0; r < 16; ++r) rli[r] = __builtin_amdgcn_rcpf(li_l[crow(r, hi)]);
  bf16* Ow = Op + (long)(wid * QBLK) * C::LDO;
  if constexpr (DV == 64) {
    bf16* stg = (bf16*)(lds + 65536) + wid * 2048;
#pragma unroll
    for (int r = 0; r < 16; ++r) { const int orow = crow(r, hi);
#pragma unroll
      for (int d0 = 0; d0 < NCB; ++d0) stg[orow * 64 + d0 * 32 + r32] = (bf16)(cvtpk(o[d0][r] * rli[r], 0.f) & 0xffffu); }
    asm volatile("s_waitcnt lgkmcnt(0)" ::: "memory");
#pragma unroll
    for (int i = 0; i < 4; ++i) { const int row = i * 8 + (lane >> 3), ch = lane & 7; const u32x4 v = *(const u32x4*)(stg + row * 64 + ch * 8); *(u32x4*)(Ow + (long)row * C::LDO + ch * 8) = v; }
  } else {
#pragma unroll
  for (int r = 0; r < 16; ++r) { const int orow = crow(r, hi);
#pragma unroll
    for (int d0 = 0; d0 < NCB; ++d0) Ow[(long)orow * C::LDO + d0 * 32 + r32] = (bf16)(cvtpk(o[d0][r] * rli[r], 0.f) & 0xffffu); }
  }
#undef SLOAD
#undef SWRITE
#undef SWAIT
#undef RESC
#undef CMASK
}
#undef SBAR
}
#define GAS __attribute__((address_space(1)))
#define LAS __attribute__((address_space(3)))
typedef unsigned short bf16;
typedef unsigned v4u __attribute__((ext_vector_type(4)));
typedef float f32x4 __attribute__((ext_vector_type(4)));
typedef short bf16x8 __attribute__((ext_vector_type(8)));
typedef GAS unsigned gu32;
typedef GAS unsigned long long gu64;
#define RLX_AGENT __ATOMIC_RELAXED, __HIP_MEMORY_SCOPE_AGENT
#define LDS_WAIT() asm volatile("s_waitcnt lgkmcnt(0)" ::: "memory")
#define VM_WAIT() asm volatile("s_waitcnt vmcnt(0)" ::: "memory")
__device__ __forceinline__ unsigned long long rt() { return __builtin_amdgcn_s_memrealtime(); }
__device__ __forceinline__ unsigned f2bf(float f) { unsigned u = __builtin_bit_cast(unsigned, f); return (u + 0x7fffu + ((u >> 16) & 1u)) >> 16; }
__device__ __forceinline__ unsigned pk2(float lo, float hi) { return f2bf(lo) | (f2bf(hi) << 16); }

#define XB_TMO      128
#define XB_XCNT(j)  (256  + 64 * (j))
#define XB_XSUB(j)  (1280 + 64 * (j))
#define XB_XGEN(j)  (2304 + 64 * (j))
#define XB_TOP      3328
#define XB_TOPGEN   3392
#define XCD_BAR_WORDS 3456
#define XB_SPIN_CAP (1u << 18)

__device__ __forceinline__ unsigned xb_ld(unsigned* p)              { return __hip_atomic_load(p, __ATOMIC_RELAXED, __HIP_MEMORY_SCOPE_AGENT); }
__device__ __forceinline__ unsigned xb_add(unsigned* p, unsigned v) { return __hip_atomic_fetch_add(p, v, __ATOMIC_RELAXED, __HIP_MEMORY_SCOPE_AGENT); }
__device__ __forceinline__ unsigned xb_xcc_id() { return (unsigned)__builtin_amdgcn_s_getreg((3 << 11) | 20) & 0xFu; }
#define XB_SPIN(cond, bar) do { unsigned _sp = 0; while (cond) { __builtin_amdgcn_s_sleep(1); \
    if ((++_sp & 255u) == 0u) { if (xb_ld(&(bar)[XB_TMO])) break; if (_sp > XB_SPIN_CAP) { atomicAdd(&(bar)[XB_TMO], 1u); break; } } } } while (0)

struct XcdBarrier {
    unsigned* bar; unsigned x;
    volatile LAS unsigned* st;
};

__device__ __forceinline__ XcdBarrier xcd_barrier_post(unsigned* bar, volatile LAS unsigned* st) {
    XcdBarrier b; b.bar = bar; b.x = xb_xcc_id(); b.st = st;
    if (threadIdx.x == 0) (void)xb_add(&bar[XB_XCNT(b.x)], 1u);
    return b;
}
__device__ __forceinline__ void xcd_barrier_complete(unsigned* bar, unsigned x, unsigned& nloc, unsigned& nx) {
    const unsigned G = gridDim.x * gridDim.y * gridDim.z;
    unsigned sum, cnt, mine, sp = 0u;
    for (;;) {
        sum = 0u; cnt = 0u; mine = 0u;
#pragma unroll
        for (unsigned j = 0; j < 16; ++j) { const unsigned c = xb_ld(&bar[XB_XCNT(j)]); sum += c; cnt += (c > 0u) ? 1u : 0u; mine = (j == x) ? c : mine; }
        if (sum == G) break;
        __builtin_amdgcn_s_sleep(1);
        if ((++sp & 255u) == 0u) { if (xb_ld(&bar[XB_TMO])) break; if (sp > XB_SPIN_CAP) { atomicAdd(&bar[XB_TMO], 1u); break; } }
    }
    nloc = mine > 0u ? mine : 1u; nx = cnt > 0u ? cnt : 1u;
}

__device__ __forceinline__ void xcd_barrier(const XcdBarrier& b) {
    asm volatile("s_waitcnt vmcnt(0)" ::: "memory");
    __syncthreads();
    if (threadIdx.x == 0) {
        unsigned* bar = b.bar;
        __builtin_amdgcn_s_waitcnt(0);
        unsigned nloc = b.st[0], nx = b.st[1];
        if (nloc == 0u) { xcd_barrier_complete(bar, b.x, nloc, nx); b.st[0] = nloc; b.st[1] = nx; }
        const unsigned old = xb_add(&bar[XB_XSUB(b.x)], 1u);
        const unsigned gen = old / nloc;
        if (old + 1u == (gen + 1u) * nloc) {
            __builtin_amdgcn_fence(__ATOMIC_RELEASE, "agent");
            asm volatile("s_waitcnt vmcnt(0)" ::: "memory");
            const unsigned og = xb_add(&bar[XB_TOP], 1u);
            const unsigned tg = og / nx;
            if (og + 1u == (tg + 1u) * nx) xb_add(&bar[XB_TOPGEN], 1u);
            else XB_SPIN(xb_ld(&bar[XB_TOPGEN]) == tg, bar);
            __builtin_amdgcn_fence(__ATOMIC_ACQUIRE, "agent");
            xb_add(&bar[XB_XGEN(b.x)], 1u);
            asm volatile("s_waitcnt vmcnt(0)" ::: "memory");
        } else {
            XB_SPIN(xb_ld(&bar[XB_XGEN(b.x)]) == gen, bar);
            __builtin_amdgcn_fence(__ATOMIC_ACQUIRE, "agent");
            asm volatile("s_waitcnt vmcnt(0)" ::: "memory");
        }
    }
    __syncthreads();
}
constexpr int NWAVES = 8;
constexpr int D = 1024, BATCH = 8, SEQ = 2048, M = BATCH * SEQ, MEM = 256, MM = BATCH * MEM;
constexpr int NH = 8, DN = 64, DR = 32, DV = 64, QL = 256, KVL = 128, DQK = DN + DR;
constexpr int CW = 512, XH = 4, XD = 128, NG = 8, EPG = 8, NE = 64, FF = 256;
constexpr int COL_CQ = 256, COL_CKV = 384, COL_KR = 416, COL_CONV = 1952, IN_COLS = 4000, INP = 4096;
constexpr int PMAX = 2 * M + NE * 256, NTILE_MAX = PMAX / 256;
constexpr float EPS = 1e-6f;
constexpr int RCAP = M;

constexpr size_t MiB = 1u << 20;
constexpr size_t WS_CTL = 0, CTL_ZERO_BYTES = 1 * MiB;
constexpr size_t WS_COS = 1 * MiB, WS_SIN = 2 * MiB, WS_RIDX = 3 * MiB, WS_SLOT = WS_RIDX + 256 * 1024, WS_EID = WS_RIDX + 512 * 1024, WS_EW = WS_RIDX + 768 * 1024;
constexpr size_t WS_WIN = 4 * MiB, WS_WUQ = 12 * MiB, WS_WUKV = 12 * MiB + 512 * 1024, WS_WA = 13 * MiB, WS_WB = 14 * MiB, WS_WOUT = 15 * MiB, WS_WQM = 17 * MiB, WS_WKVM = 18 * MiB,
                 WS_WOM = 20 * MiB, WS_WR = 21 * MiB, WS_WGU = 22 * MiB, WS_WDN = 86 * MiB;
constexpr size_t WS_XN = 118 * MiB, WS_MIX = 118 * MiB, WS_G = 150 * MiB, WS_CQ = 214 * MiB, WS_CKV = 222 * MiB, WS_KR = 226 * MiB, WS_BG = 227 * MiB, WS_U = 243 * MiB,
                 WS_Q = 259 * MiB, WS_KN = 283 * MiB, WS_V = 299 * MiB, WS_ATT = 315 * MiB, WS_CONV = 331 * MiB, WS_X1B = 347 * MiB, WS_QM = 379 * MiB, WS_MEMN = 395 * MiB,
                 WS_KM = 399 * MiB, WS_VM = 401 * MiB, WS_OM = 403 * MiB, WS_X2B = 214 * MiB, WS_LOG = 246 * MiB, WS_HH = 259 * MiB, WS_YD = 118 * MiB, WS_RIDX2 = 420 * MiB, WS_XN8 = 424 * MiB, WS_WIN8 = 440 * MiB, WS_X1 = 448 * MiB, WS_END = 512 * MiB;
constexpr int CW_BAR = 4096, CW_SSQQ = 16384, CW_SSQKV = 49152, CW_SSQ1 = 81920, CW_SSQ2 = 114688, CW_INPROJ = 147648, CW_GRP = 147712, CW_TREADY = 151808, CW_COUNTS = 164096;
static_assert((CW_COUNTS + 64 * NE) * 4 <= (int)CTL_ZERO_BYTES && CW_TREADY + 64 * NTILE_MAX <= CW_COUNTS, "CTL words inside the memset region");
constexpr int RING_OFF = 0, RING_BYTES = 131072;
constexpr int LDSCTL_OFF = RING_BYTES, MISC_OFF = LDSCTL_OFF + 320, TEXP_OFF = RING_BYTES + 1024, GTAB_OFF = RING_BYTES + 2048, OFFS_OFF = GTAB_OFF + 4096, TORD_OFF = OFFS_OFF + 1024;
constexpr int LDS_BYTES = 147456;
static_assert(TORD_OFF + 1024 <= LDS_BYTES, "LDS map");

struct Args { const float* in[27]; float* out; unsigned char* ws; int ph_lo, ph_hi, sub, pad; };
constexpr int NPHASE = 15;
#ifndef GROUPBAR
#define GROUPBAR 1
#endif
#ifndef MOEUPALIGN
#define MOEUPALIGN true
#endif
#ifndef MOEALIGN
#define MOEALIGN true
#endif
#ifndef SUALIGN
#define SUALIGN true
#endif
#ifndef P1ALIGN
#define P1ALIGN false
#endif
#ifndef INROT
#define INROT 0
#endif

__device__ __forceinline__ float wave_sum(float v) {
#pragma unroll
    for (int o = 1; o < 64; o <<= 1) v += __shfl_xor(v, o);
    return v;
}
__device__ __forceinline__ int rope_pos(int j) { const int x = j & 15, second = j >> 4; return 8 * (x >> 2) + 4 * second + (x & 3); }
struct MapId  { __device__ __forceinline__ int operator()(int n) const { return n; } };
struct MapWin { __device__ __forceinline__ int operator()(int n) const {
    if (n < COL_CKV) return n;
    if (n < COL_KR) return 384 + rope_pos(n - COL_CKV);
    if (n < COL_KR + CW) return 512 + (n - COL_KR);
    if (n < COL_KR + 2 * CW) { const int c = n - COL_KR - CW; return 1024 + (c >> 7) * 256 + (c & 127); }
    if (n < COL_CONV) { const int c = n - COL_KR - 2 * CW; return 1024 + (c >> 7) * 256 + 128 + (c & 127); }
    return 2048 + (n - COL_CONV); } };
struct MapUq  { __device__ __forceinline__ int operator()(int n) const { const int h = n / DQK, d = n % DQK; return d < DN ? h * DN + d : 512 + h * DR + rope_pos(d - DN); } };
struct MapUkv { __device__ __forceinline__ int operator()(int n) const { const int h = n >> 7, d = n & 127; return d < 64 ? h * 64 + d : 512 + h * 64 + (d - 64); } };
struct MapGu  { __device__ __forceinline__ int operator()(int n) const { const int c = n & 255; return (c >> 7) * 256 + (n >> 8) * 128 + (c & 127); } };
struct TItem { const float* W; bf16* WT; const float* gain; int K, N, k0, n0, map; };
__device__ __forceinline__ void titem_load(const TItem& t, f32x4 (&v)[8], f32x4 (&g)[2], int lane) {
    const int sub = lane >> 3, c4 = (lane & 7) * 4;
#pragma unroll
#ifdef PLAIN_TLOAD
    for (int j = 0; j < 8; ++j) v[j] = *((const GAS f32x4*)(t.W + (size_t)(t.k0 + 8 * j + sub) * t.N + t.n0 + c4));
#else
    for (int j = 0; j < 8; ++j) v[j] = __builtin_nontemporal_load((const GAS f32x4*)(t.W + (size_t)(t.k0 + 8 * j + sub) * t.N + t.n0 + c4));
#endif
    const GAS f32x4* gp = (const GAS f32x4*)((t.gain ? t.gain : t.W) + t.k0 + 8 * (lane & 7)); g[0] = gp[0]; g[1] = gp[1];
}
__device__ __forceinline__ int titem_row(int map, int n) {
    switch (map) { case 1: return MapWin()(n); case 2: return MapUq()(n); case 3: return MapUkv()(n); case 4: return MapGu()(n); default: return n; }
}
__device__ __forceinline__ void titem_finish(const TItem& t, const f32x4 (&v)[8], const f32x4 (&g)[2], LAS float* scr, int lane) {
    const int sub = lane >> 3, c4 = (lane & 7) * 4;
#pragma unroll
    for (int j = 0; j < 8; ++j) { const int kk = 8 * j + sub; LAS float* s = scr + kk * 33 + c4;
        s[0] = v[j].x; s[1] = v[j].y; s[2] = v[j].z; s[3] = v[j].w; }
    LDS_WAIT(); asm volatile("" ::: "memory");
    const int c = lane & 7; const bool hg = t.gain != nullptr;
    const float g0 = hg ? g[0].x : 1.f, g1 = hg ? g[0].y : 1.f, g2 = hg ? g[0].z : 1.f, g3 = hg ? g[0].w : 1.f, g4 = hg ? g[1].x : 1.f, g5 = hg ? g[1].y : 1.f, g6 = hg ? g[1].z : 1.f, g7 = hg ? g[1].w : 1.f;
#pragma unroll
    for (int j = 0; j < 4; ++j) { const int n = (lane >> 3) + 8 * j; const LAS float* s = scr + (8 * c) * 33 + n;
        if (t.map == 5) { unsigned w0 = 0, w1 = 0;
            w0 = __builtin_amdgcn_cvt_pk_fp8_f32(s[0 * 33] * g0 * 32.f, s[1 * 33] * g1 * 32.f, w0, false); w0 = __builtin_amdgcn_cvt_pk_fp8_f32(s[2 * 33] * g2 * 32.f, s[3 * 33] * g3 * 32.f, w0, true);
            w1 = __builtin_amdgcn_cvt_pk_fp8_f32(s[4 * 33] * g4 * 32.f, s[5 * 33] * g5 * 32.f, w1, false); w1 = __builtin_amdgcn_cvt_pk_fp8_f32(s[6 * 33] * g6 * 32.f, s[7 * 33] * g7 * 32.f, w1, true);
            *(GAS unsigned long long*)((GAS unsigned char*)t.WT + (size_t)(t.n0 + n - COL_CONV) * t.K + t.k0 + 8 * c) = (unsigned long long)w0 | ((unsigned long long)w1 << 32); continue; }
        v4u o; o.x = pk2(s[0 * 33] * g0, s[1 * 33] * g1); o.y = pk2(s[2 * 33] * g2, s[3 * 33] * g3); o.z = pk2(s[4 * 33] * g4, s[5 * 33] * g5); o.w = pk2(s[6 * 33] * g6, s[7 * 33] * g7);
        GAS v4u* dst = (GAS v4u*)(t.WT + (size_t)titem_row(t.map, t.n0 + n) * t.K + t.k0 + 8 * c);
        if (t.map == 4 || t.map == 6) __builtin_nontemporal_store(o, dst); else *dst = o; }
    LDS_WAIT(); asm volatile("" ::: "memory");
}
__device__ __forceinline__ void rms_row_to_bf16(const float* xrow, const float* g, bf16* orow, int lane) {
    const GAS f32x4* xr = (const GAS f32x4*)xrow + lane; const GAS f32x4* gr = (const GAS f32x4*)g + lane;
    f32x4 v[4]; float s = 0.f;
#pragma unroll
    for (int j = 0; j < 4; ++j) { v[j] = xr[64 * j]; s += (v[j].x * v[j].x + v[j].y * v[j].y) + (v[j].z * v[j].z + v[j].w * v[j].w); }
    const float rstd = 1.f / sqrtf(wave_sum(s) * (1.f / D) + EPS);
    GAS unsigned long long* o8 = (GAS unsigned long long*)orow + lane;
#pragma unroll
    for (int j = 0; j < 4; ++j) { const f32x4 gg = gr[64 * j]; o8[64 * j] = (unsigned long long)pk2(v[j].x * rstd * gg.x, v[j].y * rstd * gg.y) | ((unsigned long long)pk2(v[j].z * rstd * gg.z, v[j].w * rstd * gg.w) << 32); }
}

template <class MK>
__device__ __forceinline__ void run_titems(const MK& mk, int it_lo, int it_hi, int wv, int nwv, LAS float* scr, int lane) {
    f32x4 va[8], vb[8], vc[8], ga[2], gb[2], gc[2]; TItem ta, tb, tc;
    for (int it = it_lo + wv; it < it_hi; it += 3 * nwv) {
        const bool hb = it + nwv < it_hi, hc = it + 2 * nwv < it_hi;
        ta = mk(it); tb = mk(hb ? it + nwv : it); tc = mk(hc ? it + 2 * nwv : it);
        if (!hb) { tb.N = 0; tb.k0 = 0; tb.n0 = 0; } if (!hc) { tc.N = 0; tc.k0 = 0; tc.n0 = 0; }
        titem_load(ta, va, ga, lane); titem_load(tb, vb, gb, lane); titem_load(tc, vc, gc, lane);
        titem_finish(ta, va, ga, scr, lane); if (hb) titem_finish(tb, vb, gb, scr, lane); if (hc) titem_finish(tc, vc, gc, scr, lane);
    }
}
constexpr int I_GU = 16 * 8, I_DN = 4 * 16, MOE_ITEMS = NE * (I_GU + I_DN);
struct WItem { const float* W; bf16* WT; const float* gain; int K, N, k0, n0, gu; };
__device__ __forceinline__ void witem_load(const WItem& t, f32x4 (&v)[16], f32x4 (&g)[2], int lane) {
    const int sub = lane >> 4, c4 = (lane & 15) * 4;
#pragma unroll
    for (int j = 0; j < 16; ++j) v[j] = __builtin_nontemporal_load((const GAS f32x4*)(t.W + (size_t)(t.k0 + 4 * j + sub) * t.N + t.n0 + c4));
    const GAS f32x4* gp = (const GAS f32x4*)((t.gain ? t.gain : t.W) + t.k0 + 8 * (lane & 7)); g[0] = gp[0]; g[1] = gp[1];
}
__device__ __forceinline__ void witem_write(const WItem& t, const f32x4 (&v)[16], LAS float* scr, int lane) {
    const int sub = lane >> 4, c4 = (lane & 15) * 4;
#pragma unroll
    for (int j = 0; j < 16; ++j) { const int kk = 4 * j + sub; LAS float* s = scr + kk * 64;
        s[(c4 + 0 + kk) & 63] = v[j].x; s[(c4 + 1 + kk) & 63] = v[j].y; s[(c4 + 2 + kk) & 63] = v[j].z; s[(c4 + 3 + kk) & 63] = v[j].w; }
    LDS_WAIT(); asm volatile("" ::: "memory");
}
__device__ __forceinline__ void witem_gsel(const WItem& t, const f32x4 (&g)[2], f32x4 (&gs)[2]) {
    const bool hg = t.gain != nullptr; const f32x4 one = {1.f, 1.f, 1.f, 1.f}; gs[0] = hg ? g[0] : one; gs[1] = hg ? g[1] : one;
    asm volatile("" : "+v"(gs[0]), "+v"(gs[1]));
}
__device__ __forceinline__ void witem_out(const WItem& t, const f32x4 (&g)[2], LAS float* scr, int lane) {
    asm volatile("" : "+v"(lane));
    const int c = lane & 7;
    const float g0 = g[0].x, g1 = g[0].y, g2 = g[0].z, g3 = g[0].w, g4 = g[1].x, g5 = g[1].y, g6 = g[1].z, g7 = g[1].w;
#pragma unroll
    for (int j = 0; j < 8; ++j) { const int n = (lane >> 3) + 8 * j; const LAS float* s = scr + (8 * c) * 64;
#define WE(q) s[q * 64 + ((n + 8 * c + q) & 63)]
        v4u o; o.x = pk2(WE(0) * g0, WE(1) * g1); o.y = pk2(WE(2) * g2, WE(3) * g3); o.z = pk2(WE(4) * g4, WE(5) * g5); o.w = pk2(WE(6) * g6, WE(7) * g7);
#undef WE
        const int nn = t.n0 + n, row = t.gu ? MapGu()(nn) : nn;
#ifdef NT_WOUT
        __builtin_nontemporal_store(o, (GAS v4u*)(t.WT + (size_t)row * t.K + t.k0 + 8 * c)); }
#else
        *(GAS v4u*)(t.WT + (size_t)row * t.K + t.k0 + 8 * c) = o; }
#endif
    LDS_WAIT(); asm volatile("" ::: "memory");
}
__device__ __forceinline__ void moe_prep(unsigned char* ws, const float* w_gu, const float* w_dn, const float* g_moe, int it_lo, int it_hi, int wv, int nwv, LAS float* scr, int lane, size_t wgu_off = WS_WGU, size_t wdn_off = WS_WDN) {
    auto mk = [&](int it) -> WItem { WItem t; int r = it;
        if (r < NE * I_GU) { const int e = r / I_GU, item = r % I_GU; t.W = w_gu + (size_t)e * D * 512; t.WT = (bf16*)(ws + wgu_off) + (size_t)e * 512 * D; t.gain = g_moe; t.K = D; t.N = 512; t.k0 = 64 * (item / 8); t.n0 = 64 * (item % 8); t.gu = 1; return t; }
        r -= NE * I_GU; { const int e = r / I_DN, item = r % I_DN; t.W = w_dn + (size_t)e * FF * D; t.WT = (bf16*)(ws + wdn_off) + (size_t)e * D * FF; t.gain = nullptr; t.K = FF; t.N = D; t.k0 = 64 * (item / 16); t.n0 = 64 * (item % 16); t.gu = 0; return t; } };
    f32x4 v[16], gl[2], gc[2], gn[2]; WItem tc, tn; int it = it_lo + wv;
    if (it < it_hi) { tc = mk(it); witem_load(tc, v, gl, lane); witem_write(tc, v, scr, lane); witem_gsel(tc, gl, gc); }
    while (it < it_hi) {
        const int it2 = it + nwv; const bool more = it2 < it_hi;
        tn = mk(more ? it2 : it); if (!more) { tn.N = 0; tn.k0 = 0; tn.n0 = 0; } witem_load(tn, v, gl, lane);
        witem_out(tc, gc, scr, lane);
        if (more) { witem_write(tn, v, scr, lane); witem_gsel(tn, gl, gn); gc[0] = gn[0]; gc[1] = gn[1]; }
        tc = tn; it = it2;
    }
}
#ifdef PREP_IN_P0
#define PREP_A MOE_ITEMS
#define PREP_B MOE_ITEMS
#endif
#ifdef PREP_P0
#define PREP_P0V PREP_P0
#else
#define PREP_P0V 0
#endif
#ifndef DESYNC_US
#define DESYNC_US 0
#endif
#ifndef PREP_R
#define PREP_R 0
#endif
#ifndef SEAM3_BATCH
#define SEAM3_BATCH 1
#endif
#ifndef BATCHBAR
#define BATCHBAR 1
#endif
#ifndef PREP_A
#define PREP_A 0
#endif
#ifndef PREP_B
#define PREP_B 4500
#endif
__device__ __forceinline__ void group_barrier(unsigned* cnt, unsigned target, unsigned* tmo, volatile LAS unsigned* st) {
    asm volatile("s_waitcnt vmcnt(0)" ::: "memory");
    __syncthreads();
    if (threadIdx.x == 0) {
        const unsigned mode = st[0];
        if (mode != 1u) __builtin_amdgcn_fence(__ATOMIC_RELEASE, "agent");
        asm volatile("s_waitcnt vmcnt(0)" ::: "memory");
        (void)xb_add(cnt, 1u);
        unsigned sp = 0;
        while (xb_ld(cnt) < target) { __builtin_amdgcn_s_sleep(1); if ((++sp & 255u) == 0u) { if (xb_ld(tmo)) break; if (sp > XB_SPIN_CAP) { atomicAdd(tmo, 1u); break; } } }
        __builtin_amdgcn_fence(__ATOMIC_ACQUIRE, "agent");
        asm volatile("s_waitcnt vmcnt(0)" ::: "memory");
        if (mode == 0u) { const unsigned m = xb_ld(cnt + 1); st[0] = (__builtin_popcount(m) == 1) ? 1u : 2u; }
    }
    __syncthreads();
}
__device__ __forceinline__ void conv_item(unsigned char* ws, const float* conv_w, int m, int c) {
    const int s = m % SEQ; const bf16* Ub = (const bf16*)(ws + WS_U) + (size_t)m * CW + c;
    f32x4 u0a, u0b, u1a, u1b, u2a, u2b, ba, bb;
    pg8::unpack8(*(const v4u*)Ub, u2a, u2b); pg8::unpack8(*(const v4u*)((const bf16*)(ws + WS_BG) + (size_t)m * CW + c), ba, bb);
    if (s >= 1) pg8::unpack8(*(const v4u*)(Ub - CW), u1a, u1b); else { u1a = (f32x4){0.f, 0.f, 0.f, 0.f}; u1b = u1a; }
    if (s >= 2) pg8::unpack8(*(const v4u*)(Ub - 2 * CW), u0a, u0b); else { u0a = (f32x4){0.f, 0.f, 0.f, 0.f}; u0b = u0a; }
    const f32x4 w0a = *(const f32x4*)(conv_w + c), w0b = *(const f32x4*)(conv_w + c + 4), w1a = *(const f32x4*)(conv_w + CW + c), w1b = *(const f32x4*)(conv_w + CW + c + 4),
                w2a = *(const f32x4*)(conv_w + 2 * CW + c), w2b = *(const f32x4*)(conv_w + 2 * CW + c + 4);
    *(v4u*)((bf16*)(ws + WS_CONV) + (size_t)m * CW + c) = pg8::pack8(ba * (w0a * u0a + w1a * u1a + w2a * u2a), bb * (w0b * u0b + w1b * u1b + w2b * u2b));
}
__device__ __forceinline__ const void* kernarg_ptr(int i) {
    typedef const void* cvp_t;
    const __attribute__((address_space(4))) cvp_t* p = (const __attribute__((address_space(4))) cvp_t*)__builtin_amdgcn_kernarg_segment_ptr(); asm volatile("" : "+s"(p)); return p[i];
}
__global__ void __launch_bounds__(NWAVES * 64, 2) mega_fwd(Args args) {
    extern __shared__ __attribute__((aligned(16))) unsigned char lds[];
    LAS unsigned char* const ldsl = (LAS unsigned char*)lds;
    volatile LAS unsigned* const MISC = (volatile LAS unsigned*)(ldsl + MISC_OFF);
    const int tid = threadIdx.x, lane = tid & 63, wave = __builtin_amdgcn_readfirstlane(tid >> 6);
    const int G = gridDim.x, bx = blockIdx.x, vcu = (G % 8 == 0) ? (bx % 8) * (G / 8) + bx / 8 : bx;
    unsigned char* const ws = args.ws;
    gu32* const ctl = (gu32*)(ws + WS_CTL);
#define ARGF(i) ((const float*)kernarg_ptr(i))
#define WSB(off) ((bf16*)(ws + (off)))
    float* const COS = (float*)(ws + WS_COS); float* const SIN = (float*)(ws + WS_SIN);
    int* const RIDX = (int*)(ws + WS_RIDX); int* const SLOT = (int*)(ws + WS_SLOT); int* const EID = (int*)(ws + WS_EID); int* const RIDX2 = (int*)(ws + WS_RIDX2); float* const EW = (float*)(ws + WS_EW);
    pg8::ssq_t* const SSQQ = (pg8::ssq_t*)(ctl + CW_SSQQ); pg8::ssq_t* const SSQKV = (pg8::ssq_t*)(ctl + CW_SSQKV); pg8::ssq_t* const SSQ1 = (pg8::ssq_t*)(ctl + CW_SSQ1); pg8::ssq_t* const SSQ2 = (pg8::ssq_t*)(ctl + CW_SSQ2);
    unsigned* const COUNTS = (unsigned*)(ctl + CW_COUNTS);
    float* const LOG = (float*)(ws + WS_LOG);

    for (int u = tid; u < (LDS_BYTES - LDSCTL_OFF) / 4; u += NWAVES * 64) ((LAS unsigned*)(ldsl + LDSCTL_OFF))[u] = 0u;
    __syncthreads();
    const int lo = args.ph_lo, hi = args.ph_hi;
    XcdBarrier bar; bar.bar = (unsigned*)(ctl + CW_BAR); bar.x = 0; bar.st = nullptr;
    if (hi - lo > 1) { bar = xcd_barrier_post((unsigned*)(ctl + CW_BAR), MISC + 8); if (GROUPBAR && tid == 0) { atomicOr((unsigned*)(ctl + CW_GRP) + 64 * (bx % 64) + 1, 1u << bar.x); atomicOr((unsigned*)(ctl + CW_GRP) + 64 * (bx % 8) + 9, 1u << bar.x); } }
#ifndef PHMASK
#define PHMASK 0x7fff
#endif
#ifndef REPMASK
#define REPMASK 0
#endif
#ifndef REPBAR
#define REPBAR 0
#endif
#define REP(k) for (int rep_ = 0; rep_ < ((((REPMASK) >> (k)) & 1) ? 2 : 1); ++rep_, (REPBAR ? xcd_barrier(bar) : (void)0))
#define IN(k) ((((PHMASK) >> (k)) & 1) && lo <= (k) && (k) < hi)
#ifndef NBAR
#define NBAR 1
#endif
#ifdef TSPROBE
#define TSTAMP(i) do { if (bx == 0 && tid == 0) ((unsigned long long*)(ctl + 512))[i] = __builtin_amdgcn_s_memrealtime(); } while (0)
#else
#define TSTAMP(i) do {} while (0)
#endif
#define SEAM(k) do { if (IN(k) && IN((k) + 1)) { for (int nb_ = 0; nb_ < NBAR; ++nb_) xcd_barrier(bar); } TSTAMP((k) + 1); } while (0)
    unsigned* const grp_cnt = (unsigned*)(ctl + CW_GRP) + 64 * (bx % 64); unsigned* const grp_tmo = (unsigned*)(ctl + CW_BAR) + XB_TMO;
#define GSEAM(k, s) do { if (IN(k) && IN((k) + 1)) { if (GROUPBAR && G == 256) group_barrier(grp_cnt, 4u * ((s) + 1u), grp_tmo, MISC + 12); else xcd_barrier(bar); } TSTAMP((k) + 1); } while (0)
    TSTAMP(0);
#ifndef NPASS
#define NPASS 1
#endif
    const int gw = vcu * NWAVES + wave, NGW = G * NWAVES, gt = vcu * (NWAVES * 64) + tid, NGT = G * NWAVES * 64;

    constexpr int I_IN = 16 * 125, I_UQ = 4 * 24, I_UKV = 2 * 32, I_A = 8 * 32, I_OUT = 16 * 32, I_QM = 16 * 16, I_KVM = 16 * 32, I_OM = 8 * 32;
    constexpr int N_EARLY = I_IN + I_UQ + I_UKV + I_KVM, NITEMS = N_EARLY + 2 * I_A + I_OUT + I_QM + I_OM;
    auto mk_item = [&](int it) -> TItem {
        TItem t; int r = it;
        auto set = [&](const float* W, int K, int N, bf16* WT, const float* gain, int map, int item) { const int nblk = N / 32; t.W = W; t.WT = WT; t.gain = gain; t.K = K; t.N = N; t.k0 = 64 * (item / nblk); t.n0 = 32 * (item % nblk); t.map = map; };
        if (r < I_IN) { set(ARGF(4), D, IN_COLS, WSB(WS_WIN), nullptr, 1, r); return t; } r -= I_IN;
        if (r < I_UQ) { set(ARGF(7), QL, NH * DQK, WSB(WS_WUQ), ARGF(6), 2, r); return t; } r -= I_UQ;
        if (r < I_UKV) { set(ARGF(9), KVL, NH * 128, WSB(WS_WUKV), ARGF(8), 3, r); return t; } r -= I_UKV;
        if (r < I_KVM) { set(ARGF(17), D, D, WSB(WS_WKVM), nullptr, 0, r); return t; } r -= I_KVM;
        if (r < I_A) { set(ARGF(11), 512, D, WSB(WS_WA), nullptr, 0, r); return t; } r -= I_A;
        if (r < I_A) { set(ARGF(12), 512, D, WSB(WS_WB), nullptr, 0, r); return t; } r -= I_A;
        if (r < I_OUT) { set(ARGF(13), D, D, WSB(WS_WOUT), nullptr, 0, r); return t; } r -= I_OUT;
        if (r < I_QM) { set(ARGF(16), D, 512, WSB(WS_WQM), ARGF(14), 0, r); return t; } r -= I_QM;
        set(ARGF(18), 512, D, WSB(WS_WOM), nullptr, 0, r); return t;
    };
    auto router_weights = [&](int t0, int nt) {
        const float* w_rg = ARGF(20); const float* w_re = ARGF(22); const float* g_moe = ARGF(19);
        for (int i = t0; i < 256 * D; i += nt) { const int n = i >> 10, k = i & 1023;
            float v = 0.f; if (n < NG) v = w_rg[k * NG + n] * g_moe[k]; else if (n < NG + NE) v = w_re[k * NE + (n - NG)] * g_moe[k];
            WSB(WS_WR)[i] = (bf16)f2bf(v); } };
    if (IN(0)) REP(0) {
        const float* x = ARGF(0); const float* mem = ARGF(1); const int* pos = (const int*)ARGF(2); const float* g_mix = ARGF(3); const float* w_in = ARGF(4);
        const float* g_cq = ARGF(6); const float* w_uq = ARGF(7); const float* g_ckv = ARGF(8); const float* w_ukv = ARGF(9); const float* w_a = ARGF(11); const float* w_b = ARGF(12); const float* w_out = ARGF(13);
        const float* g_xattn = ARGF(14); const float* g_mem = ARGF(15); const float* w_q_mem = ARGF(16); const float* w_kv_mem = ARGF(17); const float* w_o_mem = ARGF(18); const float* g_moe = ARGF(19);
        const float* w_rg = ARGF(20); const float* w_re = ARGF(22);
        LAS float* scr = (LAS float*)(ldsl + RING_OFF + wave * 16384);
        run_titems(mk_item, 0, (G == 256) ? N_EARLY : NITEMS, gw, NGW, scr, lane);
#ifdef PREP_IN_P0
        moe_prep(ws, ARGF(24), ARGF(25), ARGF(19), 0, MOE_ITEMS, gw, NGW, scr, lane);
#elif defined(PREP_P0)
        moe_prep(ws, ARGF(24), ARGF(25), ARGF(19), MOE_ITEMS - PREP_P0, MOE_ITEMS, gw, NGW, scr, lane);
#endif
        {
            auto ldrow = [&](const float* xrow, f32x4 (&v)[4]) { const GAS f32x4* xr = (const GAS f32x4*)xrow + lane; _Pragma("unroll") for (int j = 0; j < 4; ++j) v[j] = __builtin_nontemporal_load(xr + 64 * j); };
            f32x4 gv[4];
            auto ldgain = [&](const float* g) { const GAS f32x4* gr = (const GAS f32x4*)g + lane; _Pragma("unroll") for (int j = 0; j < 4; ++j) gv[j] = gr[64 * j]; };
            auto finrow = [&](const f32x4 (&v)[4], const float* g, bf16* orow, unsigned char* orow8) { float s = 0.f;
                _Pragma("unroll") for (int j = 0; j < 4; ++j) s += (v[j].x * v[j].x + v[j].y * v[j].y) + (v[j].z * v[j].z + v[j].w * v[j].w);
                const float rstd = 1.f / sqrtf(wave_sum(s) * (1.f / D) + EPS); GAS unsigned long long* o8 = (GAS unsigned long long*)orow + lane;
                _Pragma("unroll") for (int j = 0; j < 4; ++j) { const f32x4 gg = gv[j]; const float a0 = v[j].x * rstd * gg.x, a1 = v[j].y * rstd * gg.y, a2 = v[j].z * rstd * gg.z, a3 = v[j].w * rstd * gg.w;
                    o8[64 * j] = (unsigned long long)pk2(a0, a1) | ((unsigned long long)pk2(a2, a3) << 32);
                    if (orow8) { unsigned w = 0; w = __builtin_amdgcn_cvt_pk_fp8_f32(a0, a1, w, false); w = __builtin_amdgcn_cvt_pk_fp8_f32(a2, a3, w, true); ((GAS unsigned*)orow8)[lane + 64 * j] = w; } } };
            f32x4 r0[4], r1[4]; ldgain(g_mix);
            for (int m = gw; m < M; m += 2 * NGW) { const int m1 = m + NGW; ldrow(x + (size_t)m * D, r0); if (m1 < M) ldrow(x + (size_t)m1 * D, r1);
                finrow(r0, g_mix, WSB(WS_XN) + (size_t)m * D, nullptr); if (m1 < M) finrow(r1, g_mix, WSB(WS_XN) + (size_t)m1 * D, nullptr); }
            ldgain(g_mem);
            for (int m = gw; m < MM; m += NGW) { ldrow(mem + (size_t)m * D, r0); finrow(r0, g_mem, WSB(WS_MEMN) + (size_t)m * D, nullptr); }
        }
        for (int i = gt; i < M * 16; i += NGT) { const int m = i >> 4, j = i & 15; const float inv = powf(10000.0f, -(float)(2 * j) / 32.0f); const float ang = (float)pos[m] * inv; COS[i] = cosf(ang); SIN[i] = sinf(ang); }
        for (int i = gt; i < PMAX; i += NGT) RIDX[i] = 0;
        for (int i = gt; i < 96 * D; i += NGT) WSB(WS_WIN)[(size_t)416 * D + i] = 0;
        if (G != 256) router_weights(gt, NGT);
    }
    SEAM(0);
    if (GROUPBAR && IN(0) && IN(1)) {
        if (tid == 0) { const unsigned m = xb_ld(grp_cnt + 1); MISC[12] = (__builtin_popcount(m) == 1) ? 1u : 2u;
                        const unsigned mb = xb_ld((unsigned*)(ctl + CW_GRP) + 64 * (bx % 8) + 9); MISC[13] = (__builtin_popcount(mb) == 1) ? 1u : 2u; }
        __syncthreads();
    }
    if (IN(1)) REP(1) {
        const float* b_gate = ARGF(5);
        pg8::Gemm g{WSB(WS_XN), WSB(WS_WIN), M, INP, D}; pg8::StaticOrder S;
#ifdef P1SPLIT
        S.init(M, INP, 1024, bx + args.sub * 256, INROT);
#else
        S.init(M, INP, G, bx, INROT);
#endif
        pg8::EpiInProj E{WSB(WS_CQ), WSB(WS_CKV), WSB(WS_KR), WSB(WS_BG), WSB(WS_U), WSB(WS_G), SSQQ, SSQKV, COS, SIN, b_gate, rep_ == 0, 0, 1.0f};
        pg8::gemm_phase<pg8::EpiInProj, pg8::StaticOrder, P1ALIGN>(ldsl + RING_OFF, g, S, E);
        if (rep_ == 0 && G == 256) {
            group_barrier(grp_cnt + 4, 4u, grp_tmo, MISC + 12); TSTAMP(3);
            const int pm1 = 8 * (bx % 8) + (bx / 8) % 8, j1 = bx / 64;
            if (j1 == 0 || j1 == 2) { pg8::Gemm g2{WSB(WS_CQ), WSB(WS_WUQ), M, 768, QL}; pg8::PanelOrder S2{pm1, j1 == 0 ? 2 : 1, j1 == 0 ? 0 : 2};
                pg8::EpiQUp E2{WSB(WS_Q), SSQQ, COS, SIN}; pg8::gemm_phase<pg8::EpiQUp, pg8::PanelOrder, true>(ldsl + RING_OFF, g2, S2, E2); }
            if (j1 == 1 || j1 == 2) { pg8::Gemm g2{WSB(WS_CKV), WSB(WS_WUKV), M, 1024, KVL}; pg8::PanelOrder S2{pm1, j1 == 1 ? 3 : 1, j1 == 1 ? 0 : 3};
                pg8::EpiKVUp E2{WSB(WS_KN), WSB(WS_V), SSQKV}; pg8::gemm_phase<pg8::EpiKVUp, pg8::PanelOrder, true>(ldsl + RING_OFF, g2, S2, E2); }
            if (j1 == 3) {
                if (bx < 224) { pg8::Gemm g{WSB(WS_MEMN), WSB(WS_WKVM), MM, 1024, D}; pg8::StaticOrder S; S.init(MM, 1024, G, bx - 192);
                    pg8::EpiKVM E{WSB(WS_KM), WSB(WS_VM)}; pg8::gemm_phase<pg8::EpiKVM, pg8::StaticOrder, true>(ldsl + RING_OFF, g, S, E); }
                else { run_titems(mk_item, N_EARLY, NITEMS, (bx - 224) * NWAVES + wave, 32 * NWAVES, (LAS float*)(ldsl + RING_OFF + wave * 16384), lane);
                    router_weights((bx - 224) * (NWAVES * 64) + tid, 32 * NWAVES * 64); }
                if (bx >= 224 && PREP_A > 0 && PREP_A < MOE_ITEMS) moe_prep(ws, ARGF(24), ARGF(25), ARGF(19), 0, PREP_A, (bx - 224) * NWAVES + wave, 32 * NWAVES, (LAS float*)(ldsl + RING_OFF + wave * 16384), lane);
                if (SEAM3_BATCH) {
                    asm volatile("s_waitcnt vmcnt(0)" ::: "memory"); __syncthreads();
                    if (tid == 0) { __builtin_amdgcn_fence(__ATOMIC_RELEASE, "agent"); asm volatile("s_waitcnt vmcnt(0)" ::: "memory"); (void)xb_add((unsigned*)(ctl + CW_GRP) + 64 * 16 + 8, 1u); }
                }
            }
        }
    }
    if (IN(1) && IN(2)) { if (GROUPBAR && BATCHBAR && G == 256) group_barrier((unsigned*)(ctl + CW_GRP) + 64 * (bx % 8) + 8, 32u, grp_tmo, MISC + 13); else xcd_barrier(bar); } TSTAMP(2);
    if (IN(3)) REP(3) {
        const float* conv_w = ARGF(10);
        {
            const int c = (tid & 63) * 8;
            const f32x4 w0a = *(const f32x4*)(conv_w + c), w0b = *(const f32x4*)(conv_w + c + 4), w1a = *(const f32x4*)(conv_w + CW + c), w1b = *(const f32x4*)(conv_w + CW + c + 4),
                        w2a = *(const f32x4*)(conv_w + 2 * CW + c), w2b = *(const f32x4*)(conv_w + 2 * CW + c + 4);
            auto cld = [&](int m, v4u (&r)[4]) { const int s = m % SEQ; const bf16* Ub = (const bf16*)(ws + WS_U) + (size_t)m * CW + c;
#ifdef NT_CONV
                r[0] = *(const v4u*)Ub; r[1] = *(const v4u*)(s >= 1 ? Ub - CW : Ub); r[2] = *(const v4u*)(s >= 2 ? Ub - 2 * CW : Ub); r[3] = __builtin_nontemporal_load((const v4u*)((const bf16*)(ws + WS_BG) + (size_t)m * CW + c)); };
#else
                r[0] = *(const v4u*)Ub; r[1] = *(const v4u*)(s >= 1 ? Ub - CW : Ub); r[2] = *(const v4u*)(s >= 2 ? Ub - 2 * CW : Ub); r[3] = *(const v4u*)((const bf16*)(ws + WS_BG) + (size_t)m * CW + c); };
#endif
            auto cfin = [&](int m, const v4u (&r)[4]) { const int s = m % SEQ; f32x4 u0a, u0b, u1a, u1b, u2a, u2b, ba, bb; const f32x4 z = {0.f, 0.f, 0.f, 0.f};
                pg8::unpack8(r[0], u2a, u2b); pg8::unpack8(r[1], u1a, u1b); pg8::unpack8(r[2], u0a, u0b); pg8::unpack8(r[3], ba, bb);
                if (s < 1) { u1a = z; u1b = z; } if (s < 2) { u0a = z; u0b = z; }
                *(v4u*)((bf16*)(ws + WS_CONV) + (size_t)m * CW + c) = pg8::pack8(ba * (w0a * u0a + w1a * u1a + w2a * u2a), bb * (w0b * u0b + w1b * u1b + w2b * u2b)); };
            v4u ra[4], rb[4], rc[4], rd[4];
            const bool bl = GROUPBAR && BATCHBAR && G == 256; const int NIT = bl ? SEQ * (CW / 8) : M * (CW / 8), lt = bl ? (bx / 8) * (NWAVES * 64) + tid : gt, LNT = bl ? 32 * NWAVES * 64 : NGT, mb0 = bl ? (bx % 8) * SEQ : 0;
            for (int i = lt; i < NIT; i += 4 * LNT) { const int m0 = mb0 + (i >> 6), i1 = i + LNT, i2 = i + 2 * LNT, i3 = i + 3 * LNT; const bool v1 = i1 < NIT, v2 = i2 < NIT, v3 = i3 < NIT;
                const int m1 = v1 ? mb0 + (i1 >> 6) : m0, m2 = v2 ? mb0 + (i2 >> 6) : m0, m3 = v3 ? mb0 + (i3 >> 6) : m0;
                cld(m0, ra); cld(m1, rb); cld(m2, rc); cld(m3, rd); cfin(m0, ra); if (v1) cfin(m1, rb); if (v2) cfin(m2, rc); if (v3) cfin(m3, rd); }
        }
        TSTAMP(12);
        for (int v = vcu; v < 256; v += G) {
            const int bh = v >> 2, b = bh >> 3, h = bh & 7, s4 = v & 3;
            for (int k = 0; k < 2; ++k) { const int qb = k ? 7 - s4 : s4; const size_t row0 = (size_t)b * SEQ + qb * 256, key0 = (size_t)b * SEQ;
                att::attn_unit<att::MlaCfg>(WSB(WS_Q) + row0 * 768 + h * 64, WSB(WS_Q) + row0 * 768 + 512 + h * 32, WSB(WS_KN) + key0 * 512 + h * 64, WSB(WS_KR) + key0 * 32,
                                             WSB(WS_V) + key0 * 512 + h * 64, WSB(WS_ATT) + row0 * 512 + h * 64, qb * 256, 4 * (qb + 1), (char*)lds + RING_OFF); }
        }
        __syncthreads();
    }
    if (IN(3) && IN(4)) {
        if (GROUPBAR && BATCHBAR && SEAM3_BATCH && G == 256) {
            if (tid == 0) { unsigned sp = 0; while (xb_ld((unsigned*)(ctl + CW_GRP) + 64 * 16 + 8) < 64u) { __builtin_amdgcn_s_sleep(1); if ((++sp & 255u) == 0u) { if (xb_ld(grp_tmo)) break; if (sp > XB_SPIN_CAP) { atomicAdd(grp_tmo, 1u); break; } } } }
            group_barrier((unsigned*)(ctl + CW_GRP) + 64 * (bx % 8) + 8, 64u, grp_tmo, MISC + 13);
        } else xcd_barrier(bar);
    } TSTAMP(4);
    if (IN(4)) REP(4) {
#if DESYNC_US > 0
        if (G == 256 && ((bx >> 3) & 1)) { const unsigned long long t0 = __builtin_amdgcn_s_memrealtime(); while (__builtin_amdgcn_s_memrealtime() - t0 < (unsigned long long)(DESYNC_US) * 100ull) __builtin_amdgcn_s_sleep(16); }
#endif
        { pg8::Gemm g{WSB(WS_ATT), WSB(WS_WA), M, D, 512}; pg8::StaticOrder S; S.init(M, D, G, bx);
          pg8::EpiMix<false> E{WSB(WS_MIX), WSB(WS_G)}; pg8::gemm_phase<pg8::EpiMix<false>, pg8::StaticOrder, SUALIGN>(ldsl + RING_OFF, g, S, E); }
        { pg8::Gemm g{WSB(WS_CONV), WSB(WS_WB), M, D, 512}; pg8::StaticOrder S; S.init(M, D, G, bx);
          pg8::EpiMix<true> E{WSB(WS_MIX), WSB(WS_G)}; pg8::gemm_phase<pg8::EpiMix<true>, pg8::StaticOrder, SUALIGN>(ldsl + RING_OFF, g, S, E); }
    }
    GSEAM(4, 0);
    if (IN(5)) REP(5) {
        const float* x = ARGF(0);
        pg8::Gemm g{WSB(WS_MIX), WSB(WS_WOUT), M, D, D}; pg8::StaticOrder S; S.init(M, D, G, bx);
        pg8::EpiResid<float> E{x, WSB(WS_X1B), SSQ1, rep_ == 0, (LAS pg8::ssq_t*)(ldsl + GTAB_OFF)}; pg8::gemm_phase<pg8::EpiResid<float>, pg8::StaticOrder, SUALIGN>(ldsl + RING_OFF, g, S, E);
    }
    GSEAM(5, 1);
    if (IN(6)) REP(6) {
        pg8::Gemm g{WSB(WS_X1B), WSB(WS_WQM), M, 512, D}; pg8::StaticOrder S; S.init(M, 512, G, bx);
        pg8::EpiScaleRows E{WSB(WS_QM), 512, SSQ1}; pg8::gemm_phase<pg8::EpiScaleRows, pg8::StaticOrder, SUALIGN>(ldsl + RING_OFF, g, S, E);
        if (rep_ == 0 && bx >= 128) moe_prep(ws, ARGF(24), ARGF(25), ARGF(19), PREP_A, PREP_B, (bx - 128) * NWAVES + wave, 128 * NWAVES, (LAS float*)(ldsl + RING_OFF + wave * 16384), lane);
    }
    GSEAM(6, 2);
    if (IN(7)) REP(7) {
        for (int v = bx; v < 256; v += G) {
            const int pmv = 8 * (v % 8) + (v / 8) % 8, b = pmv >> 3, qb = pmv & 7, h = v / 64; const size_t row0 = (size_t)b * SEQ + qb * 256, key0 = (size_t)b * MEM;
            att::attn_unit<att::XatCfg>(WSB(WS_QM) + row0 * 512 + h * 128, nullptr, WSB(WS_KM) + key0 * 512 + h * 128, nullptr, WSB(WS_VM) + key0 * 512 + h * 128,
                                         WSB(WS_OM) + row0 * 512 + h * 128, 0, MEM / 64, (char*)lds + RING_OFF);
        }
        __syncthreads();
    }
    GSEAM(7, 3);
    if (IN(8)) REP(8) {
        pg8::Gemm g{WSB(WS_OM), WSB(WS_WOM), M, D, 512}; pg8::StaticOrder S; S.init(M, D, G, bx);
        pg8::EpiResid<bf16> E{WSB(WS_X1B), WSB(WS_X2B), SSQ2, rep_ == 0, (LAS pg8::ssq_t*)(ldsl + GTAB_OFF)}; pg8::gemm_phase<pg8::EpiResid<bf16>, pg8::StaticOrder, SUALIGN>(ldsl + RING_OFF, g, S, E);
    }
    GSEAM(8, 4);
    if (IN(9)) REP(9) {
        const float* b_rg = ARGF(21); const float* b_re = ARGF(23);
        pg8::Gemm g{WSB(WS_X2B), WSB(WS_WR), M, 256, D}; pg8::StaticOrder S; S.init(M, 256, G, bx);
        pg8::EpiRouter E{LOG};
#ifdef PVAR
        if (rep_ == 0)
#endif
        pg8::gemm_phase<pg8::EpiRouter, pg8::StaticOrder, SUALIGN>(ldsl + RING_OFF, g, S, E);
#ifdef PVAR
        if (rep_ == 1 && bx >= 256 - PVAR) moe_prep(ws, ARGF(24), ARGF(25), ARGF(19), PREP_B, MOE_ITEMS - PREP_P0V, (bx - (256 - PVAR)) * NWAVES + wave, PVAR * NWAVES, (LAS float*)(ldsl + RING_OFF + wave * 16384), lane, WS_XN, WS_XN + (64ull << 20));
#endif
        if (rep_ == 0 && bx >= 64) moe_prep(ws, ARGF(24), ARGF(25), ARGF(19), PREP_B, MOE_ITEMS - PREP_P0V - (G == 256 ? PREP_R : 0), (bx - 64) * NWAVES + wave, 192 * NWAVES, (LAS float*)(ldsl + RING_OFF + wave * 16384), lane);
        VM_WAIT(); __syncthreads();
        if (rep_ == 0)
        { pg8::Unit ur; if (S.next(0, ur) && tid < 256) { const int n = ur.pm * 256 + tid;
            const float rs = 1.0f / sqrtf(pg8::ssq_get(SSQ2 + n) * (1.0f / D) + EPS); const float* L = LOG + (size_t)n * 128;
            float gl[NG]; float gm = -3.0e38f; int gi = 0;
#pragma unroll
            for (int g = 0; g < NG; ++g) { gl[g] = L[g] * rs + b_rg[g]; if (gl[g] > gm) { gm = gl[g]; gi = g; } }
            float se = 0.f;
#pragma unroll
            for (int g = 0; g < NG; ++g) se += __expf(gl[g] - gm);
            const float pg = 1.0f / se;
            float v0 = -3.0e38f, v1 = -3.0e38f; int i0 = 0, i1 = 0;
            for (int e = 0; e < EPG; ++e) { const float v = L[NG + gi * EPG + e] * rs + b_re[gi * EPG + e];
                if (v > v0) { v1 = v0; i1 = i0; v0 = v; i0 = e; } else if (v > v1) { v1 = v; i1 = e; } }
            const float e1 = __expf(v1 - v0);
            EID[2 * n] = gi * EPG + i0; EID[2 * n + 1] = gi * EPG + i1; EW[2 * n] = pg / (1.0f + e1); EW[2 * n + 1] = pg * e1 / (1.0f + e1);
            { const int ea = gi * EPG + i0, eb = gi * EPG + i1;
              const int sa = (int)atomicAdd(&COUNTS[64 * ea], 1u), sb = (int)atomicAdd(&COUNTS[64 * eb], 1u);
              RIDX2[ea * RCAP + sa] = n; RIDX2[eb * RCAP + sb] = n; SLOT[2 * n] = sa; SLOT[2 * n + 1] = sb; }
        } }
        if (rep_ == 0 && bx < 64 && G == 256 && PREP_R > 0) moe_prep(ws, ARGF(24), ARGF(25), ARGF(19), MOE_ITEMS - PREP_P0V - PREP_R, MOE_ITEMS - PREP_P0V, bx * NWAVES + wave, 64 * NWAVES, (LAS float*)(ldsl + RING_OFF + wave * 16384), lane);
    }
    SEAM(10);
    if (IN(12) || IN(13)) {
        LAS int* texp = (LAS int*)(ldsl + TEXP_OFF); LAS int* gtab = (LAS int*)(ldsl + GTAB_OFF); LAS int* offs = (LAS int*)(ldsl + OFFS_OFF);
        LAS int* cnts = offs + 128;
        LAS int* tord = (LAS int*)(ldsl + TORD_OFF);
        if (tid < NE) {
            const int cn = (int)__hip_atomic_load(&COUNTS[64 * tid], RLX_AGENT); cnts[tid] = cn;
            const int t = (cn + 255) / 256; int s = t;
#pragma unroll
            for (int d = 1; d < 64; d <<= 1) { const int o = __shfl_up(s, d, 64); if (lane >= d) s += o; }
            offs[tid] = (s - t) * 256; if (tid == NE - 1) offs[64] = s;
        }
        __syncthreads();
        if (tid < NTILE_MAX) { int lo_ = 0, hi_ = NE - 1;
            const int r0 = tid * 256;
            while (lo_ < hi_) { const int mid = (lo_ + hi_ + 1) >> 1; if (offs[mid] <= r0) lo_ = mid; else hi_ = mid - 1; }
            while (lo_ > 0 && cnts[lo_] == 0) --lo_;
            texp[tid] = lo_; tord[tid] = tid; }
        __syncthreads();
        const int ntiles = __builtin_amdgcn_readfirstlane(offs[64]);
        if (IN(12)) {
            unsigned* tready = (unsigned*)(ctl + CW_TREADY);
            for (int rep12 = 0; rep12 < ((((REPMASK) >> 12) & 1) ? 2 : 1); ++rep12) {
            {
                int tok_[4], tile_[4]; float q_[4]; bool ok_[4];
#pragma unroll
                for (int i = 0; i < 4; ++i) { const int L = i * G + vcu; ok_[i] = (L < ntiles * 2) && (tid < 256); tok_[i] = 0; tile_[i] = 0;
                    if (ok_[i]) { const int tile = tord[L >> 1] & 0xffff, e = texp[tile], s = tile * 256 - offs[e] + tid; tile_[i] = tile; tok_[i] = (s < cnts[e]) ? RIDX2[e * RCAP + s] : 0; } }
#pragma unroll
                for (int i = 0; i < 4; ++i) { q_[i] = 0.f; if (ok_[i]) q_[i] = pg8::ssq_get(SSQ2 + tok_[i]); }
#pragma unroll
                for (int i = 0; i < 4; ++i) if (ok_[i]) { gtab[i * 256 + tid] = tok_[i]; ((float*)RIDX)[tile_[i] * 256 + tid] = __builtin_amdgcn_rsqf(q_[i] * (1.0f / D) + EPS); }
            }
            VM_WAIT(); __syncthreads();
            { pg8::Gemm g{WSB(WS_X2B), WSB(WS_WGU), PMAX, NE * 512, D}; pg8::MoeUpOrder S{ntiles, G, vcu, texp, tord, tready};
              pg8::EpiGateUp E{WSB(WS_HH), (const float*)RIDX}; pg8::gemm_phase<pg8::EpiGateUp, pg8::MoeUpOrder, MOEUPALIGN, true>(ldsl + RING_OFF, g, S, E, gtab); }
            { pg8::Gemm g{WSB(WS_HH), WSB(WS_WDN), PMAX, NE * D, FF}; pg8::MoeDownOrder S{ntiles, G, vcu, texp, tord, tready, (unsigned*)(ctl + CW_BAR) + XB_TMO};
              pg8::EpiDown E{WSB(WS_YD)}; pg8::gemm_phase<pg8::EpiDown, pg8::MoeDownOrder, MOEALIGN>(ldsl + RING_OFF, g, S, E); }
            }
        }
    }
    SEAM(13);
    if (IN(14)) REP(14) {
        const float* g_final = ARGF(26);
        LAS int* offs = (LAS int*)(ldsl + OFFS_OFF);
        __syncthreads();
        if (tid < NE) {
            const int cn = (int)__hip_atomic_load(&COUNTS[64 * tid], RLX_AGENT); const int t = (cn + 255) / 256; int s = t;
#pragma unroll
            for (int d = 1; d < 64; d <<= 1) { const int o = __shfl_up(s, d, 64); if (lane >= d) s += o; }
            offs[tid] = (s - t) * 256;
        }
        __syncthreads();
        {
            typedef unsigned long long u64;
            const GAS f32x4* gr = (const GAS f32x4*)g_final + lane; f32x4 gg[4];
#pragma unroll
            for (int j = 0; j < 4; ++j) gg[j] = gr[64 * j];
            u64 ra[2][4], rb[2][4], rx[2][4]; float w0[2], w1[2];
            const int R = (M - gw + NGW - 1) / NGW;
            for (int base = 0; base < R; base += 64) {
            const int nr = (R - base < 64) ? R - base : 64;
            int ms0 = 0, ms1 = 0; float mw0 = 0.f, mw1 = 0.f;
            if (lane < nr) { const int mm = gw + (base + lane) * NGW; ms0 = offs[EID[2 * mm]] + SLOT[2 * mm]; ms1 = offs[EID[2 * mm + 1]] + SLOT[2 * mm + 1]; mw0 = EW[2 * mm]; mw1 = EW[2 * mm + 1]; }
            auto ld = [&](int m, int i, int b) {
                const size_t s0 = (size_t)__builtin_amdgcn_readlane(ms0, i), s1 = (size_t)__builtin_amdgcn_readlane(ms1, i);
                w0[b] = __builtin_bit_cast(float, __builtin_amdgcn_readlane(__builtin_bit_cast(int, mw0), i)); w1[b] = __builtin_bit_cast(float, __builtin_amdgcn_readlane(__builtin_bit_cast(int, mw1), i));
                const GAS u64* xr = (const GAS u64*)(WSB(WS_X2B) + (size_t)m * D) + lane; const GAS u64* y0 = (const GAS u64*)(WSB(WS_YD) + s0 * D) + lane; const GAS u64* y1 = (const GAS u64*)(WSB(WS_YD) + s1 * D) + lane;
#ifdef NT_P14
                _Pragma("unroll") for (int j = 0; j < 4; ++j) { ra[b][j] = __builtin_nontemporal_load(y0 + 64 * j); rb[b][j] = __builtin_nontemporal_load(y1 + 64 * j); rx[b][j] = __builtin_nontemporal_load(xr + 64 * j); } };
#else
                _Pragma("unroll") for (int j = 0; j < 4; ++j) { ra[b][j] = y0[64 * j]; rb[b][j] = y1[64 * j]; rx[b][j] = xr[64 * j]; } };
#endif
            auto fin = [&](int m, int b) { f32x4 v[4]; float ss = 0.f;
                _Pragma("unroll") for (int j = 0; j < 4; ++j) { const u64 a = ra[b][j], bq = rb[b][j], xw = rx[b][j];
                    const unsigned al = (unsigned)a, ah = (unsigned)(a >> 32), bl = (unsigned)bq, bh = (unsigned)(bq >> 32), xl = (unsigned)xw, xh = (unsigned)(xw >> 32);
                    const f32x4 ya = (f32x4){pg8::bf_lo(al), pg8::bf_hi(al), pg8::bf_lo(ah), pg8::bf_hi(ah)}, yb = (f32x4){pg8::bf_lo(bl), pg8::bf_hi(bl), pg8::bf_lo(bh), pg8::bf_hi(bh)};
                    v[j] = (f32x4){pg8::bf_lo(xl), pg8::bf_hi(xl), pg8::bf_lo(xh), pg8::bf_hi(xh)} + (ya * w0[b] + yb * w1[b]); ss += (v[j].x * v[j].x + v[j].y * v[j].y) + (v[j].z * v[j].z + v[j].w * v[j].w); }
                const float rstd = 1.f / sqrtf(wave_sum(ss) * (1.f / D) + EPS);
                GAS f32x4* o = (GAS f32x4*)(args.out + (size_t)m * D) + lane;
#ifdef NT_OUT
                _Pragma("unroll") for (int j = 0; j < 4; ++j) __builtin_nontemporal_store(v[j] * rstd * gg[j], o + 64 * j); };
#else
                _Pragma("unroll") for (int j = 0; j < 4; ++j) o[64 * j] = v[j] * rstd * gg[j]; };
#endif
            const int mend = gw + (base + nr) * NGW;
            int m = gw + base * NGW, i = 0; if (m < mend) ld(m, 0, 0);
            while (m < mend) {
                const int m1 = m + NGW; if (m1 < mend) ld(m1, i + 1, 1);
                fin(m, 0); if (m1 >= mend) break;
                const int m2 = m1 + NGW; if (m2 < mend) ld(m2, i + 2, 0);
                fin(m1, 1); m = m2; i += 2;
            }
            }
        }
    }
#ifdef TSPROBE
    TSTAMP(15); __syncthreads();
    if (bx == 0 && tid == 0) { asm volatile("s_waitcnt vmcnt(0)" ::: "memory"); const unsigned long long* T = (const unsigned long long*)(ctl + 512);
        unsigned long long a = T[TSPROBE], b = 0; for (int i = TSPROBE + 1; i <= 15; ++i) { b = __hip_atomic_load(&T[i], RLX_AGENT); if (b > a) break; }
        float tv = (float)(b - __hip_atomic_load(&T[TSPROBE], RLX_AGENT)) * 0.01f;
#ifdef TSMID
        tv = (float)(__hip_atomic_load(&T[3], RLX_AGENT) - __hip_atomic_load(&T[1], RLX_AGENT)) * 0.01f;
#endif
#ifdef TSTAIL
        tv = (float)(__hip_atomic_load(&T[2], RLX_AGENT) - __hip_atomic_load(&T[3], RLX_AGENT)) * 0.01f;
#endif
#ifdef TSCONV
        tv = (float)(__hip_atomic_load(&T[12], RLX_AGENT) - __hip_atomic_load(&T[2], RLX_AGENT)) * 0.01f;
#endif
#ifdef TSTOTAL
        tv = (float)(__hip_atomic_load(&T[15], RLX_AGENT) - __hip_atomic_load(&T[0], RLX_AGENT)) * 0.01f;
#endif
#ifdef TSQ
        tv = floorf(tv / (float)(TSQ)) * (float)(TSQ);
#endif
        args.out[0] = tv; }
#endif
#undef IN
#undef SEAM
#undef WSB
}
#if MODE >= 1 && MODE <= 5
constexpr int NV_PMAX = M * 2 + NE * 64, NV_NTILES = NV_PMAX / 64;
template <typename TA> __device__ __forceinline__ float4 ld4(const TA* p);
template <> __device__ __forceinline__ float4 ld4<float>(const float* p) { return *(const float4*)p; }
template <> __device__ __forceinline__ float4 ld4<bf16>(const bf16* p) { const uint2 w = *(const uint2*)p; return make_float4(pg8::bf_lo(w.x), pg8::bf_hi(w.x), pg8::bf_lo(w.y), pg8::bf_hi(w.y)); }
template <typename TA> __global__ __launch_bounds__(256) void k_gemm(const TA* __restrict__ A, int lda, const float* __restrict__ B, int ldb, float* __restrict__ C, int ldc,
                                              int Mr, int N, int K, const int* __restrict__ rowidx, const int* __restrict__ tile_group, long b_group_stride) {
    __shared__ float As[16][65];
    __shared__ float Bs[16][64];
    const int tx = threadIdx.x & 15, ty = threadIdx.x >> 4;
    const int m0 = blockIdx.y * 64, n0 = blockIdx.x * 64;
    const float* Bg = B;
    if (tile_group) { const int g = tile_group[blockIdx.y]; if (g < 0) return; Bg = B + (long)g * b_group_stride; }
    float acc[4][4];
#pragma unroll
    for (int i = 0; i < 4; ++i)
#pragma unroll
        for (int j = 0; j < 4; ++j) acc[i][j] = 0.f;
    const int ar = threadIdx.x >> 2, ak = (threadIdx.x & 3) * 4;
    const int arow = m0 + ar; long asrc = -1;
    if (arow < Mr) asrc = rowidx ? (long)rowidx[arow] : (long)arow;
    const int bk = threadIdx.x >> 4, bn = (threadIdx.x & 15) * 4;
    for (int k0 = 0; k0 < K; k0 += 16) {
        float4 av = make_float4(0.f, 0.f, 0.f, 0.f);
        if (asrc >= 0) av = ld4<TA>(A + asrc * lda + k0 + ak);
        As[ak + 0][ar] = av.x; As[ak + 1][ar] = av.y; As[ak + 2][ar] = av.z; As[ak + 3][ar] = av.w;
#pragma unroll
        for (int j = 0; j < 4; ++j) { const int n = n0 + bn + j; Bs[bk][bn + j] = (n < N) ? Bg[(long)(k0 + bk) * ldb + n] : 0.f; }
        __syncthreads();
#pragma unroll
        for (int kk = 0; kk < 16; ++kk) {
            float a0 = As[kk][ty * 4 + 0], a1 = As[kk][ty * 4 + 1], a2 = As[kk][ty * 4 + 2], a3 = As[kk][ty * 4 + 3];
            float b0 = Bs[kk][tx * 4 + 0], b1 = Bs[kk][tx * 4 + 1], b2 = Bs[kk][tx * 4 + 2], b3 = Bs[kk][tx * 4 + 3];
            acc[0][0] += a0 * b0; acc[0][1] += a0 * b1; acc[0][2] += a0 * b2; acc[0][3] += a0 * b3;
            acc[1][0] += a1 * b0; acc[1][1] += a1 * b1; acc[1][2] += a1 * b2; acc[1][3] += a1 * b3;
            acc[2][0] += a2 * b0; acc[2][1] += a2 * b1; acc[2][2] += a2 * b2; acc[2][3] += a2 * b3;
            acc[3][0] += a3 * b0; acc[3][1] += a3 * b1; acc[3][2] += a3 * b2; acc[3][3] += a3 * b3;
        }
        __syncthreads();
    }
#pragma unroll
    for (int i = 0; i < 4; ++i) { const int r = m0 + ty * 4 + i; if (r >= Mr) continue;
#pragma unroll
        for (int j = 0; j < 4; ++j) { const int c = n0 + tx * 4 + j; if (c < N) C[(long)r * ldc + c] = acc[i][j]; } }
}
__global__ __launch_bounds__(64) void k_rmsnorm(const float* __restrict__ in, int ldi, const float* __restrict__ g, float* __restrict__ out, int ldo, int cols) {
    const long r = blockIdx.x; const int lane = threadIdx.x;
    float s = 0.f;
    for (int c = lane; c < cols; c += 64) { const float v = in[r * ldi + c]; s += v * v; }
    s = wave_sum(s);
    const float rs = 1.0f / sqrtf(s / (float)cols + EPS);
    for (int c = lane; c < cols; c += 64) out[r * ldo + c] = in[r * ldi + c] * rs * g[c];
}
__global__ void k_add(const float* __restrict__ a, const float* __restrict__ b, float* __restrict__ o) {
    const long i = (long)blockIdx.x * blockDim.x + threadIdx.x; o[i] = a[i] + b[i];
}
__global__ __launch_bounds__(64) void k_xattn(const float* __restrict__ QM, const float* __restrict__ KVM, float* __restrict__ OM) {
    const int h = blockIdx.y, half = blockIdx.z; const long m = (long)blockIdx.x * 64 + threadIdx.x; const int b = (int)(m / SEQ);
    float q[XD], o[64];
#pragma unroll
    for (int d = 0; d < XD; ++d) q[d] = QM[m * (XH * XD) + h * XD + d];
#pragma unroll
    for (int d = 0; d < 64; ++d) o[d] = 0.f;
    float mr = -1e30f, l = 0.f; const float scale = 1.0f / sqrtf((float)XD);
    for (int j = 0; j < MEM; ++j) {
        const float* k = KVM + ((long)b * MEM + j) * (2 * XH * XD) + h * XD; const float* v = k + XH * XD + half * 64;
        float sc = 0.f;
#pragma unroll
        for (int d = 0; d < XD; ++d) sc += q[d] * k[d];
        sc *= scale;
        const float mn = fmaxf(mr, sc), al = expf(mr - mn), p = expf(sc - mn);
        l = l * al + p;
#pragma unroll
        for (int d = 0; d < 64; ++d) o[d] = o[d] * al + p * v[d];
        mr = mn;
    }
    const float il = 1.0f / l;
#pragma unroll
    for (int d = 0; d < 64; ++d) OM[m * (XH * XD) + h * XD + half * 64 + d] = o[d] * il;
}
__global__ void k_route(const float* __restrict__ GL, const float* __restrict__ EL, const float* __restrict__ brg, const float* __restrict__ bre,
                        int* __restrict__ eid, float* __restrict__ ew, int* __restrict__ counts) {
    const int n = blockIdx.x * blockDim.x + threadIdx.x; if (n >= M) return;
    float gl[NG]; float gm = -1e30f; int gi = 0;
#pragma unroll
    for (int g = 0; g < NG; ++g) { gl[g] = GL[(long)n * NG + g] + brg[g]; if (gl[g] > gm) { gm = gl[g]; gi = g; } }
    float se = 0.f;
#pragma unroll
    for (int g = 0; g < NG; ++g) se += expf(gl[g] - gm);
    const float pg = 1.0f / se;
    float v0 = -1e30f, v1 = -1e30f; int i0 = 0, i1 = 0;
    for (int e = 0; e < EPG; ++e) { const float v = EL[(long)n * NE + gi * EPG + e] + bre[gi * EPG + e];
        if (v > v0) { v1 = v0; i1 = i0; v0 = v; i0 = e; } else if (v > v1) { v1 = v; i1 = e; } }
    const float e1 = expf(v1 - v0), w0 = pg / (1.0f + e1), w1 = pg * e1 / (1.0f + e1);
    eid[2 * n] = gi * EPG + i0; eid[2 * n + 1] = gi * EPG + i1; ew[2 * n] = w0; ew[2 * n + 1] = w1;
    atomicAdd(&counts[gi * EPG + i0], 1); atomicAdd(&counts[gi * EPG + i1], 1);
}
__global__ void k_scan(const int* __restrict__ counts, int* __restrict__ offs, int* __restrict__ cursor, int* __restrict__ tile_group, int* __restrict__ rowidx) {
    __shared__ int so[NE + 1];
    if (threadIdx.x == 0) { int a = 0; for (int e = 0; e < NE; ++e) { so[e] = a; a += (counts[e] + 63) / 64 * 64; } so[NE] = a; }
    __syncthreads();
    if (threadIdx.x < NE) { offs[threadIdx.x] = so[threadIdx.x]; cursor[threadIdx.x] = 0; }
    for (int t = threadIdx.x; t < NV_NTILES; t += blockDim.x) { int g = -1; const int r = t * 64; if (r < so[NE]) { for (int e = 0; e < NE; ++e) if (r >= so[e] && r < so[e + 1]) g = e; } tile_group[t] = g; }
    for (int r = threadIdx.x; r < NV_PMAX; r += blockDim.x) rowidx[r] = -1;
}
__global__ void k_scatter(const int* __restrict__ eid, const int* __restrict__ offs, int* __restrict__ cursor, int* __restrict__ rowidx, int* __restrict__ slot) {
    const int i = blockIdx.x * blockDim.x + threadIdx.x; if (i >= 2 * M) return;
    const int e = eid[i]; const int p = offs[e] + atomicAdd(&cursor[e], 1);
    rowidx[p] = i >> 1; slot[i] = p;
}
__global__ void k_silu(const float* __restrict__ GU, float* __restrict__ HH) {
    const long i = (long)blockIdx.x * blockDim.x + threadIdx.x; const long r = i >> 8; const int c = (int)(i & 255);
    const float g = GU[r * 512 + c], u = GU[r * 512 + 256 + c];
    HH[i] = g / (1.0f + expf(-g)) * u;
}
__global__ __launch_bounds__(64) void k_final(const float* __restrict__ X2, const float* __restrict__ YD, const int* __restrict__ slot, const float* __restrict__ ew,
                                              const float* __restrict__ g, float* __restrict__ out) {
    const long m = blockIdx.x; const int lane = threadIdx.x;
    const long s0 = slot[2 * m], s1 = slot[2 * m + 1]; const float w0 = ew[2 * m], w1 = ew[2 * m + 1];
    float v[16]; float ss = 0.f;
#pragma unroll
    for (int j = 0; j < 16; ++j) { const int c = lane + 64 * j; v[j] = X2[m * D + c] + (w0 * YD[s0 * D + c] + w1 * YD[s1 * D + c]); ss += v[j] * v[j]; }
    ss = wave_sum(ss); const float rs = 1.0f / sqrtf(ss / (float)D + EPS);
#pragma unroll
    for (int j = 0; j < 16; ++j) { const int c = lane + 64 * j; out[m * D + c] = v[j] * rs * g[c]; }
}

__global__ __launch_bounds__(64) void k_mla_attn_b(const bf16* __restrict__ Q, const bf16* __restrict__ KN, const bf16* __restrict__ KR, const bf16* __restrict__ V, float* __restrict__ O) {
    const int h = blockIdx.y; const long m = (long)blockIdx.x * 64 + threadIdx.x; const int b = (int)(m / SEQ), s = (int)(m % SEQ);
    const int smax = (int)(((long)blockIdx.x * 64) % SEQ) + 63;
    float q[DQK], o[DV];
#pragma unroll
    for (int d = 0; d < DN; ++d) q[d] = pg8::bf_lo(Q[m * 768 + h * 64 + d]);
#pragma unroll
    for (int d = 0; d < DR; ++d) q[DN + d] = pg8::bf_lo(Q[m * 768 + 512 + h * 32 + d]);
#pragma unroll
    for (int d = 0; d < DV; ++d) o[d] = 0.f;
    float mr = -1e30f, l = 0.f; const float scale = 1.0f / sqrtf((float)DQK);
    for (int j = 0; j <= smax; ++j) {
        const long mk = (long)b * SEQ + j;
        const bf16* kn = KN + mk * 512 + h * 64; const bf16* kr = KR + mk * 32; const bf16* vv = V + mk * 512 + h * 64;
        float sc = 0.f;
#pragma unroll
        for (int d = 0; d < DN; ++d) sc += q[d] * pg8::bf_lo(kn[d]);
#pragma unroll
        for (int d = 0; d < DR; ++d) sc += q[DN + d] * pg8::bf_lo(kr[d]);
        sc *= scale;
        if (j <= s) {
            const float mn = fmaxf(mr, sc), al = expf(mr - mn), p = expf(sc - mn);
            l = l * al + p;
#pragma unroll
            for (int d = 0; d < DV; ++d) o[d] = o[d] * al + p * pg8::bf_lo(vv[d]);
            mr = mn;
        }
    }
    const float il = 1.0f / l;
#pragma unroll
    for (int d = 0; d < DV; ++d) O[m * (NH * DV) + h * DV + d] = o[d] * il;
}
__global__ void k_mix_b(const bf16* __restrict__ G, float* __restrict__ BA, const float* __restrict__ BB) {
    const long i = (long)blockIdx.x * blockDim.x + threadIdx.x; const long m = i >> 10; const int c = (int)(i & 1023);
    BA[i] = pg8::bf_lo(G[m * 2048 + c]) * BA[i] + pg8::bf_lo(G[m * 2048 + 1024 + c]) * BB[i];
}
__global__ void k_cvt_b(const bf16* __restrict__ a, float* __restrict__ o) { const long i = (long)blockIdx.x * blockDim.x + threadIdx.x; o[i] = pg8::bf_lo(a[i]); }

__global__ void k_ovr_g(const float* __restrict__ GLOG, const float* __restrict__ bg, bf16* __restrict__ G, int half) {
    const long i = (long)blockIdx.x * blockDim.x + threadIdx.x; const long m = i >> 10; const int c = (int)(i & 1023);
    G[m * 2048 + half * 1024 + c] = (bf16)f2bf(1.0f / (1.0f + expf(-(GLOG[i] + bg[half * 1024 + c]))));
}
__global__ void k_ovr_conv(const float* __restrict__ BCX, const float* __restrict__ cw, bf16* __restrict__ CONV) {
    const long m = blockIdx.x; const int c = threadIdx.x; const int s = (int)(m % SEQ);
    const float* p = BCX + m * 1536;
    float y = cw[2 * CW + c] * (p[CW + c] * p[2 * CW + c]);
    if (s >= 1) y += cw[1 * CW + c] * (p[-1536 + CW + c] * p[-1536 + 2 * CW + c]);
    if (s >= 2) y += cw[0 * CW + c] * (p[-3072 + CW + c] * p[-3072 + 2 * CW + c]);
    CONV[m * CW + c] = (bf16)f2bf(p[c] * y);
}
__global__ void k_ovr_qkv(const float* __restrict__ Qf, const float* __restrict__ KVf, const float* __restrict__ P416, const int* __restrict__ pos,
                          bf16* __restrict__ Q, bf16* __restrict__ KN, bf16* __restrict__ V, bf16* __restrict__ KR) {
    const long m = blockIdx.x; const int t = threadIdx.x;
    { const int h = t >> 7, d = t & 127; const float v = KVf[m * 1024 + t]; if (d < 64) KN[m * 512 + h * 64 + d] = (bf16)f2bf(v); else V[m * 512 + h * 64 + (d - 64)] = (bf16)f2bf(v); }
    if (t < 768) { const int h = t / 96, d = t % 96; if (d < 64) Q[m * 768 + h * 64 + d] = (bf16)f2bf(Qf[m * 768 + t]); }
    if (t < 128) { const int h = t >> 4, j = t & 15; const float inv = powf(10000.0f, -(float)(2 * j) / 32.0f); const float ang = (float)pos[m] * inv; const float c = cosf(ang), s = sinf(ang);
        const float x1 = Qf[m * 768 + h * 96 + 64 + j], x2 = Qf[m * 768 + h * 96 + 80 + j];
        Q[m * 768 + 512 + h * 32 + rope_pos(j)] = (bf16)f2bf(x1 * c - x2 * s); Q[m * 768 + 512 + h * 32 + rope_pos(16 + j)] = (bf16)f2bf(x1 * s + x2 * c);
        if (h == 0) { const float k1 = P416[m * 416 + 384 + j], k2 = P416[m * 416 + 400 + j]; KR[m * 32 + rope_pos(j)] = (bf16)f2bf(k1 * c - k2 * s); KR[m * 32 + rope_pos(16 + j)] = (bf16)f2bf(k1 * s + k2 * c); } }
}

#ifdef DIAG
__global__ void k_diag_cmp(const bf16* __restrict__ G, const bf16* __restrict__ G2, unsigned* __restrict__ cnt) {
    const long i = (long)blockIdx.x * blockDim.x + threadIdx.x; const long m = i >> 11; const int c = (int)(i & 2047);
    const float d = fabsf(pg8::bf_lo(G[i]) - pg8::bf_lo(G2[i]));
    int cls = DIAG_CLS(m, c);
    if (d > 0.02f) atomicAdd(&cnt[cls], 1u);
    atomicAdd(&cnt[8 + cls], 1u);
}
__global__ void k_diag_enc(float* __restrict__ out, const unsigned* __restrict__ cnt) {
    const long i = (long)blockIdx.x * blockDim.x + threadIdx.x;
    const float f0 = (float)cnt[0] / fmaxf((float)cnt[8], 1.f), f1 = (float)cnt[1] / fmaxf((float)cnt[9], 1.f);
    (void)f0; (void)f1; out[i] = (i == 0) ? (100.0f + 100.0f * (float)(cnt[0] > (unsigned)(DIAG_GAIN)) + 200.0f * (float)(cnt[0] > (unsigned)(DIAG_GAIN * 100.0f))) : 0.0f;
}
#endif
template <typename TA> static void gemm(hipStream_t st, const TA* A, int lda, const float* B, int ldb, float* C, int ldc, int Mr, int N, int K,
                 const int* rowidx = nullptr, const int* tg = nullptr, long gs = 0) {
    dim3 grid((N + 63) / 64, (Mr + 63) / 64);
    hipLaunchKernelGGL(k_gemm<TA>, grid, dim3(256), 0, st, A, lda, B, ldb, C, ldc, Mr, N, K, rowidx, tg, gs);
}
#endif

extern "C" void kernel_launch(void* const* d_in, const int* in_sizes, int n_in, void* d_out, int out_size, void* d_ws, size_t ws_size, hipStream_t stream) {
    static int grid = 0;
    if (grid == 0) {
        if (n_in != 27 || in_sizes[0] != M * D || out_size != M * D || ws_size < WS_END) { fprintf(stderr, "kernel_launch: unexpected shapes: n_in %d in0 %d out %d ws %zu\n", n_in, n_in > 0 ? in_sizes[0] : -1, out_size, ws_size); grid = -1; return; }
        int dev = 0, cus = 0;
        if (hipGetDevice(&dev) != hipSuccess || hipDeviceGetAttribute(&cus, hipDeviceAttributeMultiprocessorCount, dev) != hipSuccess) { grid = -1; return; }
        if (hipFuncSetAttribute((const void*)mega_fwd, hipFuncAttributeMaxDynamicSharedMemorySize, LDS_BYTES) != hipSuccess) { fprintf(stderr, "kernel_launch: hipFuncSetAttribute failed\n"); grid = -1; return; }
        (void)hipGetLastError();
        grid = cus;
        if (grid != 256) fprintf(stderr, "kernel_launch: %d CUs (built for 256)\n", grid);
    }
    if (grid < 0) return;
#ifndef NPASS
#define NPASS 1
#endif
    for (int pass_ = 0; pass_ < NPASS; ++pass_) {
    if (hipMemsetAsync((char*)d_ws + WS_CTL, 0, CTL_ZERO_BYTES, stream) != hipSuccess) return;
    Args a{};
    for (int i = 0; i < 27; ++i) a.in[i] = (const float*)d_in[i];
    a.out = (float*)d_out; a.ws = (unsigned char*)d_ws;
#ifdef DIAG
    (void)hipMemsetAsync((char*)d_ws + WS_G, 0xAA, (size_t)M * 2048 * 2, stream);
#endif
    constexpr int FAST_HI = (MODE == 1) ? 6 : (MODE == 2) ? 9 : (MODE == 3) ? 3 : (MODE == 4) ? 4 : (MODE == 5) ? 5 : NPHASE;
#if PER_PHASE
    for (int p = 0; p < FAST_HI; ++p) { a.ph_lo = p; a.ph_hi = p + 1;
#ifdef P1SPLIT
        if (p == 1) { for (int s = 0; s < 4; ++s) { a.sub = s; hipLaunchKernelGGL(mega_fwd, dim3(grid), dim3(NWAVES * 64), LDS_BYTES, stream, a); } a.sub = 0; continue; }
#endif
        hipLaunchKernelGGL(mega_fwd, dim3(grid), dim3(NWAVES * 64), LDS_BYTES, stream, a); }
#ifdef EXTRA_PHASE
    { a.ph_lo = EXTRA_PHASE; a.ph_hi = EXTRA_PHASE + 1; hipLaunchKernelGGL(mega_fwd, dim3(grid), dim3(NWAVES * 64), LDS_BYTES, stream, a); }
#endif
#else
    a.ph_lo = 0; a.ph_hi = FAST_HI;
    hipLaunchKernelGGL(mega_fwd, dim3(grid), dim3(NWAVES * 64), LDS_BYTES, stream, a);
#endif
#if MODE >= 1 && MODE <= 5
    {
        char* ws = (char*)d_ws; float* out = (float*)d_out;
        const float* mem = (const float*)d_in[1]; const float* g_xattn = (const float*)d_in[14]; const float* g_mem = (const float*)d_in[15]; const float* w_q_mem = (const float*)d_in[16];
        const float* w_kv_mem = (const float*)d_in[17]; const float* w_o_mem = (const float*)d_in[18]; const float* g_moe = (const float*)d_in[19]; const float* w_rg = (const float*)d_in[20];
        const float* b_rg = (const float*)d_in[21]; const float* w_re = (const float*)d_in[22]; const float* b_re = (const float*)d_in[23]; const float* w_gu = (const float*)d_in[24];
        const float* w_dn = (const float*)d_in[25]; const float* g_final = (const float*)d_in[26];
#define WSF(mib) ((float*)(ws + (size_t)(mib) * MiB))
        float* XA = WSF(448);
        float* X2 = XA;
#if MODE >= 3 && MODE <= 5
        {
            const float* x = (const float*)d_in[0]; const float* w_a = (const float*)d_in[11]; const float* w_b = (const float*)d_in[12]; const float* w_out = (const float*)d_in[13];
            const bf16* fQ = (const bf16*)(ws + WS_Q); const bf16* fKN = (const bf16*)(ws + WS_KN); const bf16* fKR = (const bf16*)(ws + WS_KR); const bf16* fV = (const bf16*)(ws + WS_V);
            const bf16* fATT = (const bf16*)(ws + WS_ATT); const bf16* fCONV = (const bf16*)(ws + WS_CONV); const bf16* fG = (const bf16*)(ws + WS_G); const bf16* fMIX = (const bf16*)(ws + WS_MIX);
            float* ATTf = WSF(0); float* BA = WSF(32); float* BB = WSF(347); float* T = WSF(347);
#ifdef DIAG
#define OVR_G_DST (363 * MiB)
#else
#define OVR_G_DST WS_G
#endif
#ifdef OVR
            {   const float* g_mix = (const float*)d_in[3]; const float* w_in = (const float*)d_in[4]; const float* b_gate = (const float*)d_in[5]; const float* conv_w = (const float*)d_in[10];
                const float* g_cq = (const float*)d_in[6]; const float* w_uq = (const float*)d_in[7]; const float* g_ckv = (const float*)d_in[8]; const float* w_ukv = (const float*)d_in[9]; const int* pos = (const int*)d_in[2];
                float* H = WSF(0);
                hipLaunchKernelGGL(k_rmsnorm, dim3(M), dim3(64), 0, stream, x, D, g_mix, H, D, D);
#if OVR == 1
                for (int half = 0; half < 2; ++half) { float* GLOG = WSF(64);
                    gemm<float>(stream, H, D, w_in + COL_CONV + half * 1024, IN_COLS, GLOG, 1024, M, 1024, D);
                    hipLaunchKernelGGL(k_ovr_g, dim3(M * 1024 / 256), dim3(256), 0, stream, GLOG, b_gate, (bf16*)(ws + OVR_G_DST), half); }
#ifdef DIAG
                (void)hipMemsetAsync(ws + 444 * MiB + 524288, 0, 64, stream);
                hipLaunchKernelGGL(k_diag_cmp, dim3(M * 2048 / 256), dim3(256), 0, stream, (const bf16*)(ws + WS_G), (const bf16*)(ws + OVR_G_DST), (unsigned*)(ws + 444 * MiB + 524288));
                (void)hipMemcpyAsync(ws + WS_G, ws + OVR_G_DST, (size_t)M * 2048 * 2, hipMemcpyDeviceToDevice, stream);
#endif
#elif OVR == 2
                float* BCX = WSF(347);
                gemm<float>(stream, H, D, w_in + COL_KR, IN_COLS, BCX, 1536, M, 1536, D);
                hipLaunchKernelGGL(k_ovr_conv, dim3(M), dim3(512), 0, stream, BCX, conv_w, (bf16*)(ws + WS_CONV));
#elif OVR == 3
                float* P416 = WSF(64); float* CQN = WSF(90); float* CKVN = WSF(106); float* Qf = WSF(347); float* KVf = WSF(0);
                gemm<float>(stream, H, D, w_in, IN_COLS, P416, 416, M, 416, D);
                hipLaunchKernelGGL(k_rmsnorm, dim3(M), dim3(64), 0, stream, P416, 416, g_cq, CQN, QL, QL);
                hipLaunchKernelGGL(k_rmsnorm, dim3(M), dim3(64), 0, stream, P416 + 256, 416, g_ckv, CKVN, KVL, KVL);
                gemm<float>(stream, CQN, QL, w_uq, 768, Qf, 768, M, 768, QL);
                gemm<float>(stream, CKVN, KVL, w_ukv, 1024, KVf, 1024, M, 1024, KVL);
                hipLaunchKernelGGL(k_ovr_qkv, dim3(M), dim3(1024), 0, stream, Qf, KVf, P416, pos, (bf16*)(ws + WS_Q), (bf16*)(ws + WS_KN), (bf16*)(ws + WS_V), (bf16*)(ws + WS_KR));
#endif
            }
#endif
#if MODE == 3
            hipLaunchKernelGGL(k_mla_attn_b, dim3(M / 64, NH), dim3(64), 0, stream, fQ, fKN, fKR, fV, ATTf);
            gemm<float>(stream, ATTf, 512, w_a, D, BA, D, M, D, 512);
#elif MODE == 4
            gemm<bf16>(stream, fATT, 512, w_a, D, BA, D, M, D, 512);
#endif
#if MODE == 3 || MODE == 4
            gemm<bf16>(stream, fCONV, CW, w_b, D, BB, D, M, D, CW);
            hipLaunchKernelGGL(k_mix_b, dim3(M * D / 256), dim3(256), 0, stream, fG, BA, BB);
            gemm<float>(stream, BA, D, w_out, D, T, D, M, D, D);
#else
            gemm<bf16>(stream, fMIX, D, w_out, D, T, D, M, D, D);
#endif
            hipLaunchKernelGGL(k_add, dim3(M * D / 256), dim3(256), 0, stream, x, T, WSF(448));
        }
#endif
#if MODE == 1 || (MODE >= 3 && MODE <= 5)
        float* H2 = WSF(128); float* MEMN = WSF(192); float* KVM = WSF(200); float* QM = WSF(208); float* OM = WSF(240); float* T2 = WSF(0); X2 = WSF(272);
        hipLaunchKernelGGL(k_rmsnorm, dim3(M), dim3(64), 0, stream, XA, D, g_xattn, H2, D, D);
        hipLaunchKernelGGL(k_rmsnorm, dim3(MM), dim3(64), 0, stream, mem, D, g_mem, MEMN, D, D);
        gemm<float>(stream, H2, D, w_q_mem, XH * XD, QM, XH * XD, M, XH * XD, D);
        gemm<float>(stream, MEMN, D, w_kv_mem, 2 * XH * XD, KVM, 2 * XH * XD, MM, 2 * XH * XD, D);
        hipLaunchKernelGGL(k_xattn, dim3(M / 64, XH, 2), dim3(64), 0, stream, QM, KVM, OM);
        gemm<float>(stream, OM, XH * XD, w_o_mem, D, T2, D, M, D, XH * XD);
        hipLaunchKernelGGL(k_add, dim3(M * D / 256), dim3(256), 0, stream, XA, T2, X2);
#endif
        float* H3 = WSF(192); float* GL = WSF(256); float* EL = WSF(257); int* RIDXn = (int*)WSF(261); float* GU = WSF(336); float* HH = WSF(408); float* YD = WSF(0);
        int* CNT = (int*)WSF(444); int* OFFS = CNT + 64; int* CUR = CNT + 128; int* TG = CNT + 256; int* EIDn = (int*)WSF(445); float* EWn = WSF(446); int* SLOTn = (int*)WSF(447);
        hipLaunchKernelGGL(k_rmsnorm, dim3(M), dim3(64), 0, stream, X2, D, g_moe, H3, D, D);
        gemm<float>(stream, H3, D, w_rg, NG, GL, NG, M, NG, D);
        gemm<float>(stream, H3, D, w_re, NE, EL, NE, M, NE, D);
        (void)hipMemsetAsync(CNT, 0, 64 * sizeof(int), stream);
        hipLaunchKernelGGL(k_route, dim3(M / 256), dim3(256), 0, stream, GL, EL, b_rg, b_re, EIDn, EWn, CNT);
        hipLaunchKernelGGL(k_scan, dim3(1), dim3(1024), 0, stream, CNT, OFFS, CUR, TG, RIDXn);
        hipLaunchKernelGGL(k_scatter, dim3(2 * M / 256), dim3(256), 0, stream, EIDn, OFFS, CUR, RIDXn, SLOTn);
        gemm<float>(stream, H3, D, w_gu, 2 * FF, GU, 2 * FF, NV_PMAX, 2 * FF, D, RIDXn, TG, (long)D * 2 * FF);
        hipLaunchKernelGGL(k_silu, dim3(NV_PMAX * FF / 256), dim3(256), 0, stream, GU, HH);
        gemm<float>(stream, HH, FF, w_dn, D, YD, D, NV_PMAX, D, FF, nullptr, TG, (long)FF * D);
        hipLaunchKernelGGL(k_final, dim3(M), dim3(64), 0, stream, X2, YD, SLOTn, EWn, g_final, out);
#ifdef DIAG
        hipLaunchKernelGGL(k_diag_enc, dim3(M * D / 256), dim3(256), 0, stream, out, (const unsigned*)(ws + 444 * MiB + 524288));
#endif
#undef WSF
    }
#endif
    }
    const hipError_t le = hipPeekAtLastError();
    if (le != hipSuccess) fprintf(stderr, "kernel_launch: launch failed: %s\n", hipGetErrorName(le));
}
```
